# Optimizing an MI355X kernel written in HIP

```python
import jax, jax.numpy as jnp
from jax import lax
import numpy as np

D_MODEL = 2048
BATCH = 1
SEQ = 8192
DEPTH = 1

PLE_DIM = 256
HG_HEADS = 8
HG_DK = 128
HG_DV = 128
HG_WIDTH = HG_HEADS * HG_DK
HG_CHUNK = 64
MLA_HEADS = 8
MLA_NOPE = 128
MLA_ROPE = 64
MLA_V = 128
MLA_Q_LORA = 512
MLA_KV_LORA = 512
MLA_QK = MLA_NOPE + MLA_ROPE
ROPE_THETA = 10000.0
ATTN_BLOCK = 128
PEER_HEADS = 8
PEER_NKEYS = 128
PEER_N = PEER_NKEYS * PEER_NKEYS
PEER_QDIM = 256
PEER_TOPK = 16
PEER_BLOCK = 128
IN_SIZES = (HG_WIDTH, HG_WIDTH, HG_WIDTH, HG_WIDTH,
            MLA_Q_LORA, MLA_KV_LORA, MLA_ROPE, D_MODEL, D_MODEL)
IN_WIDTH = 4 * HG_WIDTH + MLA_Q_LORA + MLA_KV_LORA + MLA_ROPE + 2 * D_MODEL
NORM_EPS = 1e-6
MASK_VALUE = -1e30

kernel_name = "hybrid_hgrn2_mla_peer_block"


def rms_norm(x, gain):
    xf = x.astype(jnp.float32)
    y = xf * lax.rsqrt(jnp.mean(xf * xf, axis=-1, keepdims=True) + NORM_EPS)
    return (y * gain.astype(jnp.float32)).astype(x.dtype)


def apply_rope(x, positions):
    half = x.shape[-1] // 2
    freqs = ROPE_THETA ** (-jnp.arange(half, dtype=jnp.float32) / half)
    ang = positions.astype(jnp.float32)[..., None] * freqs
    if x.ndim == 4:
        ang = ang[:, :, None, :]
    cos, sin = jnp.cos(ang), jnp.sin(ang)
    xf = x.astype(jnp.float32)
    x1, x2 = xf[..., :half], xf[..., half:]
    out = jnp.concatenate([x1 * cos - x2 * sin, x2 * cos + x1 * sin], axis=-1)
    return out.astype(x.dtype)


def hgrn2_chunk_scan(q, k, v, g):
    B, T, H, dk = q.shape
    dv = v.shape[-1]
    C = HG_CHUNK
    NC = T // C

    def to_chunks(a):
        return a.reshape(B, NC, C, H, a.shape[-1]).transpose(0, 3, 1, 2, 4)

    q, k, v, g = to_chunks(q), to_chunks(k), to_chunks(v), to_chunks(g)
    b = jnp.cumsum(g, axis=3)
    b_ref = b[:, :, :, C // 2 - 1:C // 2, :]
    q_in = q * jnp.exp(b - b_ref)
    k_in = k * jnp.exp(b_ref - b)
    A = jnp.einsum('bhncd,bhnsd->bhncs', q_in, k_in)
    causal = jnp.tril(jnp.ones((C, C), dtype=bool))
    A = jnp.where(causal, A, 0.0)
    o_intra = jnp.einsum('bhncs,bhnsv->bhncv', A, v)

    b_last = b[:, :, :, -1, :]
    k_dec = k * jnp.exp(b_last[:, :, :, None, :] - b)
    dS = jnp.einsum('bhncd,bhncv->bhndv', k_dec, v)
    decay = jnp.exp(b_last)

    def step(S, inp):
        dec_n, dS_n = inp
        return dec_n[..., None] * S + dS_n, S

    S0 = jnp.zeros((B, H, dk, dv), jnp.float32)
    _, S_prev = lax.scan(step, S0, (jnp.moveaxis(decay, 2, 0), jnp.moveaxis(dS, 2, 0)))
    S_prev = jnp.moveaxis(S_prev, 0, 2)
    o_inter = jnp.einsum('bhncd,bhndv->bhncv', q * jnp.exp(b), S_prev)
    o = o_intra + o_inter
    return o.transpose(0, 2, 3, 1, 4).reshape(B, T, H, dv)


def hgrn2_branch(hq, hf, hi, hog, lb, gain):
    B, T, _ = hq.shape
    f = lb + (1.0 - lb) * jax.nn.sigmoid(hf.astype(jnp.float32))
    g = jnp.log(f)
    k = 1.0 - f
    shp = (B, T, HG_HEADS, HG_DK)
    o = hgrn2_chunk_scan(hq.astype(jnp.float32).reshape(shp), k.reshape(shp),
                         hi.astype(jnp.float32).reshape(B, T, HG_HEADS, HG_DV), g.reshape(shp))
    o = o * lax.rsqrt(jnp.mean(o * o, axis=-1, keepdims=True) + NORM_EPS)
    o = o * gain.astype(jnp.float32).reshape(HG_HEADS, HG_DV)
    o = o.reshape(B, T, HG_HEADS * HG_DV) * jax.nn.silu(hog.astype(jnp.float32))
    return o.astype(hq.dtype)


def causal_block_attention(q, k, v):
    B, H, T, dq = q.shape
    dv = v.shape[-1]
    NB = T // ATTN_BLOCK
    scale = 1.0 / np.sqrt(dq).astype(np.float32)
    qb = q.reshape(B, H, NB, ATTN_BLOCK, dq).transpose(2, 0, 1, 3, 4)
    key_idx = jnp.arange(T)

    def one_block(args):
        q_blk, bi = args
        s = jnp.einsum('bhqd,bhkd->bhqk', q_blk, k,
                       preferred_element_type=jnp.float32) * scale
        q_idx = bi * ATTN_BLOCK + jnp.arange(ATTN_BLOCK)
        mask = key_idx[None, :] <= q_idx[:, None]
        s = jnp.where(mask, s, MASK_VALUE)
        pr = jax.nn.softmax(s, axis=-1).astype(v.dtype)
        return jnp.einsum('bhqk,bhkd->bhqd', pr, v)

    out = lax.map(one_block, (qb, jnp.arange(NB)))
    return out.transpose(1, 2, 0, 3, 4).reshape(B, H, T, dv)


def mla_branch(mq, mkv, mkr, positions, q_norm, kv_norm, w_uq, w_ukv):
    B, T, _ = mq.shape
    H = MLA_HEADS
    cq = rms_norm(mq, q_norm)
    q = (cq @ w_uq).reshape(B, T, H, MLA_QK)
    q_nope, q_rope = q[..., :MLA_NOPE], apply_rope(q[..., MLA_NOPE:], positions)
    ckv = rms_norm(mkv, kv_norm)
    kv = (ckv @ w_ukv).reshape(B, T, H, MLA_NOPE + MLA_V)
    k_nope, v = kv[..., :MLA_NOPE], kv[..., MLA_NOPE:]
    k_rope = apply_rope(mkr, positions)
    k_rope = jnp.broadcast_to(k_rope[:, :, None, :], (B, T, H, MLA_ROPE))
    qf = jnp.concatenate([q_nope, q_rope], axis=-1).transpose(0, 2, 1, 3)
    kf = jnp.concatenate([k_nope, k_rope], axis=-1).transpose(0, 2, 1, 3)
    o = causal_block_attention(qf, kf, v.transpose(0, 2, 1, 3))
    return o.transpose(0, 2, 1, 3).reshape(B, T, H * MLA_V)


def peer_ffn(h, wq, k1, k2, u_tab, v_tab):
    B, T, D = h.shape
    N = B * T
    K = PEER_TOPK
    half = PEER_QDIM // 2
    hf = h.reshape(N, D)
    q = (hf @ wq).reshape(N, PEER_HEADS, 2, half)
    s1 = jnp.einsum('nhc,kc->nhk', q[:, :, 0], k1)
    s2 = jnp.einsum('nhc,kc->nhk', q[:, :, 1], k2)
    v1, i1 = lax.top_k(s1, K)
    v2, i2 = lax.top_k(s2, K)
    cand = (v1[..., :, None] + v2[..., None, :]).reshape(N, PEER_HEADS, K * K)
    cv, ci = lax.top_k(cand, K)
    e_idx = (jnp.take_along_axis(i1, ci // K, axis=-1) * PEER_NKEYS
             + jnp.take_along_axis(i2, ci % K, axis=-1))
    gate = jax.nn.softmax(cv.astype(jnp.float32), axis=-1).astype(h.dtype)
    NB = N // PEER_BLOCK
    h_b = hf.reshape(NB, PEER_BLOCK, D)
    e_b = e_idx.reshape(NB, PEER_BLOCK, PEER_HEADS, K)
    g_b = gate.reshape(NB, PEER_BLOCK, PEER_HEADS, K)

    def one_block(args):
        hb, eb, gb = args
        z = jnp.einsum('thkd,td->thk', u_tab[eb], hb)
        a = jax.nn.gelu(z, approximate=False) * gb
        return jnp.einsum('thk,thkd->td', a, v_tab[eb])

    out = lax.map(one_block, (h_b, e_b, g_b))
    return out.reshape(B, T, D)


def setup_inputs(seed: int = 0) -> dict:
    key = jax.random.key(seed)
    ks = jax.random.split(key, 24)
    f32 = jnp.float32

    def nrm(k, shape, scale):
        return jax.random.normal(k, shape, f32) * scale

    def gain(k, shape):
        return 1.0 + 0.05 * jax.random.normal(k, shape, f32)

    L, D = DEPTH, D_MODEL
    return {
        "x": nrm(ks[0], (BATCH, SEQ, D), 1.0),
        "p": nrm(ks[1], (DEPTH, BATCH, SEQ, PLE_DIM), 1.0),
        "positions": jnp.broadcast_to(jnp.arange(SEQ, dtype=jnp.int32), (BATCH, SEQ)),
        "norm_mix": gain(ks[2], (L, D)),
        "w_in": nrm(ks[3], (L, D, IN_WIDTH), D ** -0.5),
        "lb_logits": nrm(ks[4], (DEPTH + 1, HG_WIDTH), 0.5),
        "hg_norm": gain(ks[5], (L, HG_WIDTH)),
        "mla_q_norm": gain(ks[6], (L, MLA_Q_LORA)),
        "mla_kv_norm": gain(ks[7], (L, MLA_KV_LORA)),
        "w_uq": nrm(ks[8], (L, MLA_Q_LORA, MLA_HEADS * MLA_QK), MLA_Q_LORA ** -0.5),
        "w_ukv": nrm(ks[9], (L, MLA_KV_LORA, MLA_HEADS * (MLA_NOPE + MLA_V)), MLA_KV_LORA ** -0.5),
        "w_a": nrm(ks[10], (L, HG_WIDTH, D), HG_WIDTH ** -0.5),
        "w_b": nrm(ks[11], (L, MLA_HEADS * MLA_V, D), (MLA_HEADS * MLA_V) ** -0.5),
        "w_o": nrm(ks[12], (L, D, D), D ** -0.5),
        "norm_ffn": gain(ks[13], (L, D)),
        "peer_wq": nrm(ks[14], (L, D, PEER_HEADS * PEER_QDIM), D ** -0.5),
        "peer_k1": nrm(ks[15], (L, PEER_NKEYS, PEER_QDIM // 2), (PEER_QDIM // 2) ** -0.5),
        "peer_k2": nrm(ks[16], (L, PEER_NKEYS, PEER_QDIM // 2), (PEER_QDIM // 2) ** -0.5),
        "peer_u": nrm(ks[17], (L, PEER_N, D), D ** -0.5),
        "peer_v": nrm(ks[18], (L, PEER_N, D), PEER_HEADS ** -0.5),
        "norm_ple": gain(ks[19], (L, D)),
        "w_pg": nrm(ks[20], (L, D, D), D ** -0.5),
        "w_pe": nrm(ks[21], (L, PLE_DIM, D), PLE_DIM ** -0.5),
        "norm_final": gain(ks[22], (D,)),
    }


def reference(x, p, positions, norm_mix, w_in, lb_logits, hg_norm, mla_q_norm, mla_kv_norm,
              w_uq, w_ukv, w_a, w_b, w_o, norm_ffn, peer_wq, peer_k1, peer_k2, peer_u, peer_v,
              norm_ple, w_pg, w_pe, norm_final):
    lb_all = jnp.cumsum(jax.nn.softmax(lb_logits.astype(jnp.float32), axis=0), axis=0)
    split_points = [int(s) for s in np.cumsum(IN_SIZES)[:-1]]
    for i in range(DEPTH):
        h = rms_norm(x, norm_mix[i])
        proj = h @ w_in[i]
        hq, hf, hi, hog, mq, mkv, mkr, ga, gb = jnp.split(proj, split_points, axis=-1)
        o_a = hgrn2_branch(hq, hf, hi, hog, lb_all[i], hg_norm[i])
        o_b = mla_branch(mq, mkv, mkr, positions, mla_q_norm[i], mla_kv_norm[i],
                         w_uq[i], w_ukv[i])
        y = jax.nn.sigmoid(ga) * (o_a @ w_a[i]) + jax.nn.sigmoid(gb) * (o_b @ w_b[i])
        x = x + y @ w_o[i]
        x = x + peer_ffn(rms_norm(x, norm_ffn[i]), peer_wq[i], peer_k1[i], peer_k2[i],
                         peer_u[i], peer_v[i])
        hp = rms_norm(x, norm_ple[i])
        x = x + jax.nn.sigmoid(hp @ w_pg[i]) * (p[i] @ w_pe[i])
    return rms_norm(x, norm_final)
```

```cpp
#include <hip/hip_runtime.h>
#include <cstdio>
#include <cstdint>

constexpr int T = 8192, DM = 2048, PLE = 256;
constexpr int HGH = 8, HGD = 128, HGW = 1024, HGC = 64, HGNC = T / HGC;
constexpr int MH = 8, MNOPE = 128, MROPE = 64, MV = 128, MQL = 512, MKVL = 512, MQK = 192;
constexpr int PH = 8, PNK = 128, PQD = 256, PK = 16;
constexpr int INW = 9280, INW_PAD = 9472;
constexpr float EPS = 1e-6f;

namespace pg8 {
#define PG8_LAS __attribute__((address_space(3)))
typedef unsigned short bf16_t;
typedef short bf16x8 __attribute__((ext_vector_type(8)));
typedef float f32x4 __attribute__((ext_vector_type(4)));
typedef unsigned u32x4 __attribute__((ext_vector_type(4)));
constexpr int BM = 256, BK = 64, HALF = 128, HTB = HALF * BK * 2  , STAGE_BYTES = 8 * HTB, NXCD = 8, WGM = 8;

__host__ __device__ __forceinline__ int lds_byte(int r, int c) { const int st = (r >> 4) * 2 + (c >> 5), rr = r & 15, cc = c & 31, ob = rr * 64 + cc * 2; return st * 1024 + (ob ^ (((ob >> 9) & 1) << 5)); }
__host__ __device__ __forceinline__ void stage_rc(int b, int& R, int& C) { const int st = b / 1024, sb = b % 1024, swz = sb ^ (((sb >> 9) & 1) << 5); R = (st >> 1) * 16 + swz / 64; C = (st & 1) * 32 + (swz % 64) / 2; }
__host__ __device__ __forceinline__ int perm32(int rho) { const int n = rho >> 4, i = rho & 15; return 8 * (i >> 2) + 4 * n + (i & 3); }

struct Unit { int pm, pn; };
struct Gemm { const bf16_t* A; const bf16_t* Bt; int M, N, K; };

struct StaticOrder {
    int nM, nN, nwg, G, c;
    __host__ __device__ void init(int M, int N, int G_, int c_) { nM = M / BM; nN = N / BM; nwg = nM * nN; G = G_; c = c_; }
    __host__ __device__ bool next(int i, Unit& u) const {
        const long L = (long)i * G + c; if (L >= nwg) return false;
        int wgid = (int)L; { const int q = nwg / NXCD, r = nwg % NXCD, xcd = wgid % NXCD, off = wgid / NXCD; wgid = (xcd < r ? xcd * (q + 1) : r * (q + 1) + (xcd - r) * q) + off; }
        const int nig = WGM * nN, gid = wgid / nig, fm = gid * WGM, gsz = (nM - fm) < WGM ? (nM - fm) : WGM;
        u.pm = fm + ((wgid % nig) % gsz); u.pn = (wgid % nig) / gsz; return true;
    }
    __device__ __forceinline__ void a_ready(const Unit&) const {}
    __device__ __forceinline__ void done(const Unit&) const {}
};


typedef float f32x2 __attribute__((ext_vector_type(2)));
typedef __bf16 bf16x2_t __attribute__((ext_vector_type(2)));
__device__ __forceinline__ unsigned cvt_pk_bf16(float lo, float hi) { const f32x2 v = {lo, hi}; const bf16x2_t b = __builtin_convertvector(v, bf16x2_t); return __builtin_bit_cast(unsigned, b); }
__device__ __forceinline__ u32x4 pack8(const f32x4 a, const f32x4 b) { u32x4 w; w.x = cvt_pk_bf16(a[0], a[1]); w.y = cvt_pk_bf16(a[2], a[3]); w.z = cvt_pk_bf16(b[0], b[1]); w.w = cvt_pk_bf16(b[2], b[3]); return w; }
__device__ __forceinline__ void unpack8(const u32x4 w, f32x4& a, f32x4& b) {
    a[0] = __uint_as_float(w.x << 16); a[1] = __uint_as_float(w.x & 0xffff0000u); a[2] = __uint_as_float(w.y << 16); a[3] = __uint_as_float(w.y & 0xffff0000u);
    b[0] = __uint_as_float(w.z << 16); b[1] = __uint_as_float(w.z & 0xffff0000u); b[2] = __uint_as_float(w.w << 16); b[3] = __uint_as_float(w.w & 0xffff0000u); }
__device__ __forceinline__ float sigm(float v) { return __builtin_amdgcn_rcpf(1.0f + __expf(-v)); }
__device__ __forceinline__ f32x4 sigm4(const f32x4 v) { return (f32x4){sigm(v[0]), sigm(v[1]), sigm(v[2]), sigm(v[3])}; }
__device__ __forceinline__ float sumsq4(const f32x4 v) { return (v[0] * v[0] + v[1] * v[1]) + (v[2] * v[2] + v[3] * v[3]); }

#define EPI_ROWS_BEGIN _Pragma("unroll") for (int ai = 0; ai < 2; ++ai) _Pragma("unroll") for (int m = 0; m < 4; ++m) { const int row = u.pm * BM + ai * HALF + wr * 64 + m * 16 + fr;
#define EPI_COLS_BEGIN _Pragma("unroll") for (int bj = 0; bj < 2; ++bj) { const int col = u.pn * BM + bj * HALF + wc * 32 + 8 * fq; const f32x4 v0 = acc[ai][bj][m][0], v1 = acc[ai][bj][m][1];
#define EPI_COLS_END }
#define EPI_ROWS_END }
typedef const f32x4 (&AccRef)[2][2][4][2];

struct EpiProj {
    static constexpr bool PERM = true, AFTER_DRAIN = false;
    bf16_t *HQ, *HV, *HOG, *MQG, *MKVG, *GA, *GB, *KB; float *F, *SSQQ, *SSQKV; const float *lb, *qn, *kvn; const f32x2* CS;
    __device__ __forceinline__ void operator()(AccRef acc, const Unit& u, int wr, int wc, int fr, int fq) const {
        const int seg = u.pn;
        EPI_ROWS_BEGIN
            float ss = 0.f;
            EPI_COLS_BEGIN
                if (seg < 4) { *(u32x4*)(HQ + (size_t)row * 1024 + col) = pack8(v0, v1); }
                else if (seg < 8) { const int c = col - 1024; const f32x4 l0 = *(const f32x4*)(lb + c), l1 = *(const f32x4*)(lb + c + 4);
                    const f32x4 f0 = l0 + (1.0f - l0) * sigm4(v0), f1 = l1 + (1.0f - l1) * sigm4(v1);
                    *(f32x4*)(F + (size_t)row * 1024 + c) = f0; *(f32x4*)(F + (size_t)row * 1024 + c + 4) = f1; }
                else if (seg < 12) { *(u32x4*)(HV + (size_t)row * 1024 + (col - 2048)) = pack8(v0, v1); }
                else if (seg < 16) { *(u32x4*)(HOG + (size_t)row * 1024 + (col - 3072)) = pack8(v0 * sigm4(v0), v1 * sigm4(v1)); }
                else if (seg < 18) { const int c = col - 4096; ss += sumsq4(v0) + sumsq4(v1);
                    *(u32x4*)(MQG + (size_t)row * 512 + c) = pack8(v0 * *(const f32x4*)(qn + c), v1 * *(const f32x4*)(qn + c + 4)); }
                else if (seg < 20) { const int c = col - 4608; ss += sumsq4(v0) + sumsq4(v1);
                    *(u32x4*)(MKVG + (size_t)row * 512 + c) = pack8(v0 * *(const f32x4*)(kvn + c), v1 * *(const f32x4*)(kvn + c + 4)); }
                else if (seg < 28) { *(u32x4*)(GA + (size_t)row * 2048 + (col - 5120)) = pack8(sigm4(v0), sigm4(v1)); }
                else if (seg < 36) { *(u32x4*)(GB + (size_t)row * 2048 + (col - 7168)) = pack8(sigm4(v0), sigm4(v1)); }
                else { const int c = col - 9216;
                    if (c < 64) { const f32x2* cs = CS + (size_t)row * 32 + (c >> 1); const f32x2 c0 = cs[0], c1 = cs[1], c2 = cs[2], c3 = cs[3];
                        f32x4 o0, o1; o0[0] = v0[0] * c0.x - v0[1] * c0.y; o0[1] = v0[1] * c0.x + v0[0] * c0.y; o0[2] = v0[2] * c1.x - v0[3] * c1.y; o0[3] = v0[3] * c1.x + v0[2] * c1.y;
                        o1[0] = v1[0] * c2.x - v1[1] * c2.y; o1[1] = v1[1] * c2.x + v1[0] * c2.y; o1[2] = v1[2] * c3.x - v1[3] * c3.y; o1[3] = v1[3] * c3.x + v1[2] * c3.y;
                        const u32x4 w = pack8(o0, o1);
#pragma unroll
                        for (int h = 0; h < MH; ++h) *(u32x4*)(KB + ((size_t)h * T + row) * MQK + MNOPE + c) = w; } }
            EPI_COLS_END
            if (seg >= 16 && seg < 20) { ss += __shfl_xor(ss, 16); ss += __shfl_xor(ss, 32);
                if (fq == 0) { float* S = seg < 18 ? SSQQ : SSQKV; S[(size_t)row * 8 + (seg & 1) * 4 + wc] = ss; } }
        EPI_ROWS_END
    }
};
constexpr float QSCALE = 0.07216878364870323f * 1.4426950408889634f;
struct EpiQ {
    static constexpr bool PERM = true, AFTER_DRAIN = false;
    bf16_t* Q; const float* SSQQ; const f32x2* CS;
    __device__ __forceinline__ void operator()(AccRef acc, const Unit& u, int wr, int wc, int fr, int fq) const {
        EPI_ROWS_BEGIN
            const f32x4 s0 = *(const f32x4*)(SSQQ + (size_t)row * 8), s1 = *(const f32x4*)(SSQQ + (size_t)row * 8 + 4);
            const float rs = __builtin_amdgcn_rsqf(((s0[0] + s0[1]) + (s0[2] + s0[3]) + (s1[0] + s1[1]) + (s1[2] + s1[3])) * (1.0f / MQL) + EPS) * QSCALE;
            EPI_COLS_BEGIN
                const int head = col / MQK, d = col - head * MQK; f32x4 a = v0 * rs, b = v1 * rs;
                if (d >= MNOPE) { const f32x2* cs = CS + (size_t)row * 32 + ((d - MNOPE) >> 1); const f32x2 c0 = cs[0], c1 = cs[1], c2 = cs[2], c3 = cs[3];
                    f32x4 o0, o1; o0[0] = a[0] * c0.x - a[1] * c0.y; o0[1] = a[1] * c0.x + a[0] * c0.y; o0[2] = a[2] * c1.x - a[3] * c1.y; o0[3] = a[3] * c1.x + a[2] * c1.y;
                    o1[0] = b[0] * c2.x - b[1] * c2.y; o1[1] = b[1] * c2.x + b[0] * c2.y; o1[2] = b[2] * c3.x - b[3] * c3.y; o1[3] = b[3] * c3.x + b[2] * c3.y; a = o0; b = o1; }
                *(u32x4*)(Q + ((size_t)head * T + row) * MQK + d) = pack8(a, b);
            EPI_COLS_END
        EPI_ROWS_END
    }
};
struct EpiKV {
    static constexpr bool PERM = true, AFTER_DRAIN = false;
    bf16_t *K, *V; const float* SSQKV;
    __device__ __forceinline__ void operator()(AccRef acc, const Unit& u, int wr, int wc, int fr, int fq) const {
        EPI_ROWS_BEGIN
            const f32x4 s0 = *(const f32x4*)(SSQKV + (size_t)row * 8), s1 = *(const f32x4*)(SSQKV + (size_t)row * 8 + 4);
            const float rs = __builtin_amdgcn_rsqf(((s0[0] + s0[1]) + (s0[2] + s0[3]) + (s1[0] + s1[1]) + (s1[2] + s1[3])) * (1.0f / MKVL) + EPS);
            EPI_COLS_BEGIN
                const int head = col >> 8, d = col & 255; const u32x4 w = pack8(v0 * rs, v1 * rs);
                if (d < MNOPE) *(u32x4*)(K + ((size_t)head * T + row) * MQK + d) = w; else *(u32x4*)(V + ((size_t)head * T + row) * MV + (d - MNOPE)) = w;
            EPI_COLS_END
        EPI_ROWS_END
    }
};
struct EpiPlain {
    static constexpr bool PERM = true, AFTER_DRAIN = false;
    bf16_t* O; int ldc;
    __device__ __forceinline__ void operator()(AccRef acc, const Unit& u, int wr, int wc, int fr, int fq) const {
        EPI_ROWS_BEGIN EPI_COLS_BEGIN *(u32x4*)(O + (size_t)row * ldc + col) = pack8(v0, v1); EPI_COLS_END EPI_ROWS_END
    }
};
struct EpiYb {
    static constexpr bool PERM = true, AFTER_DRAIN = false;
    const bf16_t* GB; bf16_t* YB;
    __device__ __forceinline__ void operator()(AccRef acc, const Unit& u, int wr, int wc, int fr, int fq) const {
        EPI_ROWS_BEGIN EPI_COLS_BEGIN f32x4 g0, g1; unpack8(*(const u32x4*)(GB + (size_t)row * DM + col), g0, g1); *(u32x4*)(YB + (size_t)row * DM + col) = pack8(v0 * g0, v1 * g1); EPI_COLS_END EPI_ROWS_END
    }
};
struct EpiY {
    static constexpr bool PERM = true, AFTER_DRAIN = false;
    const bf16_t *GA, *YB; bf16_t* Y;
    __device__ __forceinline__ void operator()(AccRef acc, const Unit& u, int wr, int wc, int fr, int fq) const {
        EPI_ROWS_BEGIN EPI_COLS_BEGIN f32x4 g0, g1, y0, y1; unpack8(*(const u32x4*)(GA + (size_t)row * DM + col), g0, g1); unpack8(*(const u32x4*)(YB + (size_t)row * DM + col), y0, y1);
            *(u32x4*)(Y + (size_t)row * DM + col) = pack8(v0 * g0 + y0, v1 * g1 + y1); EPI_COLS_END EPI_ROWS_END
    }
};
struct EpiX1 {
    static constexpr bool PERM = true, AFTER_DRAIN = false;
    const float *X, *gain; float *OUT, *SSQ; bf16_t* XG;
    __device__ __forceinline__ void operator()(AccRef acc, const Unit& u, int wr, int wc, int fr, int fq) const {
        EPI_ROWS_BEGIN
            float ss = 0.f;
            EPI_COLS_BEGIN
                const size_t o = (size_t)row * DM + col; const f32x4 a = *(const f32x4*)(X + o) + v0, b = *(const f32x4*)(X + o + 4) + v1;
                *(f32x4*)(OUT + o) = a; *(f32x4*)(OUT + o + 4) = b; ss += sumsq4(a) + sumsq4(b);
                *(u32x4*)(XG + o) = pack8(a * *(const f32x4*)(gain + col), b * *(const f32x4*)(gain + col + 4));
            EPI_COLS_END
            ss += __shfl_xor(ss, 16); ss += __shfl_xor(ss, 32);
            if (fq == 0) SSQ[(size_t)row * 32 + u.pn * 4 + wc] = ss;
        EPI_ROWS_END
    }
};
struct EpiPle {
    static constexpr bool PERM = true, AFTER_DRAIN = false;
    const bf16_t* PE; const float* SSQ2; float *OUT, *SSQ;
    __device__ __forceinline__ void operator()(AccRef acc, const Unit& u, int wr, int wc, int fr, int fq) const {
        EPI_ROWS_BEGIN
            const float rs = __builtin_amdgcn_rsqf(SSQ2[row] * (1.0f / DM) + EPS); float ss = 0.f;
            EPI_COLS_BEGIN
                const size_t o = (size_t)row * DM + col; f32x4 p0, p1; unpack8(*(const u32x4*)(PE + o), p0, p1);
                const f32x4 a = *(const f32x4*)(OUT + o) + sigm4(v0 * rs) * p0, b = *(const f32x4*)(OUT + o + 4) + sigm4(v1 * rs) * p1;
                *(f32x4*)(OUT + o) = a; *(f32x4*)(OUT + o + 4) = b; ss += sumsq4(a) + sumsq4(b);
            EPI_COLS_END
            ss += __shfl_xor(ss, 16); ss += __shfl_xor(ss, 32);
            if (fq == 0) SSQ[(size_t)row * 32 + u.pn * 4 + wc] = ss;
        EPI_ROWS_END
    }
};

template <class Epi, class Sched, bool ALIGN_EPI = false, bool SP2 = false>
__device__ __forceinline__ void gemm_phase(PG8_LAS unsigned char* lds, const Gemm g, const Sched& S, const Epi& E) {
    const int tid = threadIdx.x, wid = __builtin_amdgcn_readfirstlane(tid >> 6), lane = tid & 63, wr = wid >> 2, wc = wid & 3, fr = lane & 15, fq = lane >> 4;
    const int K = g.K, nt = K / BK;
    unsigned voffA[2], voffB[2];
#pragma unroll
    for (int i = 0; i < 2; ++i) { int R, C; stage_rc(tid * 16 + i * 8192, R, C); const int Rb = Epi::PERM ? ((R & ~31) + perm32(R & 31)) : R;
        voffA[i] = (unsigned)(R * K + C) * 2u; voffB[i] = (unsigned)(Rb * K + C) * 2u; }
    const size_t kstep = (size_t)(BK * 2);
    const size_t hstep = (size_t)HALF * K * 2;
    const size_t tstep = 2 * hstep;
    const unsigned ldsw = (unsigned)wid * 1024u;
    const int aoff = lds_byte(wr * 64 + fr, fq * 8), boff = lds_byte(wc * 32 + fr, fq * 8);
#define PG8_SA(b, h) (((b) * 2 + (h)) * HTB)
#define PG8_SB(b, h) ((4 + (b) * 2 + (h)) * HTB)
#define PG8_STAGE(bufoff, gbase, voff) do { _Pragma("unroll") for (int _i = 0; _i < 2; ++_i) \
        __builtin_amdgcn_global_load_lds((const unsigned*)((const char*)(gbase) + (voff)[_i]), (PG8_LAS unsigned*)(lds + (bufoff) + ldsw + _i * 8192), 16, 0, 0); } while (0)
#define PG8_LDA(dst, b, h) do { _Pragma("unroll") for (int m = 0; m < 4; ++m) _Pragma("unroll") for (int k = 0; k < 2; ++k) dst[m][k] = *(const PG8_LAS bf16x8*)(lds + PG8_SA(b, h) + aoff + m * 2048 + k * 1024); } while (0)
#define PG8_LDB(dst, b, h) do { _Pragma("unroll") for (int n = 0; n < 2; ++n) _Pragma("unroll") for (int k = 0; k < 2; ++k) dst[n][k] = *(const PG8_LAS bf16x8*)(lds + PG8_SB(b, h) + boff + n * 2048 + k * 1024); } while (0)
#define PG8_MMA(ai, bj, At, Bt) do { __builtin_amdgcn_s_setprio(1); _Pragma("unroll") for (int m = 0; m < 4; ++m) _Pragma("unroll") for (int n = 0; n < 2; ++n) _Pragma("unroll") for (int k = 0; k < 2; ++k) \
        acc[ai][bj][m][n] = __builtin_amdgcn_mfma_f32_16x16x32_bf16(Bt[n][k], At[m][k], acc[ai][bj][m][n], 0, 0, 0); __builtin_amdgcn_s_setprio(0); } while (0)
#define PG8_WAIT_V(n) asm volatile("s_waitcnt vmcnt(" #n ")" ::: "memory")
#define PG8_WAIT_L(n) asm volatile("s_waitcnt lgkmcnt(" #n ")" ::: "memory")
#define PG8_BAR __builtin_amdgcn_s_barrier()
#define PG8_SCHED __builtin_amdgcn_sched_barrier(0)
    Unit cur, nxt; int ui = 0;
    if (!S.next(0, cur)) return;
    f32x4 acc[2][2][4][2];
#pragma unroll
    for (int a = 0; a < 2; ++a)
#pragma unroll
        for (int b = 0; b < 2; ++b)
#pragma unroll
            for (int m = 0; m < 4; ++m)
#pragma unroll
                for (int n = 0; n < 2; ++n) acc[a][b][m][n] = (f32x4){0.f, 0.f, 0.f, 0.f};
    bf16x8 At[4][2], B0[2][2], B1[2][2];
    const char* cA = (const char*)g.A + (size_t)cur.pm * tstep; const char* cB = (const char*)g.Bt + (size_t)cur.pn * tstep;
    S.a_ready(cur);
    if constexpr (SP2) {
        PG8_STAGE(PG8_SB(0, 0), cB, voffB); PG8_STAGE(PG8_SB(0, 1), cB + hstep, voffB); PG8_STAGE(PG8_SA(0, 0), cA, voffA); PG8_STAGE(PG8_SA(0, 1), cA + hstep, voffA);
        if (wr == 1) PG8_BAR;
        PG8_WAIT_V(2); PG8_BAR;
        PG8_STAGE(PG8_SB(1, 0), cB + kstep, voffB); PG8_STAGE(PG8_SA(1, 0), cA + kstep, voffA); PG8_STAGE(PG8_SB(1, 1), cB + hstep + kstep, voffB);
        PG8_WAIT_V(6); PG8_BAR;
    } else {
        PG8_STAGE(PG8_SB(0, 0), cB, voffB); PG8_STAGE(PG8_SA(0, 0), cA, voffA); PG8_STAGE(PG8_SB(0, 1), cB + hstep, voffB); PG8_STAGE(PG8_SA(0, 1), cA + hstep, voffA);
        if (wr == 1) PG8_BAR;
        PG8_WAIT_V(4); PG8_BAR;
        PG8_STAGE(PG8_SB(1, 0), cB + kstep, voffB); PG8_STAGE(PG8_SA(1, 0), cA + kstep, voffA); PG8_STAGE(PG8_SB(1, 1), cB + hstep + kstep, voffB);
        PG8_WAIT_V(6); PG8_BAR;
    }
    for (;;) {
        const bool has_next = S.next(ui + 1, nxt);
        const char* nA = has_next ? (const char*)g.A + (size_t)nxt.pm * tstep : cA; const char* nB = has_next ? (const char*)g.Bt + (size_t)nxt.pn * tstep : cB;
        for (int t = 0; t < nt; t += 2) {
            const bool last = (t == nt - 2);
            const char* a1 = cA + (size_t)(t + 1) * kstep;
            const char* a2 = last ? nA : cA + (size_t)(t + 2) * kstep; const char* b2 = last ? nB : cB + (size_t)(t + 2) * kstep;
            const char* a3 = a2 + kstep; const char* b3 = b2 + kstep;
            if (last && has_next) S.a_ready(nxt);
            if constexpr (SP2) {
            PG8_LDB(B0, 0, 0); PG8_LDB(B1, 0, 1); PG8_SCHED; PG8_LDA(At, 0, 0); PG8_STAGE(PG8_SA(1, 1), a1 + hstep, voffA);
            PG8_WAIT_V(8); PG8_WAIT_L(0); PG8_BAR; PG8_MMA(0, 0, At, B0); PG8_MMA(0, 1, At, B1); PG8_BAR; PG8_SCHED;
            PG8_LDA(At, 0, 1); PG8_STAGE(PG8_SB(0, 0), b2, voffB); PG8_STAGE(PG8_SB(0, 1), b2 + hstep, voffB); PG8_STAGE(PG8_SA(0, 0), a2, voffA);
            PG8_WAIT_V(8); PG8_WAIT_L(0); PG8_BAR; PG8_MMA(1, 0, At, B0); PG8_MMA(1, 1, At, B1); PG8_BAR; PG8_SCHED;
            PG8_LDB(B0, 1, 0); PG8_LDB(B1, 1, 1); PG8_SCHED; PG8_LDA(At, 1, 0); PG8_STAGE(PG8_SA(0, 1), a2 + hstep, voffA);
            PG8_WAIT_V(8); PG8_WAIT_L(0); PG8_BAR; PG8_MMA(0, 0, At, B0); PG8_MMA(0, 1, At, B1); PG8_BAR; PG8_SCHED;
            PG8_LDA(At, 1, 1); PG8_STAGE(PG8_SB(1, 0), b3, voffB); PG8_STAGE(PG8_SB(1, 1), b3 + hstep, voffB); PG8_STAGE(PG8_SA(1, 0), a3, voffA);
            PG8_WAIT_V(8); PG8_WAIT_L(0); PG8_BAR; PG8_MMA(1, 0, At, B0); PG8_MMA(1, 1, At, B1); PG8_BAR; PG8_SCHED;
            } else {
            PG8_LDB(B0, 0, 0); PG8_SCHED; PG8_LDA(At, 0, 0); PG8_STAGE(PG8_SA(1, 1), a1 + hstep, voffA);
            PG8_WAIT_L(8); PG8_BAR; PG8_WAIT_L(0); PG8_MMA(0, 0, At, B0); PG8_BAR; PG8_SCHED;
            PG8_LDB(B1, 0, 1); PG8_STAGE(PG8_SB(0, 0), b2, voffB);
            PG8_BAR; PG8_WAIT_L(0); PG8_MMA(0, 1, At, B1); PG8_BAR;
            PG8_LDA(At, 0, 1); PG8_STAGE(PG8_SA(0, 0), a2, voffA);
            PG8_BAR; PG8_WAIT_L(0); PG8_MMA(1, 0, At, B0); PG8_BAR; PG8_SCHED;
            PG8_STAGE(PG8_SB(0, 1), b2 + hstep, voffB);
            PG8_WAIT_V(6); PG8_BAR; PG8_MMA(1, 1, At, B1); PG8_BAR;
            PG8_LDB(B0, 1, 0); PG8_SCHED; PG8_LDA(At, 1, 0); PG8_STAGE(PG8_SA(0, 1), a2 + hstep, voffA);
            PG8_WAIT_L(8); PG8_BAR; PG8_WAIT_L(0); PG8_MMA(0, 0, At, B0); PG8_BAR; PG8_SCHED;
            PG8_LDB(B1, 1, 1); PG8_STAGE(PG8_SB(1, 0), b3, voffB);
            PG8_BAR; PG8_WAIT_L(0); PG8_MMA(0, 1, At, B1); PG8_BAR;
            PG8_LDA(At, 1, 1); PG8_STAGE(PG8_SA(1, 0), a3, voffA);
            PG8_BAR; PG8_WAIT_L(0); PG8_MMA(1, 0, At, B0); PG8_BAR; PG8_SCHED;
            PG8_STAGE(PG8_SB(1, 1), b3 + hstep, voffB);
            PG8_WAIT_V(6); PG8_BAR; PG8_MMA(1, 1, At, B1); PG8_BAR;
            }
        }
        if constexpr (ALIGN_EPI) { if (wr == 0) PG8_BAR; }
        if constexpr (!Epi::AFTER_DRAIN) { E(acc, cur, wr, wc, fr, fq); S.done(cur); }
        if (!has_next) break;
#pragma unroll
        for (int a = 0; a < 2; ++a)
#pragma unroll
            for (int b = 0; b < 2; ++b)
#pragma unroll
                for (int m = 0; m < 4; ++m)
#pragma unroll
                    for (int n = 0; n < 2; ++n) acc[a][b][m][n] = (f32x4){0.f, 0.f, 0.f, 0.f};
        cur = nxt; cA = nA; cB = nB; ++ui;
        if constexpr (ALIGN_EPI) { if (wr == 1) PG8_BAR; }
    }
    PG8_WAIT_V(0);
    if constexpr (!ALIGN_EPI) { if (wr == 0) PG8_BAR; }
    PG8_BAR;
    if constexpr (Epi::AFTER_DRAIN) { E.fused(acc, cur, wr, wc, fr, fq, lds, wid, lane); S.done(cur); }
#undef PG8_SA
#undef PG8_SB
#undef PG8_STAGE
#undef PG8_LDA
#undef PG8_LDB
#undef PG8_MMA
#undef PG8_WAIT_V
#undef PG8_WAIT_L
#undef PG8_BAR
#undef PG8_SCHED
}
}

#define LAS __attribute__((address_space(3)))
typedef unsigned short bf16_t;
typedef short bf16x8 __attribute__((ext_vector_type(8)));
typedef short s16x4 __attribute__((ext_vector_type(4)));
typedef float f32x2 __attribute__((ext_vector_type(2)));
typedef float f32x4 __attribute__((ext_vector_type(4)));
typedef float f32x16 __attribute__((ext_vector_type(16)));
typedef unsigned u32x2 __attribute__((ext_vector_type(2)));
typedef unsigned u32x4 __attribute__((ext_vector_type(4)));
using pg8::cvt_pk_bf16; using pg8::pack8; using pg8::unpack8; using pg8::sumsq4; using pg8::sigm;
#define LDS_WAIT() asm volatile("s_waitcnt lgkmcnt(0)" ::: "memory")
__device__ __forceinline__ float bf2f(unsigned short b) { return __uint_as_float((unsigned)b << 16); }
__device__ __forceinline__ unsigned short f2bf(float f) { return (unsigned short)(cvt_pk_bf16(f, 0.f) & 0xffffu); }
__device__ __forceinline__ float wave_sum(float v) {
#pragma unroll
    for (int o = 1; o < 64; o <<= 1) v += __shfl_xor(v, o);
    return v;
}

constexpr size_t MiB = 1u << 20;
constexpr size_t WS_CTL = 0, CTL_ZERO_BYTES = 64 * 1024;
constexpr size_t WS_LB = 1 * MiB;
constexpr size_t WS_K1B = WS_LB + 64 * 1024;
constexpr size_t WS_K2B = WS_K1B + 64 * 1024;
constexpr size_t WS_SSQQ = 2 * MiB;
constexpr size_t WS_SSQKV = WS_SSQQ + 256 * 1024;
constexpr size_t WS_SSQ2 = WS_SSQKV + 256 * 1024;
constexpr size_t WS_SSQ1 = 3 * MiB;
constexpr size_t WS_SSQ3 = 4 * MiB;
constexpr size_t WS_DECAY = 5 * MiB;
constexpr size_t WS_CS = 6 * MiB;
constexpr size_t WS_EIDX = 8 * MiB;
constexpr size_t WS_GATE = 12 * MiB;
constexpr size_t WS_WUQT = 16 * MiB, WS_WUKVT = 18 * MiB, WS_WAT = 20 * MiB, WS_WBT = 24 * MiB, WS_WOT = 28 * MiB, WS_WQT = 36 * MiB, WS_WPGT = 44 * MiB, WS_WPET = 52 * MiB, WS_PBF = 53 * MiB;
constexpr size_t WS_WINT = 58 * MiB;
constexpr size_t WS_SPT = 58 * MiB;
constexpr size_t WS_ACTA = 96 * MiB;
constexpr size_t WS_GA = 128 * MiB, WS_GB = 160 * MiB;
constexpr size_t WS_QP = WS_GA, WS_PE = WS_GB;
constexpr size_t WS_HQ = 192 * MiB, WS_F = 208 * MiB, WS_HV = 240 * MiB, WS_HOG = 256 * MiB, WS_Q = 272 * MiB, WS_K = 296 * MiB, WS_V = 320 * MiB;
constexpr size_t WS_U16 = 192 * MiB, WS_V16 = 256 * MiB;
constexpr size_t WS_MQG = 336 * MiB, WS_MKVG = 344 * MiB, WS_OB = 336 * MiB;
constexpr size_t WS_DST = 352 * MiB;
constexpr size_t WS_OA = 416 * MiB, WS_YB = 432 * MiB, WS_Y = 464 * MiB, WS_END = 496 * MiB;

#define XB_TMO      128
#define XB_XCNT(j)  (256  + 64 * (j))
#define XB_XSUB(j)  (1280 + 64 * (j))
#define XB_XGEN(j)  (2304 + 64 * (j))
#define XB_TOP      3328
#define XB_TOPGEN   3392
#define XCD_BAR_WORDS 3456
#define XB_SPIN_CAP (1u << 18)

__device__ __forceinline__ unsigned xb_ld(unsigned* p)              { return __hip_atomic_load(p, __ATOMIC_RELAXED, __HIP_MEMORY_SCOPE_AGENT); }
__device__ __forceinline__ unsigned xb_add(unsigned* p, unsigned v) { return __hip_atomic_fetch_add(p, v, __ATOMIC_RELAXED, __HIP_MEMORY_SCOPE_AGENT); }
__device__ __forceinline__ unsigned xb_xcc_id() { return (unsigned)__builtin_amdgcn_s_getreg((3 << 11) | 20) & 0xFu; }
#define XB_SPIN(cond, bar) do { unsigned _sp = 0; while (cond) { __builtin_amdgcn_s_sleep(1); \
    if ((++_sp & 255u) == 0u) { if (xb_ld(&(bar)[XB_TMO])) break; if (_sp > XB_SPIN_CAP) { atomicAdd(&(bar)[XB_TMO], 1u); break; } } } } while (0)

struct XcdBarrier {
    unsigned* bar; unsigned x;
    volatile LAS unsigned* st;
};

__device__ __forceinline__ XcdBarrier xcd_barrier_post(unsigned* bar, volatile LAS unsigned* st) {
    XcdBarrier b; b.bar = bar; b.x = xb_xcc_id(); b.st = st;
    if (threadIdx.x == 0) (void)xb_add(&bar[XB_XCNT(b.x)], 1u);
    return b;
}
__device__ __forceinline__ void xcd_barrier_complete(unsigned* bar, unsigned x, unsigned& nloc, unsigned& nx) {
    const unsigned G = gridDim.x * gridDim.y * gridDim.z;
    unsigned sum, cnt, mine, sp = 0u;
    for (;;) {
        sum = 0u; cnt = 0u; mine = 0u;
#pragma unroll
        for (unsigned j = 0; j < 16; ++j) { const unsigned c = xb_ld(&bar[XB_XCNT(j)]); sum += c; cnt += (c > 0u) ? 1u : 0u; mine = (j == x) ? c : mine; }
        if (sum == G) break;
        __builtin_amdgcn_s_sleep(1);
        if ((++sp & 255u) == 0u) { if (xb_ld(&bar[XB_TMO])) break; if (sp > XB_SPIN_CAP) { atomicAdd(&bar[XB_TMO], 1u); break; } }
    }
    nloc = mine > 0u ? mine : 1u; nx = cnt > 0u ? cnt : 1u;
}

__device__ __forceinline__ void xcd_barrier(const XcdBarrier& b) {
    asm volatile("s_waitcnt vmcnt(0)" ::: "memory");
    __syncthreads();
    if (threadIdx.x == 0) {
        unsigned* bar = b.bar;
        __builtin_amdgcn_s_waitcnt(0);
        unsigned nloc = b.st[0], nx = b.st[1];
        if (nloc == 0u) { xcd_barrier_complete(bar, b.x, nloc, nx); b.st[0] = nloc; b.st[1] = nx; }
        const unsigned old = xb_add(&bar[XB_XSUB(b.x)], 1u);
        const unsigned gen = old / nloc;
        if (old + 1u == (gen + 1u) * nloc) {
            __builtin_amdgcn_fence(__ATOMIC_RELEASE, "agent");
            asm volatile("s_waitcnt vmcnt(0)" ::: "memory");
            const unsigned og = xb_add(&bar[XB_TOP], 1u);
            const unsigned tg = og / nx;
            if (og + 1u == (tg + 1u) * nx) xb_add(&bar[XB_TOPGEN], 1u);
            else XB_SPIN(xb_ld(&bar[XB_TOPGEN]) == tg, bar);
            __builtin_amdgcn_fence(__ATOMIC_ACQUIRE, "agent");
            xb_add(&bar[XB_XGEN(b.x)], 1u);
            asm volatile("s_waitcnt vmcnt(0)" ::: "memory");
        } else {
            XB_SPIN(xb_ld(&bar[XB_XGEN(b.x)]) == gen, bar);
            __builtin_amdgcn_fence(__ATOMIC_ACQUIRE, "agent");
            asm volatile("s_waitcnt vmcnt(0)" ::: "memory");
        }
    }
    __syncthreads();
}

struct Ctx { LAS unsigned char* lds; int tid, lane, wave, G, bid; float* out; unsigned char* ws; };
__device__ __forceinline__ const void* karg_ptr(int i) { return ((const void* const __attribute__((address_space(4)))*)__builtin_amdgcn_kernarg_segment_ptr())[i]; }
#define IP(i) ((const float*)karg_ptr(i))
#define WSP(type, off) ((type*)(C.ws + (off)))

__device__ __forceinline__ int ilv64(int i) { return i < 32 ? 2 * i : 2 * (i - 32) + 1; }
template <int MAP> __device__ __forceinline__ int colmap(int n) {
    if (MAP == 1) { if (n < 5120) return n; if (n < 5184) return 9216 + ilv64(n - 5120); return n - 64; }
    if (MAP == 2) { const int h = n / MQK, d = n - h * MQK; return d < MNOPE ? n : h * MQK + MNOPE + ilv64(d - MNOPE); }
    return n;
}
template <int MAP> __device__ __forceinline__ void p0_transpose_item(const float* W, int K, int N, bf16_t* WT, LAS float* scr, int item, int lane) {
    const int nblk = N / 32, kb = item / nblk, nb = item % nblk, k0 = 64 * kb, n0 = 32 * nb;
#pragma unroll 8
    for (int i = 0; i < 32; ++i) { const int kk = 2 * i + (lane >> 5); scr[kk * 33 + (lane & 31)] = W[(size_t)(k0 + kk) * N + n0 + (lane & 31)]; }
    LDS_WAIT(); asm volatile("" ::: "memory");
    const int c = lane & 7;
#pragma unroll
    for (int j = 0; j < 4; ++j) { const int n = (lane >> 3) + 8 * j; const LAS float* s = scr + (8 * c) * 33 + n;
        u32x4 o; o.x = cvt_pk_bf16(s[0 * 33], s[1 * 33]); o.y = cvt_pk_bf16(s[2 * 33], s[3 * 33]); o.z = cvt_pk_bf16(s[4 * 33], s[5 * 33]); o.w = cvt_pk_bf16(s[6 * 33], s[7 * 33]);
        *(u32x4*)(WT + (size_t)colmap<MAP>(n0 + n) * K + k0 + 8 * c) = o; }
    LDS_WAIT(); asm volatile("" ::: "memory");
}
__device__ __forceinline__ void rms_row_to_bf16(const float* xrow, const float* gain, bf16_t* orow, int lane) {
    const f32x4* xr = (const f32x4*)xrow + lane; const f32x4* gr = (const f32x4*)gain + lane;
    f32x4 v[8]; float s = 0.f;
#pragma unroll
    for (int j = 0; j < 8; ++j) { v[j] = xr[64 * j]; s += sumsq4(v[j]); }
    const float rs = __builtin_amdgcn_rsqf(wave_sum(s) * (1.0f / DM) + EPS);
    u32x2* o8 = (u32x2*)orow + lane;
#pragma unroll
    for (int j = 0; j < 8; ++j) { const f32x4 y = v[j] * rs * gr[64 * j]; u32x2 w; w.x = cvt_pk_bf16(y[0], y[1]); w.y = cvt_pk_bf16(y[2], y[3]); o8[64 * j] = w; }
}
__device__ __forceinline__ void cvt_copy(const float* src, bf16_t* dst, size_t n, size_t gtid, size_t nthr) {
    for (size_t i = gtid; i < n / 8; i += nthr) { const f32x4 a = ((const f32x4*)src)[2 * i], b = ((const f32x4*)src)[2 * i + 1]; ((u32x4*)dst)[i] = pack8(a, b); }
}

__device__ __forceinline__ void phase_prep(const Ctx& C) {
    LAS float* scr = (LAS float*)(C.lds + C.wave * 16384);
    const int gw = C.bid * 8 + C.wave, NGW = C.G * 8;
    constexpr int I_IN = (DM / 64) * (INW / 32), I_UQ = (MQL / 64) * (MH * MQK / 32), I_UKV = (MKVL / 64) * (2048 / 32), I_A = (HGW / 64) * (DM / 32), I_O = (DM / 64) * (DM / 32), I_PE = (PLE / 64) * (DM / 32);
    constexpr int NITEMS = I_IN + I_UQ + I_UKV + 2 * I_A + 3 * I_O + I_PE;
    for (int it = gw; it < NITEMS; it += NGW) {
        int r = it;
        if (r < I_IN) { p0_transpose_item<1>(IP(4), DM, INW, WSP(bf16_t, WS_WINT), scr, r, C.lane); continue; } r -= I_IN;
        if (r < I_UQ) { p0_transpose_item<2>(IP(9), MQL, MH * MQK, WSP(bf16_t, WS_WUQT), scr, r, C.lane); continue; } r -= I_UQ;
        if (r < I_UKV) { p0_transpose_item<0>(IP(10), MKVL, 2048, WSP(bf16_t, WS_WUKVT), scr, r, C.lane); continue; } r -= I_UKV;
        if (r < I_A) { p0_transpose_item<0>(IP(11), HGW, DM, WSP(bf16_t, WS_WAT), scr, r, C.lane); continue; } r -= I_A;
        if (r < I_A) { p0_transpose_item<0>(IP(12), HGW, DM, WSP(bf16_t, WS_WBT), scr, r, C.lane); continue; } r -= I_A;
        if (r < I_O) { p0_transpose_item<0>(IP(13), DM, DM, WSP(bf16_t, WS_WOT), scr, r, C.lane); continue; } r -= I_O;
        if (r < I_O) { p0_transpose_item<0>(IP(15), DM, DM, WSP(bf16_t, WS_WQT), scr, r, C.lane); continue; } r -= I_O;
        if (r < I_O) { p0_transpose_item<0>(IP(21), DM, DM, WSP(bf16_t, WS_WPGT), scr, r, C.lane); continue; } r -= I_O;
        p0_transpose_item<0>(IP(22), PLE, DM, WSP(bf16_t, WS_WPET), scr, r, C.lane);
    }
    for (int m = gw; m < T; m += NGW) rms_row_to_bf16(IP(0) + (size_t)m * DM, IP(3), WSP(bf16_t, WS_ACTA) + (size_t)m * DM, C.lane);
    const size_t gtid = (size_t)C.bid * 512 + C.tid, nthr = (size_t)C.G * 512;
    { u32x4* z = (u32x4*)(WSP(bf16_t, WS_WINT) + (size_t)INW * DM); for (size_t i = gtid; i < (size_t)(INW_PAD - INW) * DM / 8; i += nthr) z[i] = (u32x4){0u, 0u, 0u, 0u}; }
    cvt_copy(IP(1), WSP(bf16_t, WS_PBF), (size_t)T * PLE, gtid, nthr);
    cvt_copy(IP(16), WSP(bf16_t, WS_K1B), (size_t)PNK * 128, gtid, nthr);
    cvt_copy(IP(17), WSP(bf16_t, WS_K2B), (size_t)PNK * 128, gtid, nthr);
    for (size_t i = gtid; i < HGW; i += nthr) WSP(float, WS_LB)[i] = 1.0f / (1.0f + __expf(IP(5)[HGW + i] - IP(5)[i]));
    for (size_t e = gtid; e < (size_t)T * 32; e += nthr) { const int t = (int)(e >> 5), i = (int)(e & 31);
        double fr = 1.0; for (int k = 0; k < i; ++k) fr *= 0.74989420933245582;
        const float ang = (float)((const int*)karg_ptr(2))[t] * (float)fr; const double rev = (double)ang * 0.15915494309189535; const float fx = (float)(rev - floor(rev));
        WSP(f32x2, WS_CS)[e] = (f32x2){__builtin_amdgcn_cosf(fx), __builtin_amdgcn_sinf(fx)}; }
}

__device__ __forceinline__ void hgrn_cumsum(const Ctx& C, int h, int n, float (&fv)[16], float (&bb)[16], float& b_ref, float& b_last, LAS float* TOT) {
    const int d = C.tid & 127, rg = C.tid >> 7; const float* F = WSP(float, WS_F) + ((size_t)(n * HGC + rg * 16)) * HGW + h * HGD + d;
    float run = 0.f;
#pragma unroll
    for (int i = 0; i < 16; ++i) { fv[i] = F[(size_t)i * HGW]; run += __logf(fv[i]); bb[i] = run; }
    TOT[rg * 128 + d] = run; LDS_WAIT(); __syncthreads();
    const float t0 = TOT[d], t1 = TOT[128 + d], t2 = TOT[256 + d], t3 = TOT[384 + d];
    const float off = rg == 0 ? 0.f : rg == 1 ? t0 : rg == 2 ? t0 + t1 : (t0 + t1) + t2;
    b_ref = t0 + t1; b_last = ((t0 + t1) + t2) + t3;
#pragma unroll
    for (int i = 0; i < 16; ++i) bb[i] += off;
}
constexpr int HG_KDT = 0, HG_VT = 18432, HG_TOT = 36864;
__device__ __forceinline__ void hgrn_a_unit(const Ctx& C, int h, int n) {
    LAS bf16_t* KDT = (LAS bf16_t*)(C.lds + HG_KDT); LAS bf16_t* VT = (LAS bf16_t*)(C.lds + HG_VT); LAS float* TOT = (LAS float*)(C.lds + HG_TOT);
    const int d = C.tid & 127, rg = C.tid >> 7;
    float fv[16], bb[16], b_ref, b_last; hgrn_cumsum(C, h, n, fv, bb, b_ref, b_last, TOT);
    const bf16_t* HVp = WSP(bf16_t, WS_HV) + ((size_t)(n * HGC + rg * 16)) * HGW + h * HGD + d;
#pragma unroll
    for (int g = 0; g < 2; ++g) { float kd[8], vv[8];
#pragma unroll
        for (int i = 0; i < 8; ++i) { const int r = g * 8 + i; kd[i] = (1.0f - fv[r]) * __expf(b_last - bb[r]); vv[i] = bf2f(HVp[(size_t)r * HGW]); }
        u32x4 wk, wv; wk.x = cvt_pk_bf16(kd[0], kd[1]); wk.y = cvt_pk_bf16(kd[2], kd[3]); wk.z = cvt_pk_bf16(kd[4], kd[5]); wk.w = cvt_pk_bf16(kd[6], kd[7]);
        wv.x = cvt_pk_bf16(vv[0], vv[1]); wv.y = cvt_pk_bf16(vv[2], vv[3]); wv.z = cvt_pk_bf16(vv[4], vv[5]); wv.w = cvt_pk_bf16(vv[6], vv[7]);
        *(LAS u32x4*)(KDT + d * 72 + rg * 16 + g * 8) = wk; *(LAS u32x4*)(VT + d * 72 + rg * 16 + g * 8) = wv; }
    if (rg == 0) WSP(float, WS_DECAY)[((size_t)h * HGNC + n) * HGD + d] = __expf(b_last);
    LDS_WAIT(); __syncthreads();
    const int fr = C.lane & 15, fq = C.lane >> 4, w = C.wave;
    bf16x8 bfr[2];
#pragma unroll
    for (int ks = 0; ks < 2; ++ks) bfr[ks] = *(const LAS bf16x8*)(VT + (16 * w + fr) * 72 + 8 * fq + 32 * ks);
    float* DST = WSP(float, WS_DST) + (((size_t)h * HGNC + n) * HGD + 16 * w + fr) * HGD;
#pragma unroll
    for (int mt = 0; mt < 8; ++mt) { f32x4 acc = {0.f, 0.f, 0.f, 0.f};
#pragma unroll
        for (int ks = 0; ks < 2; ++ks) { const bf16x8 a = *(const LAS bf16x8*)(KDT + (16 * mt + fr) * 72 + 8 * fq + 32 * ks); acc = __builtin_amdgcn_mfma_f32_16x16x32_bf16(a, bfr[ks], acc, 0, 0, 0); }
        *(f32x4*)(DST + 16 * mt + 4 * fq) = acc; }
    LDS_WAIT(); __syncthreads();
}
__device__ __forceinline__ void hgrn_scan(const Ctx& C) {
    const float* DST = WSP(float, WS_DST); const float* DEC = WSP(float, WS_DECAY); bf16_t* SPT = WSP(bf16_t, WS_SPT);
    for (int e = C.bid * 512 + C.tid; e < HGH * HGD * HGD; e += C.G * 512) {
        const int h = e >> 14, dv = (e >> 7) & 127, dk = e & 127; float S = 0.f;
        const size_t base = ((size_t)h * HGNC * HGD + dv) * HGD + dk; const size_t dbase = (size_t)h * HGNC * HGD + dk;
#pragma unroll 8
        for (int n = 0; n < HGNC; ++n) { SPT[base + (size_t)n * HGD * HGD] = f2bf(S); S = DEC[dbase + (size_t)n * HGD] * S + DST[base + (size_t)n * HGD * HGD]; }
    }
}
constexpr int HC_QIN = 0, HC_KIN = 17408, HC_QE = 34816, HC_VT = 52224, HC_AQ = 70656, HC_TOT = 79872, HC_OL = 81920;
__device__ __forceinline__ void hgrn_c_unit(const Ctx& C, int h, int n) {
    LAS bf16_t* QIN = (LAS bf16_t*)(C.lds + HC_QIN); LAS bf16_t* KIN = (LAS bf16_t*)(C.lds + HC_KIN); LAS bf16_t* QE = (LAS bf16_t*)(C.lds + HC_QE);
    LAS bf16_t* VT = (LAS bf16_t*)(C.lds + HC_VT); LAS bf16_t* AQ = (LAS bf16_t*)(C.lds + HC_AQ); LAS float* TOT = (LAS float*)(C.lds + HC_TOT); LAS float* OL = (LAS float*)(C.lds + HC_OL);
    const int d = C.tid & 127, rg = C.tid >> 7;
    float fv[16], bb[16], b_ref, b_last; hgrn_cumsum(C, h, n, fv, bb, b_ref, b_last, TOT);
    const size_t gro = ((size_t)(n * HGC + rg * 16)) * HGW + h * HGD + d; const bf16_t* HVp = WSP(bf16_t, WS_HV) + gro; const bf16_t* HQp = WSP(bf16_t, WS_HQ) + gro;
#pragma unroll
    for (int g = 0; g < 2; ++g) { float vv[8];
#pragma unroll
        for (int i = 0; i < 8; ++i) { const int r = g * 8 + i, c = rg * 16 + r; const float q = bf2f(HQp[(size_t)r * HGW]), k = 1.0f - fv[r];
            QIN[c * 136 + d] = f2bf(q * __expf(bb[r] - b_ref)); KIN[c * 136 + d] = f2bf(k * __expf(b_ref - bb[r])); QE[c * 136 + d] = f2bf(q * __expf(bb[r])); vv[i] = bf2f(HVp[(size_t)r * HGW]); }
        u32x4 wv; wv.x = cvt_pk_bf16(vv[0], vv[1]); wv.y = cvt_pk_bf16(vv[2], vv[3]); wv.z = cvt_pk_bf16(vv[4], vv[5]); wv.w = cvt_pk_bf16(vv[6], vv[7]);
        *(LAS u32x4*)(VT + d * 72 + rg * 16 + g * 8) = wv; }
    LDS_WAIT(); __syncthreads();
    const int fr = C.lane & 15, fq = C.lane >> 4, w = C.wave;
    { const int mt = w >> 1;
#pragma unroll
      for (int j = 0; j < 2; ++j) { const int nt = 2 * (w & 1) + j; f32x4 acc = {0.f, 0.f, 0.f, 0.f};
#pragma unroll
        for (int ks = 0; ks < 4; ++ks) { const bf16x8 a = *(const LAS bf16x8*)(QIN + (16 * mt + fr) * 136 + 8 * fq + 32 * ks), b = *(const LAS bf16x8*)(KIN + (16 * nt + fr) * 136 + 8 * fq + 32 * ks);
            acc = __builtin_amdgcn_mfma_f32_16x16x32_bf16(a, b, acc, 0, 0, 0); }
        const int s = 16 * nt + fr;
#pragma unroll
        for (int i = 0; i < 4; ++i) { const int c = 16 * mt + 4 * fq + i; AQ[c * 72 + s] = f2bf(s <= c ? acc[i] : 0.f); } } }
    LDS_WAIT(); __syncthreads();
    { bf16x8 bv[2], bs[4]; const bf16_t* SP = WSP(bf16_t, WS_SPT) + (((size_t)h * HGNC + n) * HGD + 16 * w + fr) * HGD;
#pragma unroll
      for (int ks = 0; ks < 2; ++ks) bv[ks] = *(const LAS bf16x8*)(VT + (16 * w + fr) * 72 + 8 * fq + 32 * ks);
#pragma unroll
      for (int ks = 0; ks < 4; ++ks) bs[ks] = *(const bf16x8*)(SP + 8 * fq + 32 * ks);
#pragma unroll
      for (int mt = 0; mt < 4; ++mt) { f32x4 acc = {0.f, 0.f, 0.f, 0.f};
#pragma unroll
        for (int ks = 0; ks < 2; ++ks) { const bf16x8 a = *(const LAS bf16x8*)(AQ + (16 * mt + fr) * 72 + 8 * fq + 32 * ks); acc = __builtin_amdgcn_mfma_f32_16x16x32_bf16(a, bv[ks], acc, 0, 0, 0); }
#pragma unroll
        for (int ks = 0; ks < 4; ++ks) { const bf16x8 a = *(const LAS bf16x8*)(QE + (16 * mt + fr) * 136 + 8 * fq + 32 * ks); acc = __builtin_amdgcn_mfma_f32_16x16x32_bf16(a, bs[ks], acc, 0, 0, 0); }
#pragma unroll
        for (int i = 0; i < 4; ++i) OL[(16 * mt + 4 * fq + i) * 132 + 16 * w + fr] = acc[i]; } }
    LDS_WAIT(); __syncthreads();
    { const int c = C.tid >> 3, j = C.tid & 7; f32x4 o[4]; float ss = 0.f;
#pragma unroll
      for (int i = 0; i < 4; ++i) { o[i] = *(const LAS f32x4*)(OL + c * 132 + 16 * j + 4 * i); ss += sumsq4(o[i]); }
      ss += __shfl_xor(ss, 1); ss += __shfl_xor(ss, 2); ss += __shfl_xor(ss, 4);
      const float rs = __builtin_amdgcn_rsqf(ss * (1.0f / HGD) + EPS); const size_t go = (size_t)(n * HGC + c) * HGW + h * HGD + 16 * j;
      const float* gn = IP(6) + h * HGD + 16 * j; const bf16_t* HOG = WSP(bf16_t, WS_HOG) + go; bf16_t* OA = WSP(bf16_t, WS_OA) + go;
#pragma unroll
      for (int i = 0; i < 2; ++i) { f32x4 s0, s1; unpack8(*(const u32x4*)(HOG + 8 * i), s0, s1);
          *(u32x4*)(OA + 8 * i) = pack8(o[2 * i] * rs * *(const f32x4*)(gn + 8 * i) * s0, o[2 * i + 1] * rs * *(const f32x4*)(gn + 8 * i + 4) * s1); } }
    LDS_WAIT(); __syncthreads();
}

constexpr int AT_K = 0, AT_KSTR = 400, AT_V = 25600, AT_MRG = 0, AT_MRG_STRIDE = 16384 + 256;
typedef short v4i16_t __attribute__((ext_vector_type(4)));
__device__ __forceinline__ s16x4 vtr(const LAS unsigned char* p) { return __builtin_bit_cast(s16x4, __builtin_amdgcn_ds_read_tr16_b64_v4i16((LAS v4i16_t*)p)); }
__device__ __forceinline__ int crow(int r, int hi) { return (r & 3) + 8 * (r >> 2) + 4 * hi; }
__device__ __forceinline__ void attn_unit(const Ctx& C, int h, int qb) {
    const int lane = C.lane, ql = lane & 31, hi = lane >> 5, kg = C.wave >> 2, qw = C.wave & 3, tid = C.tid;
    const int q0 = qb * 128, ntiles = 2 * (qb + 1), qpos = q0 + 32 * qw + ql;
    const bf16_t* Qp = WSP(bf16_t, WS_Q) + ((size_t)h * T + qpos) * MQK + 8 * hi; const bf16_t* Kp = WSP(bf16_t, WS_K) + (size_t)h * T * MQK; const bf16_t* Vp = WSP(bf16_t, WS_V) + (size_t)h * T * MV;
    bf16x8 qf[12];
#pragma unroll
    for (int ks = 0; ks < 12; ++ks) qf[ks] = *(const bf16x8*)(Qp + 16 * ks);
    float m_run = -1e30f, l_run = 0.f; f32x16 oT[4];
#pragma unroll
    for (int nb = 0; nb < 4; ++nb) oT[nb] = (f32x16){0.f, 0.f, 0.f, 0.f, 0.f, 0.f, 0.f, 0.f, 0.f, 0.f, 0.f, 0.f, 0.f, 0.f, 0.f, 0.f};
    const LAS unsigned char* kfrag = C.lds + AT_K + (32 * kg + ql) * AT_KSTR + 16 * hi;
    const LAS unsigned char* vfrag = C.lds + AT_V + (16 * kg) * 512 + (4 * hi + ((lane & 15) >> 2)) * 64 + ((lane >> 4) & 1) * 32 + (lane & 3) * 8;
    for (int j = 0; j < ntiles; ++j) {
        const int k0 = 64 * j;
        __syncthreads();
#pragma unroll
        for (int i = 0; i < 3; ++i) { const int cid = tid + 512 * i, r = cid / 24, cc = cid - r * 24; *(LAS u32x4*)(C.lds + AT_K + r * AT_KSTR + cc * 16) = *(const u32x4*)(Kp + (size_t)(k0 + r) * MQK + cc * 8); }
#pragma unroll
        for (int i = 0; i < 2; ++i) { const int cid = tid + 512 * i, r = cid >> 4, cc = cid & 15; *(LAS u32x4*)(C.lds + AT_V + ((r >> 3) * 4 + (cc >> 2)) * 512 + (r & 7) * 64 + (cc & 3) * 16) = *(const u32x4*)(Vp + (size_t)(k0 + r) * MV + cc * 8); }
        LDS_WAIT(); __syncthreads();
        const int kbase = k0 + 32 * kg;
        if (kbase <= q0 + 32 * qw + 31) {
            f32x16 st = (f32x16){0.f, 0.f, 0.f, 0.f, 0.f, 0.f, 0.f, 0.f, 0.f, 0.f, 0.f, 0.f, 0.f, 0.f, 0.f, 0.f};
#pragma unroll
            for (int ks = 0; ks < 12; ++ks) { const bf16x8 a = *(const LAS bf16x8*)(kfrag + 32 * ks); st = __builtin_amdgcn_mfma_f32_32x32x16_bf16(a, qf[ks], st, 0, 0, 0); }
            if (kbase + 31 > q0 + 32 * qw) {
#pragma unroll
                for (int r = 0; r < 16; ++r) if (kbase + crow(r, hi) > qpos) st[r] = -__builtin_inff();
            }
            float mx = st[0];
#pragma unroll
            for (int r = 1; r < 16; ++r) mx = fmaxf(mx, st[r]);
            mx = fmaxf(mx, __shfl_xor(mx, 32));
            const float m_new = fmaxf(m_run, mx), alpha = __builtin_amdgcn_exp2f(m_run - m_new); m_run = m_new;
            float ps = 0.f;
#pragma unroll
            for (int r = 0; r < 16; ++r) { st[r] = __builtin_amdgcn_exp2f(st[r] - m_new); ps += st[r]; }
            ps += __shfl_xor(ps, 32); l_run = l_run * alpha + ps;
#pragma unroll
            for (int nb = 0; nb < 4; ++nb) oT[nb] *= alpha;
            bf16x8 pf[2];
#pragma unroll
            for (int s2 = 0; s2 < 2; ++s2) { u32x4 w; w.x = cvt_pk_bf16(st[8 * s2 + 0], st[8 * s2 + 1]); w.y = cvt_pk_bf16(st[8 * s2 + 2], st[8 * s2 + 3]); w.z = cvt_pk_bf16(st[8 * s2 + 4], st[8 * s2 + 5]); w.w = cvt_pk_bf16(st[8 * s2 + 6], st[8 * s2 + 7]); pf[s2] = __builtin_bit_cast(bf16x8, w); }
#pragma unroll
            for (int nb = 0; nb < 4; ++nb)
#pragma unroll
                for (int s2 = 0; s2 < 2; ++s2) { const s16x4 lo = vtr(vfrag + (8 * s2) * 512 + nb * 512), hh = vtr(vfrag + (8 * s2 + 4) * 512 + nb * 512);
                    const bf16x8 vf = (bf16x8){lo[0], lo[1], lo[2], lo[3], hh[0], hh[1], hh[2], hh[3]};
                    oT[nb] = __builtin_amdgcn_mfma_f32_32x32x16_bf16(vf, pf[s2], oT[nb], 0, 0, 0); }
        }
    }
    __syncthreads();
    LAS float* MG = (LAS float*)(C.lds + AT_MRG + qw * AT_MRG_STRIDE);
    if (kg == 1) { if (hi == 0) { MG[2 * ql] = m_run; MG[2 * ql + 1] = l_run; }
#pragma unroll
        for (int nb = 0; nb < 4; ++nb)
#pragma unroll
            for (int r = 0; r < 16; ++r) MG[64 + (nb * 16 + r) * 64 + lane] = oT[nb][r]; }
    LDS_WAIT(); __syncthreads();
    if (kg == 0) { const float m2 = MG[2 * ql], l2 = MG[2 * ql + 1], mm = fmaxf(m_run, m2), a1 = __builtin_amdgcn_exp2f(m_run - mm), a2 = __builtin_amdgcn_exp2f(m2 - mm);
        const float inv = 1.0f / (a1 * l_run + a2 * l2); const float c1 = a1 * inv, c2 = a2 * inv;
        bf16_t* O = WSP(bf16_t, WS_OB) + (size_t)qpos * HGW + h * MV + 4 * hi;
#pragma unroll
        for (int nb = 0; nb < 4; ++nb)
#pragma unroll
            for (int g = 0; g < 4; ++g) { float o[4];
#pragma unroll
                for (int i = 0; i < 4; ++i) { const int r = 4 * g + i; o[i] = c1 * oT[nb][r] + c2 * MG[64 + (nb * 16 + r) * 64 + lane]; }
                u32x2 w; w.x = cvt_pk_bf16(o[0], o[1]); w.y = cvt_pk_bf16(o[2], o[3]); *(u32x2*)(O + 32 * nb + 8 * g) = w; } }
    LDS_WAIT();
}

constexpr int TK_KEY = 0, TK_SCR = 65536;
__device__ __forceinline__ int f2ord(float f) { const int i = __float_as_int(f); return i >= 0 ? i : (i ^ 0x7fffffff); }
__device__ __forceinline__ float ord2f(int k) { return __int_as_float(k >= 0 ? k : (k ^ 0x7fffffff)); }
__device__ __forceinline__ void topk_unit(const Ctx& C, int tb, int h) {
    const int lane = C.lane, fr = lane & 15, fq = lane >> 4, w = C.wave, t0 = tb * 64;
    LAS int* KEY = (LAS int*)(C.lds + TK_KEY);
    { const bf16_t* QP = WSP(bf16_t, WS_QP) + (size_t)t0 * DM + h * PQD;
#pragma unroll
      for (int half = 0; half < 2; ++half) { const bf16_t* KB = WSP(bf16_t, half ? WS_K2B : WS_K1B) + (16 * w + fr) * 128 + 8 * fq; bf16x8 b[4];
#pragma unroll
        for (int ks = 0; ks < 4; ++ks) b[ks] = *(const bf16x8*)(KB + 32 * ks);
#pragma unroll
        for (int mt = 0; mt < 4; ++mt) { f32x4 acc = {0.f, 0.f, 0.f, 0.f};
#pragma unroll
            for (int ks = 0; ks < 4; ++ks) { const bf16x8 a = *(const bf16x8*)(QP + (size_t)(16 * mt + fr) * DM + half * 128 + 8 * fq + 32 * ks); acc = __builtin_amdgcn_mfma_f32_16x16x32_bf16(a, b[ks], acc, 0, 0, 0); }
            const int key = 16 * w + fr;
#pragma unroll
            for (int i = 0; i < 4; ++i) KEY[((16 * mt + 4 * fq + i) * 2 + half) * 128 + key] = (f2ord(acc[i]) & ~127) | (127 - key); } } }
    LDS_WAIT(); __syncthreads();
    LAS int* TOP = (LAS int*)(C.lds + TK_SCR + 1024 * w); LAS int* CK = TOP + 32; LAS int* SELE = CK + 64; LAS float* SELV = (LAS float*)(SELE + 16);
    const int ca = (lane >= 16) + (lane >= 24) + (lane >= 29) + (lane >= 33) + (lane >= 36) + (lane >= 38) + (lane >= 40) + (lane >= 42) + (lane >= 43) + (lane >= 44) + (lane >= 45) + (lane >= 46) + (lane >= 47) + (lane >= 48) + (lane >= 49);
    const int cb = lane - (ca == 0 ? 0 : ca == 1 ? 16 : ca == 2 ? 24 : ca == 3 ? 29 : ca == 4 ? 33 : ca == 5 ? 36 : ca == 6 ? 38 : ca == 7 ? 40 : 42 + (ca - 8));
    for (int tt = 0; tt < 8; ++tt) { const int tl = w * 8 + tt, t = t0 + tl;
#pragma unroll
        for (int half = 0; half < 2; ++half) { const LAS int* row = KEY + (tl * 2 + half) * 128; const int own0 = row[lane], own1 = row[lane + 64]; int c0 = 0, c1 = 0;
#pragma unroll 8
            for (int jj = 0; jj < 32; ++jj) { const u32x4 kk = *(const LAS u32x4*)(row + 4 * jj);
                c0 += ((int)kk.x > own0) + ((int)kk.y > own0) + ((int)kk.z > own0) + ((int)kk.w > own0); c1 += ((int)kk.x > own1) + ((int)kk.y > own1) + ((int)kk.z > own1) + ((int)kk.w > own1); }
            if (c0 < 16) TOP[half * 16 + c0] = own0; if (c1 < 16) TOP[half * 16 + c1] = own1; }
        LDS_WAIT();
        int ka = 0, kb = 0, ck = (int)0x80000000; float cv = 0.f;
        if (lane < 50) { ka = TOP[ca]; kb = TOP[16 + cb]; cv = ord2f(ka & ~127) + ord2f(kb & ~127); ck = (f2ord(cv) & ~63) | (63 - lane); }
        CK[lane] = ck; LDS_WAIT();
        int rk = 0;
#pragma unroll
        for (int jj = 0; jj < 13; ++jj) { const u32x4 kk = *(const LAS u32x4*)(CK + 4 * jj); rk += ((int)kk.x > ck) + ((int)kk.y > ck) + ((int)kk.z > ck) + ((int)kk.w > ck); }
        if (lane < 50 && rk < 16) { SELE[rk] = (127 - (ka & 127)) * PNK + (127 - (kb & 127)); SELV[rk] = cv; }
        LDS_WAIT();
        if (lane < 16) { const f32x4 s0 = *(const f32x4*)(WSP(float, WS_SSQ1) + (size_t)t * 32 + 8 * (lane & 3)), s1 = *(const f32x4*)(WSP(float, WS_SSQ1) + (size_t)t * 32 + 8 * (lane & 3) + 4);
            float ss = (s0[0] + s0[1]) + (s0[2] + s0[3]) + (s1[0] + s1[1]) + (s1[2] + s1[3]); ss += __shfl_xor(ss, 1); ss += __shfl_xor(ss, 2);
            const float rs = __builtin_amdgcn_rsqf(ss * (1.0f / DM) + EPS);
            float ex = __expf((SELV[lane] - SELV[0]) * rs); float sm = ex; sm += __shfl_xor(sm, 1); sm += __shfl_xor(sm, 2); sm += __shfl_xor(sm, 4); sm += __shfl_xor(sm, 8);
            WSP(int, WS_EIDX)[(size_t)t * 128 + h * 16 + lane] = SELE[lane]; WSP(float, WS_GATE)[(size_t)t * 128 + h * 16 + lane] = ex / sm; }
        LDS_WAIT();
    }
    __syncthreads();
}

__device__ __forceinline__ float gelu_erf(float z) { return 0.5f * z * (1.0f + erff(z * 0.70710678118654752f)); }
__device__ __forceinline__ void peer_token(const Ctx& C, int t) {
    const int lane = C.lane; float* xr = C.out + (size_t)t * DM + 8 * lane;
    f32x4 hn[8]; float ss = 0.f;
#pragma unroll
    for (int j = 0; j < 4; ++j) { hn[2 * j] = *(const f32x4*)(xr + 512 * j); hn[2 * j + 1] = *(const f32x4*)(xr + 512 * j + 4); ss += sumsq4(hn[2 * j]) + sumsq4(hn[2 * j + 1]); }
    const float rs = __builtin_amdgcn_rsqf(wave_sum(ss) * (1.0f / DM) + EPS);
#pragma unroll
    for (int j = 0; j < 4; ++j) { hn[2 * j] = hn[2 * j] * rs * *(const f32x4*)(IP(14) + 512 * j + 8 * lane); hn[2 * j + 1] = hn[2 * j + 1] * rs * *(const f32x4*)(IP(14) + 512 * j + 8 * lane + 4); }
    const int e0 = WSP(int, WS_EIDX)[(size_t)t * 128 + lane], e1 = WSP(int, WS_EIDX)[(size_t)t * 128 + 64 + lane];
    const float g0 = WSP(float, WS_GATE)[(size_t)t * 128 + lane], g1 = WSP(float, WS_GATE)[(size_t)t * 128 + 64 + lane];
    f32x4 oa[8];
#pragma unroll
    for (int j = 0; j < 8; ++j) oa[j] = (f32x4){0.f, 0.f, 0.f, 0.f};
    const bf16_t* U = WSP(bf16_t, WS_U16) + 8 * lane; const bf16_t* V = WSP(bf16_t, WS_V16) + 8 * lane;
    constexpr int EB = 2;
    for (int eb = 0; eb < 128; eb += EB) {
        u32x4 uw[EB][4], vw[EB][4]; float z[EB], gt[EB];
#pragma unroll
        for (int k = 0; k < EB; ++k) { const int ei = eb + k; const int e = ei < 64 ? __builtin_amdgcn_readlane(e0, ei) : __builtin_amdgcn_readlane(e1, ei - 64);
            const int gi = ei < 64 ? __builtin_amdgcn_readlane(__float_as_int(g0), ei) : __builtin_amdgcn_readlane(__float_as_int(g1), ei - 64);
            gt[k] = __int_as_float(gi);
#pragma unroll
            for (int j = 0; j < 4; ++j) { uw[k][j] = *(const u32x4*)(U + (size_t)e * DM + 512 * j); vw[k][j] = *(const u32x4*)(V + (size_t)e * DM + 512 * j); } }
#pragma unroll
        for (int k = 0; k < EB; ++k) { float s = 0.f;
#pragma unroll
            for (int j = 0; j < 4; ++j) { f32x4 a, b; unpack8(uw[k][j], a, b); const f32x4 pa = a * hn[2 * j], pb = b * hn[2 * j + 1]; s += ((pa[0] + pa[1]) + (pa[2] + pa[3])) + ((pb[0] + pb[1]) + (pb[2] + pb[3])); }
            z[k] = s; }
#pragma unroll
        for (int o = 1; o < 64; o <<= 1) {
#pragma unroll
            for (int k = 0; k < EB; ++k) z[k] += __shfl_xor(z[k], o); }
#pragma unroll
        for (int k = 0; k < EB; ++k) { const float a = gelu_erf(z[k]) * gt[k];
#pragma unroll
            for (int j = 0; j < 4; ++j) { f32x4 va, vb; unpack8(vw[k][j], va, vb); oa[2 * j] += va * a; oa[2 * j + 1] += vb * a; } }
    }
    float s2 = 0.f; bf16_t* xg = WSP(bf16_t, WS_ACTA) + (size_t)t * DM + 8 * lane;
#pragma unroll
    for (int j = 0; j < 4; ++j) { const f32x4 a = *(const f32x4*)(xr + 512 * j) + oa[2 * j], b = *(const f32x4*)(xr + 512 * j + 4) + oa[2 * j + 1];
        *(f32x4*)(xr + 512 * j) = a; *(f32x4*)(xr + 512 * j + 4) = b; s2 += sumsq4(a) + sumsq4(b);
        *(u32x4*)(xg + 512 * j) = pack8(a * *(const f32x4*)(IP(20) + 512 * j + 8 * lane), b * *(const f32x4*)(IP(20) + 512 * j + 8 * lane + 4)); }
    s2 = wave_sum(s2); if (lane == 0) WSP(float, WS_SSQ2)[t] = s2;
}
__device__ __forceinline__ void final_row(const Ctx& C, int t) {
    const int lane = C.lane; float pz = lane < 32 ? WSP(float, WS_SSQ3)[(size_t)t * 32 + lane] : 0.f;
    const float rs = __builtin_amdgcn_rsqf(wave_sum(pz) * (1.0f / DM) + EPS);
    f32x4* xr = (f32x4*)(C.out + (size_t)t * DM) + lane; const f32x4* gr = (const f32x4*)IP(23) + lane;
#pragma unroll
    for (int j = 0; j < 8; ++j) xr[64 * j] = xr[64 * j] * rs * gr[64 * j];
}

constexpr int NPHASE = 12;
#ifndef MK_ONE_LAUNCH
#define MK_ONE_LAUNCH 0
#endif
constexpr int LDS_BYTES = 147456;
constexpr int MISC_OFF = 131072 + 320;
struct Args { const void* in[24]; float* out; unsigned char* ws; int ph_lo, ph_hi; };
#define GEMM_ALIGN true
#define GEMM_SP2 true

__global__ void __launch_bounds__(512, 2) mk_fwd(Args args) {
    extern __shared__ __attribute__((aligned(16))) unsigned char lds_raw[];
    Ctx C;
    C.lds = (LAS unsigned char*)lds_raw; C.tid = threadIdx.x; C.lane = C.tid & 63; C.wave = __builtin_amdgcn_readfirstlane(C.tid >> 6); C.G = gridDim.x; C.bid = blockIdx.x;
    C.out = (float*)karg_ptr(24); C.ws = (unsigned char*)karg_ptr(25);
    volatile LAS unsigned* MISC = (volatile LAS unsigned*)(C.lds + MISC_OFF);
    if (C.tid < 32) MISC[C.tid] = 0u;
    __syncthreads();
    const int lo = ((const int __attribute__((address_space(4)))*)__builtin_amdgcn_kernarg_segment_ptr())[52], hi = ((const int __attribute__((address_space(4)))*)__builtin_amdgcn_kernarg_segment_ptr())[53];
    const bool multi = (hi - lo) > 1;
    XcdBarrier bar; bar.bar = (unsigned*)(C.ws + WS_CTL) + 1024; bar.x = 0; bar.st = nullptr;
    if (multi) bar = xcd_barrier_post((unsigned*)(C.ws + WS_CTL) + 1024, MISC + 8);
#ifndef PHMASK
#define PHMASK 0xFFF
#endif
#define IN(k) (((PHMASK >> (k)) & 1) && lo <= (k) && (k) < hi)
#define SEAM(k) do { if (IN(k) && IN((k) + 1)) xcd_barrier(bar); } while (0)
    LAS unsigned char* L = C.lds;
    const int gw = C.bid * 8 + C.wave, NGW = C.G * 8;

    if (IN(0)) { phase_prep(C); } SEAM(0);

    if (IN(1)) {
        pg8::Gemm g{WSP(bf16_t, WS_ACTA), WSP(bf16_t, WS_WINT), T, INW_PAD, DM}; pg8::StaticOrder S; S.init(T, INW_PAD, C.G, C.bid);
        pg8::EpiProj E{WSP(bf16_t, WS_HQ), WSP(bf16_t, WS_HV), WSP(bf16_t, WS_HOG), WSP(bf16_t, WS_MQG), WSP(bf16_t, WS_MKVG), WSP(bf16_t, WS_GA), WSP(bf16_t, WS_GB), WSP(bf16_t, WS_K),
                       WSP(float, WS_F), WSP(float, WS_SSQQ), WSP(float, WS_SSQKV), WSP(float, WS_LB), IP(7), IP(8), WSP(pg8::f32x2, WS_CS)};
        pg8::gemm_phase<pg8::EpiProj, pg8::StaticOrder, GEMM_ALIGN, GEMM_SP2>(L, g, S, E);
    } SEAM(1);

    if (IN(2)) {
        { pg8::Gemm g{WSP(bf16_t, WS_MQG), WSP(bf16_t, WS_WUQT), T, MH * MQK, MQL}; pg8::StaticOrder S; S.init(T, MH * MQK, C.G, C.bid);
          pg8::EpiQ E{WSP(bf16_t, WS_Q), WSP(float, WS_SSQQ), WSP(pg8::f32x2, WS_CS)};
          pg8::gemm_phase<pg8::EpiQ, pg8::StaticOrder, GEMM_ALIGN, GEMM_SP2>(L, g, S, E); }
        { pg8::Gemm g{WSP(bf16_t, WS_MKVG), WSP(bf16_t, WS_WUKVT), T, 2048, MKVL}; pg8::StaticOrder S; S.init(T, 2048, C.G, C.bid);
          pg8::EpiKV E{WSP(bf16_t, WS_K), WSP(bf16_t, WS_V), WSP(float, WS_SSQKV)};
          pg8::gemm_phase<pg8::EpiKV, pg8::StaticOrder, GEMM_ALIGN, GEMM_SP2>(L, g, S, E); }
        __syncthreads();
        for (int u = C.bid; u < HGH * HGNC; u += C.G) hgrn_a_unit(C, u >> 7, u & 127);
    } SEAM(2);

    if (IN(3)) {
        hgrn_scan(C);
        for (int pr = C.bid; pr < 256; pr += C.G) { const int h = pr >> 5, s = pr & 31; attn_unit(C, h, 63 - s); attn_unit(C, h, s); }
    } SEAM(3);

    if (IN(4)) {
        __syncthreads();
        for (int u = C.bid; u < HGH * HGNC; u += C.G) hgrn_c_unit(C, u >> 7, u & 127);
        __syncthreads();
        pg8::Gemm g{WSP(bf16_t, WS_OB), WSP(bf16_t, WS_WBT), T, DM, HGW}; pg8::StaticOrder S; S.init(T, DM, C.G, C.bid);
        pg8::EpiYb E{WSP(bf16_t, WS_GB), WSP(bf16_t, WS_YB)};
        pg8::gemm_phase<pg8::EpiYb, pg8::StaticOrder, GEMM_ALIGN, GEMM_SP2>(L, g, S, E);
    } SEAM(4);

    if (IN(5)) {
        const size_t gtid = (size_t)C.bid * 512 + C.tid, nthr = (size_t)C.G * 512;
        cvt_copy(IP(18), WSP(bf16_t, WS_U16), (size_t)PNK * PNK * DM, gtid, nthr);
        cvt_copy(IP(19), WSP(bf16_t, WS_V16), (size_t)PNK * PNK * DM, gtid, nthr);
        pg8::Gemm g{WSP(bf16_t, WS_OA), WSP(bf16_t, WS_WAT), T, DM, HGW}; pg8::StaticOrder S; S.init(T, DM, C.G, C.bid);
        pg8::EpiY E{WSP(bf16_t, WS_GA), WSP(bf16_t, WS_YB), WSP(bf16_t, WS_Y)};
        pg8::gemm_phase<pg8::EpiY, pg8::StaticOrder, GEMM_ALIGN, GEMM_SP2>(L, g, S, E);
    } SEAM(5);

    if (IN(6)) {
        pg8::Gemm g{WSP(bf16_t, WS_Y), WSP(bf16_t, WS_WOT), T, DM, DM}; pg8::StaticOrder S; S.init(T, DM, C.G, C.bid);
        pg8::EpiX1 E{IP(0), IP(14), C.out, WSP(float, WS_SSQ1), WSP(bf16_t, WS_ACTA)};
        pg8::gemm_phase<pg8::EpiX1, pg8::StaticOrder, GEMM_ALIGN, GEMM_SP2>(L, g, S, E);
    } SEAM(6);

    if (IN(7)) {
        { pg8::Gemm g{WSP(bf16_t, WS_ACTA), WSP(bf16_t, WS_WQT), T, DM, DM}; pg8::StaticOrder S; S.init(T, DM, C.G, C.bid);
          pg8::EpiPlain E{WSP(bf16_t, WS_QP), DM};
          pg8::gemm_phase<pg8::EpiPlain, pg8::StaticOrder, GEMM_ALIGN, GEMM_SP2>(L, g, S, E); }
        { pg8::Gemm g{WSP(bf16_t, WS_PBF), WSP(bf16_t, WS_WPET), T, DM, PLE}; pg8::StaticOrder S; S.init(T, DM, C.G, C.bid);
          pg8::EpiPlain E{WSP(bf16_t, WS_PE), DM};
          pg8::gemm_phase<pg8::EpiPlain, pg8::StaticOrder, GEMM_ALIGN, GEMM_SP2>(L, g, S, E); }
    } SEAM(7);

    if (IN(8)) {
        __syncthreads();
        for (int u = C.bid; u < (T / 64) * PH; u += C.G) topk_unit(C, u >> 3, u & 7);
    } SEAM(8);

    if (IN(9)) {
        for (int t = gw; t < T; t += NGW) peer_token(C, t);
    } SEAM(9);

    if (IN(10)) {
        pg8::Gemm g{WSP(bf16_t, WS_ACTA), WSP(bf16_t, WS_WPGT), T, DM, DM}; pg8::StaticOrder S; S.init(T, DM, C.G, C.bid);
        pg8::EpiPle E{WSP(bf16_t, WS_PE), WSP(float, WS_SSQ2), C.out, WSP(float, WS_SSQ3)};
        pg8::gemm_phase<pg8::EpiPle, pg8::StaticOrder, GEMM_ALIGN, GEMM_SP2>(L, g, S, E);
    } SEAM(10);

    if (IN(11)) { for (int t = gw; t < T; t += NGW) final_row(C, t); }
#undef IN
#undef SEAM
}

extern "C" void kernel_launch(void* const* d_in, const int* in_sizes, int n_in, void* d_out, int out_size, void* d_ws, size_t ws_size, hipStream_t stream) {
    static int grid = 0;
    if (grid == 0) {
        if (n_in != 24 || out_size != T * DM || ws_size < WS_END) { fprintf(stderr, "kernel_launch: unexpected shapes: n_in %d out %d ws %zu (need %zu)\n", n_in, out_size, ws_size, (size_t)WS_END); grid = -1; return; }
        int dev = 0, cus = 0;
        if (hipGetDevice(&dev) != hipSuccess || hipDeviceGetAttribute(&cus, hipDeviceAttributeMultiprocessorCount, dev) != hipSuccess) { grid = -1; return; }
        if (hipFuncSetAttribute((const void*)mk_fwd, hipFuncAttributeMaxDynamicSharedMemorySize, LDS_BYTES) != hipSuccess) { fprintf(stderr, "kernel_launch: hipFuncSetAttribute failed\n"); grid = -1; return; }
        (void)hipGetLastError();
        grid = cus;
    }
    if (grid < 0) return;
    (void)hipMemsetAsync((char*)d_ws + WS_CTL, 0, CTL_ZERO_BYTES, stream);
    Args a{};
    for (int i = 0; i < 24; ++i) a.in[i] = d_in[i];
    a.out = (float*)d_out; a.ws = (unsigned char*)d_ws;
#if MK_ONE_LAUNCH
    a.ph_lo = 0; a.ph_hi = NPHASE;
    hipLaunchKernelGGL(mk_fwd, dim3(grid), dim3(512), LDS_BYTES, stream, a);
#else
    for (int ph = 0; ph < NPHASE; ++ph) { a.ph_lo = ph; a.ph_hi = ph + 1; hipLaunchKernelGGL(mk_fwd, dim3(grid), dim3(512), LDS_BYTES, stream, a); }
#endif
}
```

```cpp
#include <hip/hip_runtime.h>
#include <cstdio>
#include <cstdint>

constexpr int T = 8192, DM = 2048, PLE = 256;
constexpr int HGH = 8, HGD = 128, HGW = 1024, HGC = 64, HGNC = T / HGC;
constexpr int MH = 8, MNOPE = 128, MROPE = 64, MV = 128, MQL = 512, MKVL = 512, MQK = 192;
constexpr int PH = 8, PNK = 128, PQD = 256, PK = 16;
constexpr int INW = 9280, INW_PAD = 9472;
constexpr float EPS = 1e-6f;

namespace pg8 {
#define PG8_LAS __attribute__((address_space(3)))
typedef unsigned short bf16_t;
typedef short bf16x8 __attribute__((ext_vector_type(8)));
typedef float f32x4 __attribute__((ext_vector_type(4)));
typedef unsigned u32x4 __attribute__((ext_vector_type(4)));
constexpr int BM = 256, BK = 64, HALF = 128, HTB = HALF * BK * 2  , STAGE_BYTES = 8 * HTB, NXCD = 8, WGM = 8;

__host__ __device__ __forceinline__ int lds_byte(int r, int c) { const int st = (r >> 4) * 2 + (c >> 5), rr = r & 15, cc = c & 31, ob = rr * 64 + cc * 2; return st * 1024 + (ob ^ (((ob >> 9) & 1) << 5)); }
__host__ __device__ __forceinline__ void stage_rc(int b, int& R, int& C) { const int st = b / 1024, sb = b % 1024, swz = sb ^ (((sb >> 9) & 1) << 5); R = (st >> 1) * 16 + swz / 64; C = (st & 1) * 32 + (swz % 64) / 2; }
__host__ __device__ __forceinline__ int perm32(int rho) { const int n = rho >> 4, i = rho & 15; return 8 * (i >> 2) + 4 * n + (i & 3); }

struct Unit { int pm, pn; };
struct Gemm { const bf16_t* A; const bf16_t* Bt; int M, N, K; };

struct StaticOrder {
    int nM, nN, nwg, G, c;
    __host__ __device__ void init(int M, int N, int G_, int c_) { nM = M / BM; nN = N / BM; nwg = nM * nN; G = G_; c = c_; }
    __host__ __device__ bool next(int i, Unit& u) const {
        const long L = (long)i * G + c; if (L >= nwg) return false;
        int wgid = (int)L; { const int q = nwg / NXCD, r = nwg % NXCD, xcd = wgid % NXCD, off = wgid / NXCD; wgid = (xcd < r ? xcd * (q + 1) : r * (q + 1) + (xcd - r) * q) + off; }
        const int nig = WGM * nN, gid = wgid / nig, fm = gid * WGM, gsz = (nM - fm) < WGM ? (nM - fm) : WGM;
        u.pm = fm + ((wgid % nig) % gsz); u.pn = (wgid % nig) / gsz; return true;
    }
    __device__ __forceinline__ void a_ready(const Unit&) const {}
    __device__ __forceinline__ void done(const Unit&) const {}
};


typedef float f32x2 __attribute__((ext_vector_type(2)));
typedef __bf16 bf16x2_t __attribute__((ext_vector_type(2)));
__device__ __forceinline__ unsigned cvt_pk_bf16(float lo, float hi) { const f32x2 v = {lo, hi}; const bf16x2_t b = __builtin_convertvector(v, bf16x2_t); return __builtin_bit_cast(unsigned, b); }
__device__ __forceinline__ u32x4 pack8(const f32x4 a, const f32x4 b) { u32x4 w; w.x = cvt_pk_bf16(a[0], a[1]); w.y = cvt_pk_bf16(a[2], a[3]); w.z = cvt_pk_bf16(b[0], b[1]); w.w = cvt_pk_bf16(b[2], b[3]); return w; }
__device__ __forceinline__ void unpack8(const u32x4 w, f32x4& a, f32x4& b) {
    a[0] = __uint_as_float(w.x << 16); a[1] = __uint_as_float(w.x & 0xffff0000u); a[2] = __uint_as_float(w.y << 16); a[3] = __uint_as_float(w.y & 0xffff0000u);
    b[0] = __uint_as_float(w.z << 16); b[1] = __uint_as_float(w.z & 0xffff0000u); b[2] = __uint_as_float(w.w << 16); b[3] = __uint_as_float(w.w & 0xffff0000u); }
__device__ __forceinline__ float sigm(float v) { return __builtin_amdgcn_rcpf(1.0f + __expf(-v)); }
__device__ __forceinline__ f32x4 sigm4(const f32x4 v) { return (f32x4){sigm(v[0]), sigm(v[1]), sigm(v[2]), sigm(v[3])}; }
__device__ __forceinline__ float sumsq4(const f32x4 v) { return (v[0] * v[0] + v[1] * v[1]) + (v[2] * v[2] + v[3] * v[3]); }

#define EPI_ROWS_BEGIN _Pragma("unroll") for (int ai = 0; ai < 2; ++ai) _Pragma("unroll") for (int m = 0; m < 4; ++m) { const int row = u.pm * BM + ai * HALF + wr * 64 + m * 16 + fr;
#define EPI_COLS_BEGIN _Pragma("unroll") for (int bj = 0; bj < 2; ++bj) { const int col = u.pn * BM + bj * HALF + wc * 32 + 8 * fq; const f32x4 v0 = acc[ai][bj][m][0], v1 = acc[ai][bj][m][1];
#define EPI_COLS_END }
#define EPI_ROWS_END }
typedef const f32x4 (&AccRef)[2][2][4][2];

struct EpiProj {
    static constexpr bool PERM = true, AFTER_DRAIN = false;
    bf16_t *HQ, *HV, *HOG, *MQG, *MKVG, *GA, *GB, *KB; float *F, *SSQQ, *SSQKV; const float *lb, *qn, *kvn; const f32x2* CS;
    __device__ __forceinline__ void operator()(AccRef acc, const Unit& u, int wr, int wc, int fr, int fq) const {
        const int seg = u.pn;
        EPI_ROWS_BEGIN
            float ss = 0.f;
            EPI_COLS_BEGIN
                if (seg < 4) { *(u32x4*)(HQ + (size_t)row * 1024 + col) = pack8(v0, v1); }
                else if (seg < 8) { const int c = col - 1024; const f32x4 l0 = *(const f32x4*)(lb + c), l1 = *(const f32x4*)(lb + c + 4);
                    const f32x4 f0 = l0 + (1.0f - l0) * sigm4(v0), f1 = l1 + (1.0f - l1) * sigm4(v1);
                    *(f32x4*)(F + (size_t)row * 1024 + c) = f0; *(f32x4*)(F + (size_t)row * 1024 + c + 4) = f1; }
                else if (seg < 12) { *(u32x4*)(HV + (size_t)row * 1024 + (col - 2048)) = pack8(v0, v1); }
                else if (seg < 16) { *(u32x4*)(HOG + (size_t)row * 1024 + (col - 3072)) = pack8(v0 * sigm4(v0), v1 * sigm4(v1)); }
                else if (seg < 18) { const int c = col - 4096; ss += sumsq4(v0) + sumsq4(v1);
                    *(u32x4*)(MQG + (size_t)row * 512 + c) = pack8(v0 * *(const f32x4*)(qn + c), v1 * *(const f32x4*)(qn + c + 4)); }
                else if (seg < 20) { const int c = col - 4608; ss += sumsq4(v0) + sumsq4(v1);
                    *(u32x4*)(MKVG + (size_t)row * 512 + c) = pack8(v0 * *(const f32x4*)(kvn + c), v1 * *(const f32x4*)(kvn + c + 4)); }
                else if (seg < 28) { *(u32x4*)(GA + (size_t)row * 2048 + (col - 5120)) = pack8(sigm4(v0), sigm4(v1)); }
                else if (seg < 36) { *(u32x4*)(GB + (size_t)row * 2048 + (col - 7168)) = pack8(sigm4(v0), sigm4(v1)); }
                else { const int c = col - 9216;
                    if (c < 64) { const f32x2* cs = CS + (size_t)row * 32 + (c >> 1); const f32x2 c0 = cs[0], c1 = cs[1], c2 = cs[2], c3 = cs[3];
                        f32x4 o0, o1; o0[0] = v0[0] * c0.x - v0[1] * c0.y; o0[1] = v0[1] * c0.x + v0[0] * c0.y; o0[2] = v0[2] * c1.x - v0[3] * c1.y; o0[3] = v0[3] * c1.x + v0[2] * c1.y;
                        o1[0] = v1[0] * c2.x - v1[1] * c2.y; o1[1] = v1[1] * c2.x + v1[0] * c2.y; o1[2] = v1[2] * c3.x - v1[3] * c3.y; o1[3] = v1[3] * c3.x + v1[2] * c3.y;
                        const u32x4 w = pack8(o0, o1);
#pragma unroll
                        for (int h = 0; h < MH; ++h) *(u32x4*)(KB + ((size_t)h * T + row) * MQK + MNOPE + c) = w; } }
            EPI_COLS_END
            if (seg >= 16 && seg < 20) { ss += __shfl_xor(ss, 16); ss += __shfl_xor(ss, 32);
                if (fq == 0) { float* S = seg < 18 ? SSQQ : SSQKV; S[(size_t)row * 8 + (seg & 1) * 4 + wc] = ss; } }
        EPI_ROWS_END
    }
};
constexpr float QSCALE = 0.07216878364870323f * 1.4426950408889634f;
struct EpiQ {
    static constexpr bool PERM = true, AFTER_DRAIN = false;
    bf16_t* Q; const float* SSQQ; const f32x2* CS;
    __device__ __forceinline__ void operator()(AccRef acc, const Unit& u, int wr, int wc, int fr, int fq) const {
        EPI_ROWS_BEGIN
            const f32x4 s0 = *(const f32x4*)(SSQQ + (size_t)row * 8), s1 = *(const f32x4*)(SSQQ + (size_t)row * 8 + 4);
            const float rs = __builtin_amdgcn_rsqf(((s0[0] + s0[1]) + (s0[2] + s0[3]) + (s1[0] + s1[1]) + (s1[2] + s1[3])) * (1.0f / MQL) + EPS) * QSCALE;
            EPI_COLS_BEGIN
                const int head = col / MQK, d = col - head * MQK; f32x4 a = v0 * rs, b = v1 * rs;
                if (d >= MNOPE) { const f32x2* cs = CS + (size_t)row * 32 + ((d - MNOPE) >> 1); const f32x2 c0 = cs[0], c1 = cs[1], c2 = cs[2], c3 = cs[3];
                    f32x4 o0, o1; o0[0] = a[0] * c0.x - a[1] * c0.y; o0[1] = a[1] * c0.x + a[0] * c0.y; o0[2] = a[2] * c1.x - a[3] * c1.y; o0[3] = a[3] * c1.x + a[2] * c1.y;
                    o1[0] = b[0] * c2.x - b[1] * c2.y; o1[1] = b[1] * c2.x + b[0] * c2.y; o1[2] = b[2] * c3.x - b[3] * c3.y; o1[3] = b[3] * c3.x + b[2] * c3.y; a = o0; b = o1; }
                *(u32x4*)(Q + ((size_t)head * T + row) * MQK + d) = pack8(a, b);
            EPI_COLS_END
        EPI_ROWS_END
    }
};
struct EpiKV {
    static constexpr bool PERM = true, AFTER_DRAIN = false;
    bf16_t *K, *V; const float* SSQKV;
    __device__ __forceinline__ void operator()(AccRef acc, const Unit& u, int wr, int wc, int fr, int fq) const {
        EPI_ROWS_BEGIN
            const f32x4 s0 = *(const f32x4*)(SSQKV + (size_t)row * 8), s1 = *(const f32x4*)(SSQKV + (size_t)row * 8 + 4);
            const float rs = __builtin_amdgcn_rsqf(((s0[0] + s0[1]) + (s0[2] + s0[3]) + (s1[0] + s1[1]) + (s1[2] + s1[3])) * (1.0f / MKVL) + EPS);
            EPI_COLS_BEGIN
                const int head = col >> 8, d = col & 255; const u32x4 w = pack8(v0 * rs, v1 * rs);
                if (d < MNOPE) *(u32x4*)(K + ((size_t)head * T + row) * MQK + d) = w; else *(u32x4*)(V + ((size_t)head * T + row) * MV + (d - MNOPE)) = w;
            EPI_COLS_END
        EPI_ROWS_END
    }
};
struct EpiPlain {
    static constexpr bool PERM = true, AFTER_DRAIN = false;
    bf16_t* O; int ldc;
    __device__ __forceinline__ void operator()(AccRef acc, const Unit& u, int wr, int wc, int fr, int fq) const {
        EPI_ROWS_BEGIN EPI_COLS_BEGIN *(u32x4*)(O + (size_t)row * ldc + col) = pack8(v0, v1); EPI_COLS_END EPI_ROWS_END
    }
};
struct EpiYb {
    static constexpr bool PERM = true, AFTER_DRAIN = false;
    const bf16_t* GB; bf16_t* YB;
    __device__ __forceinline__ void operator()(AccRef acc, const Unit& u, int wr, int wc, int fr, int fq) const {
        EPI_ROWS_BEGIN EPI_COLS_BEGIN f32x4 g0, g1; unpack8(*(const u32x4*)(GB + (size_t)row * DM + col), g0, g1); *(u32x4*)(YB + (size_t)row * DM + col) = pack8(v0 * g0, v1 * g1); EPI_COLS_END EPI_ROWS_END
    }
};
struct EpiY {
    static constexpr bool PERM = true, AFTER_DRAIN = false;
    const bf16_t *GA, *YB; bf16_t* Y;
    __device__ __forceinline__ void operator()(AccRef acc, const Unit& u, int wr, int wc, int fr, int fq) const {
        EPI_ROWS_BEGIN EPI_COLS_BEGIN f32x4 g0, g1, y0, y1; unpack8(*(const u32x4*)(GA + (size_t)row * DM + col), g0, g1); unpack8(*(const u32x4*)(YB + (size_t)row * DM + col), y0, y1);
            *(u32x4*)(Y + (size_t)row * DM + col) = pack8(v0 * g0 + y0, v1 * g1 + y1); EPI_COLS_END EPI_ROWS_END
    }
};
struct EpiX1 {
    static constexpr bool PERM = true, AFTER_DRAIN = false;
    const float *X, *gain; float *OUT, *SSQ; bf16_t* XG;
    __device__ __forceinline__ void operator()(AccRef acc, const Unit& u, int wr, int wc, int fr, int fq) const {
        EPI_ROWS_BEGIN
            float ss = 0.f;
            EPI_COLS_BEGIN
                const size_t o = (size_t)row * DM + col; const f32x4 a = *(const f32x4*)(X + o) + v0, b = *(const f32x4*)(X + o + 4) + v1;
                *(f32x4*)(OUT + o) = a; *(f32x4*)(OUT + o + 4) = b; ss += sumsq4(a) + sumsq4(b);
                *(u32x4*)(XG + o) = pack8(a * *(const f32x4*)(gain + col), b * *(const f32x4*)(gain + col + 4));
            EPI_COLS_END
            ss += __shfl_xor(ss, 16); ss += __shfl_xor(ss, 32);
            if (fq == 0) SSQ[(size_t)row * 32 + u.pn * 4 + wc] = ss;
        EPI_ROWS_END
    }
};
struct EpiPle {
    static constexpr bool PERM = true, AFTER_DRAIN = false;
    const bf16_t* PE; const float *SSQ2, *X2; float *OUT, *SSQ;
    __device__ __forceinline__ void operator()(AccRef acc, const Unit& u, int wr, int wc, int fr, int fq) const {
        EPI_ROWS_BEGIN
            const float rs = __builtin_amdgcn_rsqf(SSQ2[row] * (1.0f / DM) + EPS); float ss = 0.f;
            EPI_COLS_BEGIN
                const size_t o = (size_t)row * DM + col; f32x4 p0, p1; unpack8(*(const u32x4*)(PE + o), p0, p1);
                const f32x4 a = *(const f32x4*)(X2 + o) + sigm4(v0 * rs) * p0, b = *(const f32x4*)(X2 + o + 4) + sigm4(v1 * rs) * p1;
                *(f32x4*)(OUT + o) = a; *(f32x4*)(OUT + o + 4) = b; ss += sumsq4(a) + sumsq4(b);
            EPI_COLS_END
            ss += __shfl_xor(ss, 16); ss += __shfl_xor(ss, 32);
            if (fq == 0) SSQ[(size_t)row * 32 + u.pn * 4 + wc] = ss;
        EPI_ROWS_END
    }
};

template <class Epi, class Sched, bool ALIGN_EPI = false, bool SP2 = false>
__device__ __forceinline__ void gemm_phase(PG8_LAS unsigned char* lds, const Gemm g, const Sched& S, const Epi& E) {
    const int tid = threadIdx.x, wid = __builtin_amdgcn_readfirstlane(tid >> 6), lane = tid & 63, wr = wid >> 2, wc = wid & 3, fr = lane & 15, fq = lane >> 4;
    const int K = g.K, nt = K / BK;
    unsigned voffA[2], voffB[2];
#pragma unroll
    for (int i = 0; i < 2; ++i) { int R, C; stage_rc(tid * 16 + i * 8192, R, C); const int Rb = Epi::PERM ? ((R & ~31) + perm32(R & 31)) : R;
        voffA[i] = (unsigned)(R * K + C) * 2u; voffB[i] = (unsigned)(Rb * K + C) * 2u; }
    const size_t kstep = (size_t)(BK * 2);
    const size_t hstep = (size_t)HALF * K * 2;
    const size_t tstep = 2 * hstep;
    const unsigned ldsw = (unsigned)wid * 1024u;
    const int aoff = lds_byte(wr * 64 + fr, fq * 8), boff = lds_byte(wc * 32 + fr, fq * 8);
#define PG8_SA(b, h) (((b) * 2 + (h)) * HTB)
#define PG8_SB(b, h) ((4 + (b) * 2 + (h)) * HTB)
#define PG8_STAGE(bufoff, gbase, voff) do { _Pragma("unroll") for (int _i = 0; _i < 2; ++_i) \
        __builtin_amdgcn_global_load_lds((const unsigned*)((const char*)(gbase) + (voff)[_i]), (PG8_LAS unsigned*)(lds + (bufoff) + ldsw + _i * 8192), 16, 0, 0); } while (0)
#define PG8_LDA(dst, b, h) do { _Pragma("unroll") for (int m = 0; m < 4; ++m) _Pragma("unroll") for (int k = 0; k < 2; ++k) dst[m][k] = *(const PG8_LAS bf16x8*)(lds + PG8_SA(b, h) + aoff + m * 2048 + k * 1024); } while (0)
#define PG8_LDB(dst, b, h) do { _Pragma("unroll") for (int n = 0; n < 2; ++n) _Pragma("unroll") for (int k = 0; k < 2; ++k) dst[n][k] = *(const PG8_LAS bf16x8*)(lds + PG8_SB(b, h) + boff + n * 2048 + k * 1024); } while (0)
#define PG8_MMA(ai, bj, At, Bt) do { __builtin_amdgcn_s_setprio(1); _Pragma("unroll") for (int m = 0; m < 4; ++m) _Pragma("unroll") for (int n = 0; n < 2; ++n) _Pragma("unroll") for (int k = 0; k < 2; ++k) \
        acc[ai][bj][m][n] = __builtin_amdgcn_mfma_f32_16x16x32_bf16(Bt[n][k], At[m][k], acc[ai][bj][m][n], 0, 0, 0); __builtin_amdgcn_s_setprio(0); } while (0)
#define PG8_WAIT_V(n) asm volatile("s_waitcnt vmcnt(" #n ")" ::: "memory")
#define PG8_WAIT_L(n) asm volatile("s_waitcnt lgkmcnt(" #n ")" ::: "memory")
#define PG8_BAR __builtin_amdgcn_s_barrier()
#define PG8_SCHED __builtin_amdgcn_sched_barrier(0)
    Unit cur, nxt; int ui = 0;
    if (!S.next(0, cur)) return;
    f32x4 acc[2][2][4][2];
#pragma unroll
    for (int a = 0; a < 2; ++a)
#pragma unroll
        for (int b = 0; b < 2; ++b)
#pragma unroll
            for (int m = 0; m < 4; ++m)
#pragma unroll
                for (int n = 0; n < 2; ++n) acc[a][b][m][n] = (f32x4){0.f, 0.f, 0.f, 0.f};
    bf16x8 At[4][2], B0[2][2], B1[2][2];
    const char* cA = (const char*)g.A + (size_t)cur.pm * tstep; const char* cB = (const char*)g.Bt + (size_t)cur.pn * tstep;
    S.a_ready(cur);
    if constexpr (SP2) {
        PG8_STAGE(PG8_SB(0, 0), cB, voffB); PG8_STAGE(PG8_SB(0, 1), cB + hstep, voffB); PG8_STAGE(PG8_SA(0, 0), cA, voffA); PG8_STAGE(PG8_SA(0, 1), cA + hstep, voffA);
        if (wr == 1) PG8_BAR;
        PG8_WAIT_V(2); PG8_BAR;
        PG8_STAGE(PG8_SB(1, 0), cB + kstep, voffB); PG8_STAGE(PG8_SA(1, 0), cA + kstep, voffA); PG8_STAGE(PG8_SB(1, 1), cB + hstep + kstep, voffB);
        PG8_WAIT_V(6); PG8_BAR;
    } else {
        PG8_STAGE(PG8_SB(0, 0), cB, voffB); PG8_STAGE(PG8_SA(0, 0), cA, voffA); PG8_STAGE(PG8_SB(0, 1), cB + hstep, voffB); PG8_STAGE(PG8_SA(0, 1), cA + hstep, voffA);
        if (wr == 1) PG8_BAR;
        PG8_WAIT_V(4); PG8_BAR;
        PG8_STAGE(PG8_SB(1, 0), cB + kstep, voffB); PG8_STAGE(PG8_SA(1, 0), cA + kstep, voffA); PG8_STAGE(PG8_SB(1, 1), cB + hstep + kstep, voffB);
        PG8_WAIT_V(6); PG8_BAR;
    }
    for (;;) {
        const bool has_next = S.next(ui + 1, nxt);
        const char* nA = has_next ? (const char*)g.A + (size_t)nxt.pm * tstep : cA; const char* nB = has_next ? (const char*)g.Bt + (size_t)nxt.pn * tstep : cB;
        for (int t = 0; t < nt; t += 2) {
            const bool last = (t == nt - 2);
            const char* a1 = cA + (size_t)(t + 1) * kstep;
            const char* a2 = last ? nA : cA + (size_t)(t + 2) * kstep; const char* b2 = last ? nB : cB + (size_t)(t + 2) * kstep;
            const char* a3 = a2 + kstep; const char* b3 = b2 + kstep;
            if (last && has_next) S.a_ready(nxt);
            if constexpr (SP2) {
            PG8_LDB(B0, 0, 0); PG8_LDB(B1, 0, 1); PG8_SCHED; PG8_LDA(At, 0, 0); PG8_STAGE(PG8_SA(1, 1), a1 + hstep, voffA);
            PG8_WAIT_V(8); PG8_WAIT_L(0); PG8_BAR; PG8_MMA(0, 0, At, B0); PG8_MMA(0, 1, At, B1); PG8_BAR; PG8_SCHED;
            PG8_LDA(At, 0, 1); PG8_STAGE(PG8_SB(0, 0), b2, voffB); PG8_STAGE(PG8_SB(0, 1), b2 + hstep, voffB); PG8_STAGE(PG8_SA(0, 0), a2, voffA);
            PG8_WAIT_V(8); PG8_WAIT_L(0); PG8_BAR; PG8_MMA(1, 0, At, B0); PG8_MMA(1, 1, At, B1); PG8_BAR; PG8_SCHED;
            PG8_LDB(B0, 1, 0); PG8_LDB(B1, 1, 1); PG8_SCHED; PG8_LDA(At, 1, 0); PG8_STAGE(PG8_SA(0, 1), a2 + hstep, voffA);
            PG8_WAIT_V(8); PG8_WAIT_L(0); PG8_BAR; PG8_MMA(0, 0, At, B0); PG8_MMA(0, 1, At, B1); PG8_BAR; PG8_SCHED;
            PG8_LDA(At, 1, 1); PG8_STAGE(PG8_SB(1, 0), b3, voffB); PG8_STAGE(PG8_SB(1, 1), b3 + hstep, voffB); PG8_STAGE(PG8_SA(1, 0), a3, voffA);
            PG8_WAIT_V(8); PG8_WAIT_L(0); PG8_BAR; PG8_MMA(1, 0, At, B0); PG8_MMA(1, 1, At, B1); PG8_BAR; PG8_SCHED;
            } else {
            PG8_LDB(B0, 0, 0); PG8_SCHED; PG8_LDA(At, 0, 0); PG8_STAGE(PG8_SA(1, 1), a1 + hstep, voffA);
            PG8_WAIT_L(8); PG8_BAR; PG8_WAIT_L(0); PG8_MMA(0, 0, At, B0); PG8_BAR; PG8_SCHED;
            PG8_LDB(B1, 0, 1); PG8_STAGE(PG8_SB(0, 0), b2, voffB);
            PG8_BAR; PG8_WAIT_L(0); PG8_MMA(0, 1, At, B1); PG8_BAR;
            PG8_LDA(At, 0, 1); PG8_STAGE(PG8_SA(0, 0), a2, voffA);
            PG8_BAR; PG8_WAIT_L(0); PG8_MMA(1, 0, At, B0); PG8_BAR; PG8_SCHED;
            PG8_STAGE(PG8_SB(0, 1), b2 + hstep, voffB);
            PG8_WAIT_V(6); PG8_BAR; PG8_MMA(1, 1, At, B1); PG8_BAR;
            PG8_LDB(B0, 1, 0); PG8_SCHED; PG8_LDA(At, 1, 0); PG8_STAGE(PG8_SA(0, 1), a2 + hstep, voffA);
            PG8_WAIT_L(8); PG8_BAR; PG8_WAIT_L(0); PG8_MMA(0, 0, At, B0); PG8_BAR; PG8_SCHED;
            PG8_LDB(B1, 1, 1); PG8_STAGE(PG8_SB(1, 0), b3, voffB);
            PG8_BAR; PG8_WAIT_L(0); PG8_MMA(0, 1, At, B1); PG8_BAR;
            PG8_LDA(At, 1, 1); PG8_STAGE(PG8_SA(1, 0), a3, voffA);
            PG8_BAR; PG8_WAIT_L(0); PG8_MMA(1, 0, At, B0); PG8_BAR; PG8_SCHED;
            PG8_STAGE(PG8_SB(1, 1), b3 + hstep, voffB);
            PG8_WAIT_V(6); PG8_BAR; PG8_MMA(1, 1, At, B1); PG8_BAR;
            }
        }
        if constexpr (ALIGN_EPI) { if (wr == 0) PG8_BAR; }
        if constexpr (!Epi::AFTER_DRAIN) { E(acc, cur, wr, wc, fr, fq); S.done(cur); }
        if (!has_next) break;
#pragma unroll
        for (int a = 0; a < 2; ++a)
#pragma unroll
            for (int b = 0; b < 2; ++b)
#pragma unroll
                for (int m = 0; m < 4; ++m)
#pragma unroll
                    for (int n = 0; n < 2; ++n) acc[a][b][m][n] = (f32x4){0.f, 0.f, 0.f, 0.f};
        cur = nxt; cA = nA; cB = nB; ++ui;
        if constexpr (ALIGN_EPI) { if (wr == 1) PG8_BAR; }
    }
    PG8_WAIT_V(0);
    if constexpr (!ALIGN_EPI) { if (wr == 0) PG8_BAR; }
    PG8_BAR;
    if constexpr (Epi::AFTER_DRAIN) { E.fused(acc, cur, wr, wc, fr, fq, lds, wid, lane); S.done(cur); }
#undef PG8_SA
#undef PG8_SB
#undef PG8_STAGE
#undef PG8_LDA
#undef PG8_LDB
#undef PG8_MMA
#undef PG8_WAIT_V
#undef PG8_WAIT_L
#undef PG8_BAR
#undef PG8_SCHED
}
}

#define LAS __attribute__((address_space(3)))
typedef unsigned short bf16_t;
typedef short bf16x8 __attribute__((ext_vector_type(8)));
typedef short s16x4 __attribute__((ext_vector_type(4)));
typedef float f32x2 __attribute__((ext_vector_type(2)));
typedef float f32x4 __attribute__((ext_vector_type(4)));
typedef float f32x16 __attribute__((ext_vector_type(16)));
typedef unsigned u32x2 __attribute__((ext_vector_type(2)));
typedef unsigned u32x4 __attribute__((ext_vector_type(4)));
using pg8::cvt_pk_bf16; using pg8::pack8; using pg8::unpack8; using pg8::sumsq4; using pg8::sigm;
#define LDS_WAIT() asm volatile("s_waitcnt lgkmcnt(0)" ::: "memory")
__device__ __forceinline__ float bf2f(unsigned short b) { return __uint_as_float((unsigned)b << 16); }
__device__ __forceinline__ unsigned short f2bf(float f) { return (unsigned short)(cvt_pk_bf16(f, 0.f) & 0xffffu); }
__device__ __forceinline__ float wave_sum(float v) {
#pragma unroll
    for (int o = 1; o < 64; o <<= 1) v += __shfl_xor(v, o);
    return v;
}

constexpr size_t MiB = 1u << 20;
constexpr size_t WS_CTL = 0, CTL_ZERO_BYTES = 64 * 1024;
constexpr size_t WS_LB = 1 * MiB;
constexpr size_t WS_K1B = WS_LB + 64 * 1024;
constexpr size_t WS_K2B = WS_K1B + 64 * 1024;
constexpr size_t WS_SSQQ = 2 * MiB;
constexpr size_t WS_SSQKV = WS_SSQQ + 256 * 1024;
constexpr size_t WS_SSQ2 = WS_SSQKV + 256 * 1024;
constexpr size_t WS_SSQ1 = 3 * MiB;
constexpr size_t WS_SSQ3 = 4 * MiB;
constexpr size_t WS_DECAY = 5 * MiB;
constexpr size_t WS_CS = 6 * MiB;
constexpr size_t WS_EIDX = 8 * MiB;
constexpr size_t WS_GATE = 12 * MiB;
constexpr size_t WS_WUQT = 16 * MiB, WS_WUKVT = 18 * MiB, WS_WAT = 20 * MiB, WS_WBT = 24 * MiB, WS_WOT = 28 * MiB, WS_WQT = 36 * MiB, WS_WPGT = 44 * MiB, WS_WPET = 52 * MiB, WS_PBF = 53 * MiB;
constexpr size_t WS_WINT = 58 * MiB;
constexpr size_t WS_SPT = 58 * MiB;
constexpr size_t WS_ACTA = 96 * MiB;
constexpr size_t WS_GA = 128 * MiB, WS_GB = 160 * MiB;
constexpr size_t WS_QP = WS_GA, WS_PE = WS_GB;
constexpr size_t WS_HQ = 192 * MiB, WS_F = 208 * MiB, WS_HV = 240 * MiB, WS_HOG = 256 * MiB, WS_Q = 272 * MiB, WS_K = 296 * MiB, WS_V = 320 * MiB;
constexpr size_t WS_U8 = 192 * MiB, WS_V8 = 224 * MiB;
constexpr size_t WS_SU = 1 * MiB + 256 * 1024, WS_SV = WS_SU + 64 * 1024;
constexpr size_t WS_MQG = 336 * MiB, WS_MKVG = 344 * MiB, WS_OB = 336 * MiB;
constexpr size_t WS_DST = 352 * MiB;
constexpr size_t WS_OA = 416 * MiB, WS_YB = 432 * MiB, WS_Y = 464 * MiB, WS_END = 496 * MiB;
constexpr size_t WS_X2 = 432 * MiB;

#define XB_TMO      128
#define XB_XCNT(j)  (256  + 64 * (j))
#define XB_XSUB(j)  (1280 + 64 * (j))
#define XB_XGEN(j)  (2304 + 64 * (j))
#define XB_TOP      3328
#define XB_TOPGEN   3392
#define XCD_BAR_WORDS 3456
#define XB_SPIN_CAP (1u << 18)

__device__ __forceinline__ unsigned xb_ld(unsigned* p)              { return __hip_atomic_load(p, __ATOMIC_RELAXED, __HIP_MEMORY_SCOPE_AGENT); }
__device__ __forceinline__ unsigned xb_add(unsigned* p, unsigned v) { return __hip_atomic_fetch_add(p, v, __ATOMIC_RELAXED, __HIP_MEMORY_SCOPE_AGENT); }
__device__ __forceinline__ unsigned xb_xcc_id() { return (unsigned)__builtin_amdgcn_s_getreg((3 << 11) | 20) & 0xFu; }
#define XB_SPIN(cond, bar) do { unsigned _sp = 0; while (cond) { __builtin_amdgcn_s_sleep(1); \
    if ((++_sp & 255u) == 0u) { if (xb_ld(&(bar)[XB_TMO])) break; if (_sp > XB_SPIN_CAP) { atomicAdd(&(bar)[XB_TMO], 1u); break; } } } } while (0)

struct XcdBarrier {
    unsigned* bar; unsigned x;
    volatile LAS unsigned* st;
};

__device__ __forceinline__ XcdBarrier xcd_barrier_post(unsigned* bar, volatile LAS unsigned* st) {
    XcdBarrier b; b.bar = bar; b.x = xb_xcc_id(); b.st = st;
    if (threadIdx.x == 0) (void)xb_add(&bar[XB_XCNT(b.x)], 1u);
    return b;
}
__device__ __forceinline__ void xcd_barrier_complete(unsigned* bar, unsigned x, unsigned& nloc, unsigned& nx) {
    const unsigned G = gridDim.x * gridDim.y * gridDim.z;
    unsigned sum, cnt, mine, sp = 0u;
    for (;;) {
        sum = 0u; cnt = 0u; mine = 0u;
#pragma unroll
        for (unsigned j = 0; j < 16; ++j) { const unsigned c = xb_ld(&bar[XB_XCNT(j)]); sum += c; cnt += (c > 0u) ? 1u : 0u; mine = (j == x) ? c : mine; }
        if (sum == G) break;
        __builtin_amdgcn_s_sleep(1);
        if ((++sp & 255u) == 0u) { if (xb_ld(&bar[XB_TMO])) break; if (sp > XB_SPIN_CAP) { atomicAdd(&bar[XB_TMO], 1u); break; } }
    }
    nloc = mine > 0u ? mine : 1u; nx = cnt > 0u ? cnt : 1u;
}

__device__ __forceinline__ void xcd_barrier(const XcdBarrier& b) {
    asm volatile("s_waitcnt vmcnt(0)" ::: "memory");
    __syncthreads();
    if (threadIdx.x == 0) {
        unsigned* bar = b.bar;
        __builtin_amdgcn_s_waitcnt(0);
        unsigned nloc = b.st[0], nx = b.st[1];
        if (nloc == 0u) { xcd_barrier_complete(bar, b.x, nloc, nx); b.st[0] = nloc; b.st[1] = nx; }
        const unsigned old = xb_add(&bar[XB_XSUB(b.x)], 1u);
        const unsigned gen = old / nloc;
        if (old + 1u == (gen + 1u) * nloc) {
            __builtin_amdgcn_fence(__ATOMIC_RELEASE, "agent");
            asm volatile("s_waitcnt vmcnt(0)" ::: "memory");
            const unsigned og = xb_add(&bar[XB_TOP], 1u);
            const unsigned tg = og / nx;
            if (og + 1u == (tg + 1u) * nx) xb_add(&bar[XB_TOPGEN], 1u);
            else XB_SPIN(xb_ld(&bar[XB_TOPGEN]) == tg, bar);
            __builtin_amdgcn_fence(__ATOMIC_ACQUIRE, "agent");
            xb_add(&bar[XB_XGEN(b.x)], 1u);
            asm volatile("s_waitcnt vmcnt(0)" ::: "memory");
        } else {
            XB_SPIN(xb_ld(&bar[XB_XGEN(b.x)]) == gen, bar);
            __builtin_amdgcn_fence(__ATOMIC_ACQUIRE, "agent");
            asm volatile("s_waitcnt vmcnt(0)" ::: "memory");
        }
    }
    __syncthreads();
}

struct Ctx { LAS unsigned char* lds; int tid, lane, wave, G, bid; float* out; unsigned char* ws; };
__device__ __forceinline__ const void* karg_ptr(int i) { return ((const void* const __attribute__((address_space(4)))*)__builtin_amdgcn_kernarg_segment_ptr())[i]; }
#define IP(i) ((const float*)karg_ptr(i))
#define WSP(type, off) ((type*)(C.ws + (off)))

__device__ __forceinline__ int ilv64(int i) { return i < 32 ? 2 * i : 2 * (i - 32) + 1; }
template <int MAP> __device__ __forceinline__ int colmap(int n) {
    if (MAP == 1) { if (n < 5120) return n; if (n < 5184) return 9216 + ilv64(n - 5120); return n - 64; }
    if (MAP == 2) { const int h = n / MQK, d = n - h * MQK; return d < MNOPE ? n : h * MQK + MNOPE + ilv64(d - MNOPE); }
    return n;
}
template <int MAP> __device__ __forceinline__ void p0_transpose_item(const float* W, int K, int N, bf16_t* WT, LAS float* scr, int item, int lane) {
    const int nblk = N / 32, kb = item / nblk, nb = item % nblk, k0 = 64 * kb, n0 = 32 * nb;
#pragma unroll 8
    for (int i = 0; i < 32; ++i) { const int kk = 2 * i + (lane >> 5); scr[kk * 33 + (lane & 31)] = W[(size_t)(k0 + kk) * N + n0 + (lane & 31)]; }
    LDS_WAIT(); asm volatile("" ::: "memory");
    const int c = lane & 7;
#pragma unroll
    for (int j = 0; j < 4; ++j) { const int n = (lane >> 3) + 8 * j; const LAS float* s = scr + (8 * c) * 33 + n;
        u32x4 o; o.x = cvt_pk_bf16(s[0 * 33], s[1 * 33]); o.y = cvt_pk_bf16(s[2 * 33], s[3 * 33]); o.z = cvt_pk_bf16(s[4 * 33], s[5 * 33]); o.w = cvt_pk_bf16(s[6 * 33], s[7 * 33]);
        *(u32x4*)(WT + (size_t)colmap<MAP>(n0 + n) * K + k0 + 8 * c) = o; }
    LDS_WAIT(); asm volatile("" ::: "memory");
}
__device__ __forceinline__ void rms_row_to_bf16(const float* xrow, const float* gain, bf16_t* orow, int lane) {
    const f32x4* xr = (const f32x4*)xrow + lane; const f32x4* gr = (const f32x4*)gain + lane;
    f32x4 v[8]; float s = 0.f;
#pragma unroll
    for (int j = 0; j < 8; ++j) { v[j] = xr[64 * j]; s += sumsq4(v[j]); }
    const float rs = __builtin_amdgcn_rsqf(wave_sum(s) * (1.0f / DM) + EPS);
    u32x2* o8 = (u32x2*)orow + lane;
#pragma unroll
    for (int j = 0; j < 8; ++j) { const f32x4 y = v[j] * rs * gr[64 * j]; u32x2 w; w.x = cvt_pk_bf16(y[0], y[1]); w.y = cvt_pk_bf16(y[2], y[3]); o8[64 * j] = w; }
}
__device__ __forceinline__ void cvt_copy(const float* src, bf16_t* dst, size_t n, size_t gtid, size_t nthr) {
    for (size_t i = gtid; i < n / 8; i += nthr) { const f32x4 a = ((const f32x4*)src)[2 * i], b = ((const f32x4*)src)[2 * i + 1]; ((u32x4*)dst)[i] = pack8(a, b); }
}

__device__ __forceinline__ void phase_prep(const Ctx& C) {
    LAS float* scr = (LAS float*)(C.lds + C.wave * 16384);
    const int gw = C.bid * 8 + C.wave, NGW = C.G * 8;
    constexpr int I_IN = (DM / 64) * (INW / 32), I_UQ = (MQL / 64) * (MH * MQK / 32), I_UKV = (MKVL / 64) * (2048 / 32), I_A = (HGW / 64) * (DM / 32), I_O = (DM / 64) * (DM / 32), I_PE = (PLE / 64) * (DM / 32);
    constexpr int NITEMS = I_IN + I_UQ + I_UKV + 2 * I_A + 3 * I_O + I_PE;
    for (int it = gw; it < NITEMS; it += NGW) {
        int r = it;
        if (r < I_IN) { p0_transpose_item<1>(IP(4), DM, INW, WSP(bf16_t, WS_WINT), scr, r, C.lane); continue; } r -= I_IN;
        if (r < I_UQ) { p0_transpose_item<2>(IP(9), MQL, MH * MQK, WSP(bf16_t, WS_WUQT), scr, r, C.lane); continue; } r -= I_UQ;
        if (r < I_UKV) { p0_transpose_item<0>(IP(10), MKVL, 2048, WSP(bf16_t, WS_WUKVT), scr, r, C.lane); continue; } r -= I_UKV;
        if (r < I_A) { p0_transpose_item<0>(IP(11), HGW, DM, WSP(bf16_t, WS_WAT), scr, r, C.lane); continue; } r -= I_A;
        if (r < I_A) { p0_transpose_item<0>(IP(12), HGW, DM, WSP(bf16_t, WS_WBT), scr, r, C.lane); continue; } r -= I_A;
        if (r < I_O) { p0_transpose_item<0>(IP(13), DM, DM, WSP(bf16_t, WS_WOT), scr, r, C.lane); continue; } r -= I_O;
        if (r < I_O) { p0_transpose_item<0>(IP(15), DM, DM, WSP(bf16_t, WS_WQT), scr, r, C.lane); continue; } r -= I_O;
        if (r < I_O) { p0_transpose_item<0>(IP(21), DM, DM, WSP(bf16_t, WS_WPGT), scr, r, C.lane); continue; } r -= I_O;
        p0_transpose_item<0>(IP(22), PLE, DM, WSP(bf16_t, WS_WPET), scr, r, C.lane);
    }
    for (int m = gw; m < T; m += NGW) rms_row_to_bf16(IP(0) + (size_t)m * DM, IP(3), WSP(bf16_t, WS_ACTA) + (size_t)m * DM, C.lane);
    const size_t gtid = (size_t)C.bid * 512 + C.tid, nthr = (size_t)C.G * 512;
    { u32x4* z = (u32x4*)(WSP(bf16_t, WS_WINT) + (size_t)INW * DM); for (size_t i = gtid; i < (size_t)(INW_PAD - INW) * DM / 8; i += nthr) z[i] = (u32x4){0u, 0u, 0u, 0u}; }
    cvt_copy(IP(1), WSP(bf16_t, WS_PBF), (size_t)T * PLE, gtid, nthr);
    cvt_copy(IP(16), WSP(bf16_t, WS_K1B), (size_t)PNK * 128, gtid, nthr);
    cvt_copy(IP(17), WSP(bf16_t, WS_K2B), (size_t)PNK * 128, gtid, nthr);
    for (size_t i = gtid; i < HGW; i += nthr) WSP(float, WS_LB)[i] = 1.0f / (1.0f + __expf(IP(5)[HGW + i] - IP(5)[i]));
    for (size_t e = gtid; e < (size_t)T * 32; e += nthr) { const int t = (int)(e >> 5), i = (int)(e & 31);
        double fr = 1.0; for (int k = 0; k < i; ++k) fr *= 0.74989420933245582;
        const float ang = (float)((const int*)karg_ptr(2))[t] * (float)fr; const double rev = (double)ang * 0.15915494309189535; const float fx = (float)(rev - floor(rev));
        WSP(f32x2, WS_CS)[e] = (f32x2){__builtin_amdgcn_cosf(fx), __builtin_amdgcn_sinf(fx)}; }
}

__device__ __forceinline__ void hgrn_cumsum(const Ctx& C, int h, int n, float (&fv)[16], float (&bb)[16], float& b_ref, float& b_last, LAS float* TOT) {
    const int d = C.tid & 127, rg = C.tid >> 7; const float* F = WSP(float, WS_F) + ((size_t)(n * HGC + rg * 16)) * HGW + h * HGD + d;
    float run = 0.f;
#pragma unroll
    for (int i = 0; i < 16; ++i) { fv[i] = F[(size_t)i * HGW]; run += __logf(fv[i]); bb[i] = run; }
    TOT[rg * 128 + d] = run; LDS_WAIT(); __syncthreads();
    const float t0 = TOT[d], t1 = TOT[128 + d], t2 = TOT[256 + d], t3 = TOT[384 + d];
    const float off = rg == 0 ? 0.f : rg == 1 ? t0 : rg == 2 ? t0 + t1 : (t0 + t1) + t2;
    b_ref = t0 + t1; b_last = ((t0 + t1) + t2) + t3;
#pragma unroll
    for (int i = 0; i < 16; ++i) bb[i] += off;
}
constexpr int HG_KDT = 0, HG_VT = 18432, HG_TOT = 36864;
__device__ __forceinline__ void hgrn_a_unit(const Ctx& C, int h, int n) {
    LAS bf16_t* KDT = (LAS bf16_t*)(C.lds + HG_KDT); LAS bf16_t* VT = (LAS bf16_t*)(C.lds + HG_VT); LAS float* TOT = (LAS float*)(C.lds + HG_TOT);
    const int d = C.tid & 127, rg = C.tid >> 7;
    float fv[16], bb[16], b_ref, b_last; hgrn_cumsum(C, h, n, fv, bb, b_ref, b_last, TOT);
    const bf16_t* HVp = WSP(bf16_t, WS_HV) + ((size_t)(n * HGC + rg * 16)) * HGW + h * HGD + d;
#pragma unroll
    for (int g = 0; g < 2; ++g) { float kd[8], vv[8];
#pragma unroll
        for (int i = 0; i < 8; ++i) { const int r = g * 8 + i; kd[i] = (1.0f - fv[r]) * __expf(b_last - bb[r]); vv[i] = bf2f(HVp[(size_t)r * HGW]); }
        u32x4 wk, wv; wk.x = cvt_pk_bf16(kd[0], kd[1]); wk.y = cvt_pk_bf16(kd[2], kd[3]); wk.z = cvt_pk_bf16(kd[4], kd[5]); wk.w = cvt_pk_bf16(kd[6], kd[7]);
        wv.x = cvt_pk_bf16(vv[0], vv[1]); wv.y = cvt_pk_bf16(vv[2], vv[3]); wv.z = cvt_pk_bf16(vv[4], vv[5]); wv.w = cvt_pk_bf16(vv[6], vv[7]);
        *(LAS u32x4*)(KDT + d * 72 + rg * 16 + g * 8) = wk; *(LAS u32x4*)(VT + d * 72 + rg * 16 + g * 8) = wv; }
    if (rg == 0) WSP(float, WS_DECAY)[((size_t)h * HGNC + n) * HGD + d] = __expf(b_last);
    LDS_WAIT(); __syncthreads();
    const int fr = C.lane & 15, fq = C.lane >> 4, w = C.wave;
    bf16x8 bfr[2];
#pragma unroll
    for (int ks = 0; ks < 2; ++ks) bfr[ks] = *(const LAS bf16x8*)(VT + (16 * w + fr) * 72 + 8 * fq + 32 * ks);
    float* DST = WSP(float, WS_DST) + (((size_t)h * HGNC + n) * HGD + 16 * w + fr) * HGD;
#pragma unroll
    for (int mt = 0; mt < 8; ++mt) { f32x4 acc = {0.f, 0.f, 0.f, 0.f};
#pragma unroll
        for (int ks = 0; ks < 2; ++ks) { const bf16x8 a = *(const LAS bf16x8*)(KDT + (16 * mt + fr) * 72 + 8 * fq + 32 * ks); acc = __builtin_amdgcn_mfma_f32_16x16x32_bf16(a, bfr[ks], acc, 0, 0, 0); }
        *(f32x4*)(DST + 16 * mt + 4 * fq) = acc; }
    LDS_WAIT(); __syncthreads();
}
__device__ __forceinline__ void hgrn_scan(const Ctx& C) {
    const float* DST = WSP(float, WS_DST); const float* DEC = WSP(float, WS_DECAY); bf16_t* SPT = WSP(bf16_t, WS_SPT);
    for (int e = C.bid * 512 + C.tid; e < HGH * HGD * HGD; e += C.G * 512) {
        const int h = e >> 14, dv = (e >> 7) & 127, dk = e & 127; float S = 0.f;
        const size_t base = ((size_t)h * HGNC * HGD + dv) * HGD + dk; const size_t dbase = (size_t)h * HGNC * HGD + dk;
#pragma unroll 8
        for (int n = 0; n < HGNC; ++n) { SPT[base + (size_t)n * HGD * HGD] = f2bf(S); S = DEC[dbase + (size_t)n * HGD] * S + DST[base + (size_t)n * HGD * HGD]; }
    }
}
constexpr int HC_QIN = 0, HC_KIN = 17408, HC_QE = 34816, HC_VT = 52224, HC_AQ = 70656, HC_TOT = 79872, HC_OL = 81920;
__device__ __forceinline__ void hgrn_c_unit(const Ctx& C, int h, int n) {
    LAS bf16_t* QIN = (LAS bf16_t*)(C.lds + HC_QIN); LAS bf16_t* KIN = (LAS bf16_t*)(C.lds + HC_KIN); LAS bf16_t* QE = (LAS bf16_t*)(C.lds + HC_QE);
    LAS bf16_t* VT = (LAS bf16_t*)(C.lds + HC_VT); LAS bf16_t* AQ = (LAS bf16_t*)(C.lds + HC_AQ); LAS float* TOT = (LAS float*)(C.lds + HC_TOT); LAS float* OL = (LAS float*)(C.lds + HC_OL);
    const int d = C.tid & 127, rg = C.tid >> 7;
    float fv[16], bb[16], b_ref, b_last; hgrn_cumsum(C, h, n, fv, bb, b_ref, b_last, TOT);
    const size_t gro = ((size_t)(n * HGC + rg * 16)) * HGW + h * HGD + d; const bf16_t* HVp = WSP(bf16_t, WS_HV) + gro; const bf16_t* HQp = WSP(bf16_t, WS_HQ) + gro;
#pragma unroll
    for (int g = 0; g < 2; ++g) { float vv[8];
#pragma unroll
        for (int i = 0; i < 8; ++i) { const int r = g * 8 + i, c = rg * 16 + r; const float q = bf2f(HQp[(size_t)r * HGW]), k = 1.0f - fv[r];
            QIN[c * 136 + d] = f2bf(q * __expf(bb[r] - b_ref)); KIN[c * 136 + d] = f2bf(k * __expf(b_ref - bb[r])); QE[c * 136 + d] = f2bf(q * __expf(bb[r])); vv[i] = bf2f(HVp[(size_t)r * HGW]); }
        u32x4 wv; wv.x = cvt_pk_bf16(vv[0], vv[1]); wv.y = cvt_pk_bf16(vv[2], vv[3]); wv.z = cvt_pk_bf16(vv[4], vv[5]); wv.w = cvt_pk_bf16(vv[6], vv[7]);
        *(LAS u32x4*)(VT + d * 72 + rg * 16 + g * 8) = wv; }
    LDS_WAIT(); __syncthreads();
    const int fr = C.lane & 15, fq = C.lane >> 4, w = C.wave;
    { const int mt = w >> 1;
#pragma unroll
      for (int j = 0; j < 2; ++j) { const int nt = 2 * (w & 1) + j; f32x4 acc = {0.f, 0.f, 0.f, 0.f};
#pragma unroll
        for (int ks = 0; ks < 4; ++ks) { const bf16x8 a = *(const LAS bf16x8*)(QIN + (16 * mt + fr) * 136 + 8 * fq + 32 * ks), b = *(const LAS bf16x8*)(KIN + (16 * nt + fr) * 136 + 8 * fq + 32 * ks);
            acc = __builtin_amdgcn_mfma_f32_16x16x32_bf16(a, b, acc, 0, 0, 0); }
        const int s = 16 * nt + fr;
#pragma unroll
        for (int i = 0; i < 4; ++i) { const int c = 16 * mt + 4 * fq + i; AQ[c * 72 + s] = f2bf(s <= c ? acc[i] : 0.f); } } }
    LDS_WAIT(); __syncthreads();
    { bf16x8 bv[2], bs[4]; const bf16_t* SP = WSP(bf16_t, WS_SPT) + (((size_t)h * HGNC + n) * HGD + 16 * w + fr) * HGD;
#pragma unroll
      for (int ks = 0; ks < 2; ++ks) bv[ks] = *(const LAS bf16x8*)(VT + (16 * w + fr) * 72 + 8 * fq + 32 * ks);
#pragma unroll
      for (int ks = 0; ks < 4; ++ks) bs[ks] = *(const bf16x8*)(SP + 8 * fq + 32 * ks);
#pragma unroll
      for (int mt = 0; mt < 4; ++mt) { f32x4 acc = {0.f, 0.f, 0.f, 0.f};
#pragma unroll
        for (int ks = 0; ks < 2; ++ks) { const bf16x8 a = *(const LAS bf16x8*)(AQ + (16 * mt + fr) * 72 + 8 * fq + 32 * ks); acc = __builtin_amdgcn_mfma_f32_16x16x32_bf16(a, bv[ks], acc, 0, 0, 0); }
#pragma unroll
        for (int ks = 0; ks < 4; ++ks) { const bf16x8 a = *(const LAS bf16x8*)(QE + (16 * mt + fr) * 136 + 8 * fq + 32 * ks); acc = __builtin_amdgcn_mfma_f32_16x16x32_bf16(a, bs[ks], acc, 0, 0, 0); }
#pragma unroll
        for (int i = 0; i < 4; ++i) OL[(16 * mt + 4 * fq + i) * 132 + 16 * w + fr] = acc[i]; } }
    LDS_WAIT(); __syncthreads();
    { const int c = C.tid >> 3, j = C.tid & 7; f32x4 o[4]; float ss = 0.f;
#pragma unroll
      for (int i = 0; i < 4; ++i) { o[i] = *(const LAS f32x4*)(OL + c * 132 + 16 * j + 4 * i); ss += sumsq4(o[i]); }
      ss += __shfl_xor(ss, 1); ss += __shfl_xor(ss, 2); ss += __shfl_xor(ss, 4);
      const float rs = __builtin_amdgcn_rsqf(ss * (1.0f / HGD) + EPS); const size_t go = (size_t)(n * HGC + c) * HGW + h * HGD + 16 * j;
      const float* gn = IP(6) + h * HGD + 16 * j; const bf16_t* HOG = WSP(bf16_t, WS_HOG) + go; bf16_t* OA = WSP(bf16_t, WS_OA) + go;
#pragma unroll
      for (int i = 0; i < 2; ++i) { f32x4 s0, s1; unpack8(*(const u32x4*)(HOG + 8 * i), s0, s1);
          *(u32x4*)(OA + 8 * i) = pack8(o[2 * i] * rs * *(const f32x4*)(gn + 8 * i) * s0, o[2 * i + 1] * rs * *(const f32x4*)(gn + 8 * i + 4) * s1); } }
    LDS_WAIT(); __syncthreads();
}

constexpr int AT_K = 0, AT_KSTR = 400, AT_V = 25600, AT_MRG = 0, AT_MRG_STRIDE = 16384 + 256;
typedef short v4i16_t __attribute__((ext_vector_type(4)));
__device__ __forceinline__ s16x4 vtr(const LAS unsigned char* p) { return __builtin_bit_cast(s16x4, __builtin_amdgcn_ds_read_tr16_b64_v4i16((LAS v4i16_t*)p)); }
__device__ __forceinline__ int crow(int r, int hi) { return (r & 3) + 8 * (r >> 2) + 4 * hi; }
__device__ __forceinline__ void attn_unit(const Ctx& C, int h, int qb) {
    const int lane = C.lane, ql = lane & 31, hi = lane >> 5, kg = C.wave >> 2, qw = C.wave & 3, tid = C.tid;
    const int q0 = qb * 128, ntiles = 2 * (qb + 1), qpos = q0 + 32 * qw + ql;
    const bf16_t* Qp = WSP(bf16_t, WS_Q) + ((size_t)h * T + qpos) * MQK + 8 * hi; const bf16_t* Kp = WSP(bf16_t, WS_K) + (size_t)h * T * MQK; const bf16_t* Vp = WSP(bf16_t, WS_V) + (size_t)h * T * MV;
    bf16x8 qf[12];
#pragma unroll
    for (int ks = 0; ks < 12; ++ks) qf[ks] = *(const bf16x8*)(Qp + 16 * ks);
    float m_run = -1e30f, l_run = 0.f; f32x16 oT[4];
#pragma unroll
    for (int nb = 0; nb < 4; ++nb) oT[nb] = (f32x16){0.f, 0.f, 0.f, 0.f, 0.f, 0.f, 0.f, 0.f, 0.f, 0.f, 0.f, 0.f, 0.f, 0.f, 0.f, 0.f};
    const LAS unsigned char* kfrag = C.lds + AT_K + (32 * kg + ql) * AT_KSTR + 16 * hi;
    const LAS unsigned char* vfrag = C.lds + AT_V + (16 * kg) * 512 + (4 * hi + ((lane & 15) >> 2)) * 64 + ((lane >> 4) & 1) * 32 + (lane & 3) * 8;
    for (int j = 0; j < ntiles; ++j) {
        const int k0 = 64 * j;
        __syncthreads();
#pragma unroll
        for (int i = 0; i < 3; ++i) { const int cid = tid + 512 * i, r = cid / 24, cc = cid - r * 24; *(LAS u32x4*)(C.lds + AT_K + r * AT_KSTR + cc * 16) = *(const u32x4*)(Kp + (size_t)(k0 + r) * MQK + cc * 8); }
#pragma unroll
        for (int i = 0; i < 2; ++i) { const int cid = tid + 512 * i, r = cid >> 4, cc = cid & 15; *(LAS u32x4*)(C.lds + AT_V + ((r >> 3) * 4 + (cc >> 2)) * 512 + (r & 7) * 64 + (cc & 3) * 16) = *(const u32x4*)(Vp + (size_t)(k0 + r) * MV + cc * 8); }
        LDS_WAIT(); __syncthreads();
        const int kbase = k0 + 32 * kg;
        if (kbase <= q0 + 32 * qw + 31) {
            f32x16 st = (f32x16){0.f, 0.f, 0.f, 0.f, 0.f, 0.f, 0.f, 0.f, 0.f, 0.f, 0.f, 0.f, 0.f, 0.f, 0.f, 0.f};
#pragma unroll
            for (int ks = 0; ks < 12; ++ks) { const bf16x8 a = *(const LAS bf16x8*)(kfrag + 32 * ks); st = __builtin_amdgcn_mfma_f32_32x32x16_bf16(a, qf[ks], st, 0, 0, 0); }
            if (kbase + 31 > q0 + 32 * qw) {
#pragma unroll
                for (int r = 0; r < 16; ++r) if (kbase + crow(r, hi) > qpos) st[r] = -__builtin_inff();
            }
            float mx = st[0];
#pragma unroll
            for (int r = 1; r < 16; ++r) mx = fmaxf(mx, st[r]);
            mx = fmaxf(mx, __shfl_xor(mx, 32));
            const float m_new = fmaxf(m_run, mx), alpha = __builtin_amdgcn_exp2f(m_run - m_new); m_run = m_new;
            float ps = 0.f;
#pragma unroll
            for (int r = 0; r < 16; ++r) { st[r] = __builtin_amdgcn_exp2f(st[r] - m_new); ps += st[r]; }
            ps += __shfl_xor(ps, 32); l_run = l_run * alpha + ps;
#pragma unroll
            for (int nb = 0; nb < 4; ++nb) oT[nb] *= alpha;
            bf16x8 pf[2];
#pragma unroll
            for (int s2 = 0; s2 < 2; ++s2) { u32x4 w; w.x = cvt_pk_bf16(st[8 * s2 + 0], st[8 * s2 + 1]); w.y = cvt_pk_bf16(st[8 * s2 + 2], st[8 * s2 + 3]); w.z = cvt_pk_bf16(st[8 * s2 + 4], st[8 * s2 + 5]); w.w = cvt_pk_bf16(st[8 * s2 + 6], st[8 * s2 + 7]); pf[s2] = __builtin_bit_cast(bf16x8, w); }
#pragma unroll
            for (int nb = 0; nb < 4; ++nb)
#pragma unroll
                for (int s2 = 0; s2 < 2; ++s2) { const s16x4 lo = vtr(vfrag + (8 * s2) * 512 + nb * 512), hh = vtr(vfrag + (8 * s2 + 4) * 512 + nb * 512);
                    const bf16x8 vf = (bf16x8){lo[0], lo[1], lo[2], lo[3], hh[0], hh[1], hh[2], hh[3]};
                    oT[nb] = __builtin_amdgcn_mfma_f32_32x32x16_bf16(vf, pf[s2], oT[nb], 0, 0, 0); }
        }
    }
    __syncthreads();
    LAS float* MG = (LAS float*)(C.lds + AT_MRG + qw * AT_MRG_STRIDE);
    if (kg == 1) { if (hi == 0) { MG[2 * ql] = m_run; MG[2 * ql + 1] = l_run; }
#pragma unroll
        for (int nb = 0; nb < 4; ++nb)
#pragma unroll
            for (int r = 0; r < 16; ++r) MG[64 + (nb * 16 + r) * 64 + lane] = oT[nb][r]; }
    LDS_WAIT(); __syncthreads();
    if (kg == 0) { const float m2 = MG[2 * ql], l2 = MG[2 * ql + 1], mm = fmaxf(m_run, m2), a1 = __builtin_amdgcn_exp2f(m_run - mm), a2 = __builtin_amdgcn_exp2f(m2 - mm);
        const float inv = 1.0f / (a1 * l_run + a2 * l2); const float c1 = a1 * inv, c2 = a2 * inv;
        bf16_t* O = WSP(bf16_t, WS_OB) + (size_t)qpos * HGW + h * MV + 4 * hi;
#pragma unroll
        for (int nb = 0; nb < 4; ++nb)
#pragma unroll
            for (int g = 0; g < 4; ++g) { float o[4];
#pragma unroll
                for (int i = 0; i < 4; ++i) { const int r = 4 * g + i; o[i] = c1 * oT[nb][r] + c2 * MG[64 + (nb * 16 + r) * 64 + lane]; }
                u32x2 w; w.x = cvt_pk_bf16(o[0], o[1]); w.y = cvt_pk_bf16(o[2], o[3]); *(u32x2*)(O + 32 * nb + 8 * g) = w; } }
    LDS_WAIT();
}

constexpr int TK_KEY = 0, TK_SCR = 65536;
__device__ __forceinline__ int f2ord(float f) { const int i = __float_as_int(f); return i >= 0 ? i : (i ^ 0x7fffffff); }
__device__ __forceinline__ float ord2f(int k) { return __int_as_float(k >= 0 ? k : (k ^ 0x7fffffff)); }
__device__ __forceinline__ void topk_unit(const Ctx& C, int tb, int h) {
    const int lane = C.lane, fr = lane & 15, fq = lane >> 4, w = C.wave, t0 = tb * 64;
    LAS int* KEY = (LAS int*)(C.lds + TK_KEY);
    { const bf16_t* QP = WSP(bf16_t, WS_QP) + (size_t)t0 * DM + h * PQD;
#pragma unroll
      for (int half = 0; half < 2; ++half) { const bf16_t* KB = WSP(bf16_t, half ? WS_K2B : WS_K1B) + (16 * w + fr) * 128 + 8 * fq; bf16x8 b[4];
#pragma unroll
        for (int ks = 0; ks < 4; ++ks) b[ks] = *(const bf16x8*)(KB + 32 * ks);
#pragma unroll
        for (int mt = 0; mt < 4; ++mt) { f32x4 acc = {0.f, 0.f, 0.f, 0.f};
#pragma unroll
            for (int ks = 0; ks < 4; ++ks) { const bf16x8 a = *(const bf16x8*)(QP + (size_t)(16 * mt + fr) * DM + half * 128 + 8 * fq + 32 * ks); acc = __builtin_amdgcn_mfma_f32_16x16x32_bf16(a, b[ks], acc, 0, 0, 0); }
            const int key = 16 * w + fr;
#pragma unroll
            for (int i = 0; i < 4; ++i) KEY[((16 * mt + 4 * fq + i) * 2 + half) * 128 + key] = (f2ord(acc[i]) & ~127) | (127 - key); } } }
    LDS_WAIT(); __syncthreads();
    LAS int* TOP = (LAS int*)(C.lds + TK_SCR + 1024 * w); LAS int* CK = TOP + 32; LAS int* SELE = CK + 64; LAS float* SELV = (LAS float*)(SELE + 16);
    const int ca = (lane >= 16) + (lane >= 24) + (lane >= 29) + (lane >= 33) + (lane >= 36) + (lane >= 38) + (lane >= 40) + (lane >= 42) + (lane >= 43) + (lane >= 44) + (lane >= 45) + (lane >= 46) + (lane >= 47) + (lane >= 48) + (lane >= 49);
    const int cb = lane - (ca == 0 ? 0 : ca == 1 ? 16 : ca == 2 ? 24 : ca == 3 ? 29 : ca == 4 ? 33 : ca == 5 ? 36 : ca == 6 ? 38 : ca == 7 ? 40 : 42 + (ca - 8));
    for (int tt = 0; tt < 8; ++tt) { const int tl = w * 8 + tt, t = t0 + tl;
#pragma unroll
        for (int half = 0; half < 2; ++half) { const LAS int* row = KEY + (tl * 2 + half) * 128; const int own0 = row[lane], own1 = row[lane + 64]; int c0 = 0, c1 = 0;
#pragma unroll 8
            for (int jj = 0; jj < 32; ++jj) { const u32x4 kk = *(const LAS u32x4*)(row + 4 * jj);
                c0 += ((int)kk.x > own0) + ((int)kk.y > own0) + ((int)kk.z > own0) + ((int)kk.w > own0); c1 += ((int)kk.x > own1) + ((int)kk.y > own1) + ((int)kk.z > own1) + ((int)kk.w > own1); }
            if (c0 < 16) TOP[half * 16 + c0] = own0; if (c1 < 16) TOP[half * 16 + c1] = own1; }
        LDS_WAIT();
        int ka = 0, kb = 0, ck = (int)0x80000000; float cv = 0.f;
        if (lane < 50) { ka = TOP[ca]; kb = TOP[16 + cb]; cv = ord2f(ka & ~127) + ord2f(kb & ~127); ck = (f2ord(cv) & ~63) | (63 - lane); }
        CK[lane] = ck; LDS_WAIT();
        int rk = 0;
#pragma unroll
        for (int jj = 0; jj < 13; ++jj) { const u32x4 kk = *(const LAS u32x4*)(CK + 4 * jj); rk += ((int)kk.x > ck) + ((int)kk.y > ck) + ((int)kk.z > ck) + ((int)kk.w > ck); }
        if (lane < 50 && rk < 16) { SELE[rk] = (127 - (ka & 127)) * PNK + (127 - (kb & 127)); SELV[rk] = cv; }
        LDS_WAIT();
        if (lane < 16) { const f32x4 s0 = *(const f32x4*)(WSP(float, WS_SSQ1) + (size_t)t * 32 + 8 * (lane & 3)), s1 = *(const f32x4*)(WSP(float, WS_SSQ1) + (size_t)t * 32 + 8 * (lane & 3) + 4);
            float ss = (s0[0] + s0[1]) + (s0[2] + s0[3]) + (s1[0] + s1[1]) + (s1[2] + s1[3]); ss += __shfl_xor(ss, 1); ss += __shfl_xor(ss, 2);
            const float rs = __builtin_amdgcn_rsqf(ss * (1.0f / DM) + EPS);
            float ex = __expf((SELV[lane] - SELV[0]) * rs); float sm = ex; sm += __shfl_xor(sm, 1); sm += __shfl_xor(sm, 2); sm += __shfl_xor(sm, 4); sm += __shfl_xor(sm, 8);
            WSP(int, WS_EIDX)[(size_t)t * 128 + h * 16 + lane] = SELE[lane]; WSP(float, WS_GATE)[(size_t)t * 128 + h * 16 + lane] = ex / sm; }
        LDS_WAIT();
    }
    __syncthreads();
}

__device__ __forceinline__ void fp8_row(const float* src, unsigned char* dst, float* scale, int row, int lane) {
    const float* xr = src + (size_t)row * DM + 16 * lane; f32x4 v[8]; float am = 0.f;
#pragma unroll
    for (int j = 0; j < 2; ++j)
#pragma unroll
        for (int i = 0; i < 4; ++i) { v[4 * j + i] = *(const f32x4*)(xr + 1024 * j + 4 * i); am = fmaxf(am, fmaxf(fmaxf(fabsf(v[4 * j + i][0]), fabsf(v[4 * j + i][1])), fmaxf(fabsf(v[4 * j + i][2]), fabsf(v[4 * j + i][3])))); }
#pragma unroll
    for (int o = 1; o < 64; o <<= 1) am = fmaxf(am, __shfl_xor(am, o));
    const float sc = am > 0.f ? am * (1.0f / 240.0f) : 1.0f, inv = am > 0.f ? 240.0f / am : 1.0f;
    if (lane == 0) scale[row] = sc;
#pragma unroll
    for (int j = 0; j < 2; ++j) { u32x4 w;
#pragma unroll
        for (int i = 0; i < 4; ++i) { const f32x4 y = v[4 * j + i] * inv; int p = 0; p = __builtin_amdgcn_cvt_pk_fp8_f32(y[0], y[1], p, false); p = __builtin_amdgcn_cvt_pk_fp8_f32(y[2], y[3], p, true); w[i] = (unsigned)p; }
        *(u32x4*)(dst + (size_t)row * DM + 1024 * j + 16 * lane) = w; }
}
__device__ __forceinline__ float gelu_erf(float z) { return 0.5f * z * (1.0f + erff(z * 0.70710678118654752f)); }
__device__ __forceinline__ void peer_token(const Ctx& C, int t) {
    const int lane = C.lane; const float* xr = C.out + (size_t)t * DM + 16 * lane;
    f32x2 hn[16]; float ss = 0.f;
    { const float* gn = IP(14) + 16 * lane; f32x4 xv[8];
#pragma unroll
      for (int j = 0; j < 2; ++j)
#pragma unroll
        for (int i = 0; i < 4; ++i) { xv[4 * j + i] = *(const f32x4*)(xr + 1024 * j + 4 * i); ss += sumsq4(xv[4 * j + i]); }
      const float rs = __builtin_amdgcn_rsqf(wave_sum(ss) * (1.0f / DM) + EPS);
#pragma unroll
      for (int j = 0; j < 2; ++j)
#pragma unroll
        for (int i = 0; i < 4; ++i) { const f32x4 y = xv[4 * j + i] * rs * *(const f32x4*)(gn + 1024 * j + 4 * i); hn[8 * j + 2 * i] = (f32x2){y[0], y[1]}; hn[8 * j + 2 * i + 1] = (f32x2){y[2], y[3]}; } }
    const int e0 = WSP(int, WS_EIDX)[(size_t)t * 128 + lane], e1 = WSP(int, WS_EIDX)[(size_t)t * 128 + 64 + lane];
    const float g0 = WSP(float, WS_GATE)[(size_t)t * 128 + lane], g1 = WSP(float, WS_GATE)[(size_t)t * 128 + 64 + lane];
    const float su0 = WSP(float, WS_SU)[e0], su1 = WSP(float, WS_SU)[e1];
    const float gv0 = g0 * WSP(float, WS_SV)[e0], gv1 = g1 * WSP(float, WS_SV)[e1];
    f32x2 oa[16];
#pragma unroll
    for (int j = 0; j < 16; ++j) oa[j] = (f32x2){0.f, 0.f};
    const unsigned char* U = WSP(unsigned char, WS_U8) + 16 * lane; const unsigned char* V = WSP(unsigned char, WS_V8) + 16 * lane;
    constexpr int EB = 4;
    for (int eb = 0; eb < 128; eb += EB) {
        u32x4 uw[EB][2], vw[EB][2]; float z[EB], cf[EB], us[EB];
#pragma unroll
        for (int k = 0; k < EB; ++k) { const int ei = eb + k; const int e = ei < 64 ? __builtin_amdgcn_readlane(e0, ei) : __builtin_amdgcn_readlane(e1, ei - 64);
            us[k] = __int_as_float(ei < 64 ? __builtin_amdgcn_readlane(__float_as_int(su0), ei) : __builtin_amdgcn_readlane(__float_as_int(su1), ei - 64));
            cf[k] = __int_as_float(ei < 64 ? __builtin_amdgcn_readlane(__float_as_int(gv0), ei) : __builtin_amdgcn_readlane(__float_as_int(gv1), ei - 64));
#pragma unroll
            for (int j = 0; j < 2; ++j) { uw[k][j] = *(const u32x4*)(U + (size_t)e * DM + 1024 * j); vw[k][j] = *(const u32x4*)(V + (size_t)e * DM + 1024 * j); } }
#pragma unroll
        for (int k = 0; k < EB; ++k) { f32x2 s = {0.f, 0.f};
#pragma unroll
            for (int j = 0; j < 2; ++j)
#pragma unroll
                for (int i = 0; i < 4; ++i) { const int w = (int)uw[k][j][i]; s += __builtin_amdgcn_cvt_pk_f32_fp8(w, false) * hn[8 * j + 2 * i]; s += __builtin_amdgcn_cvt_pk_f32_fp8(w, true) * hn[8 * j + 2 * i + 1]; }
            z[k] = s.x + s.y; }
#pragma unroll
        for (int o = 1; o < 64; o <<= 1) {
#pragma unroll
            for (int k = 0; k < EB; ++k) z[k] += __shfl_xor(z[k], o); }
#pragma unroll
        for (int k = 0; k < EB; ++k) { const float a = gelu_erf(z[k] * us[k]) * cf[k];
#pragma unroll
            for (int j = 0; j < 2; ++j)
#pragma unroll
                for (int i = 0; i < 4; ++i) { const int w = (int)vw[k][j][i]; oa[8 * j + 2 * i] += __builtin_amdgcn_cvt_pk_f32_fp8(w, false) * a; oa[8 * j + 2 * i + 1] += __builtin_amdgcn_cvt_pk_f32_fp8(w, true) * a; } }
    }
    float s2 = 0.f; bf16_t* xg = WSP(bf16_t, WS_ACTA) + (size_t)t * DM + 16 * lane; float* x2r = WSP(float, WS_X2) + (size_t)t * DM + 16 * lane; const float* gp = IP(20) + 16 * lane;
#pragma unroll
    for (int j = 0; j < 2; ++j) { f32x4 r[4];
#pragma unroll
        for (int i = 0; i < 4; ++i) { const f32x4 o = {oa[8 * j + 2 * i].x, oa[8 * j + 2 * i].y, oa[8 * j + 2 * i + 1].x, oa[8 * j + 2 * i + 1].y}; r[i] = *(const f32x4*)(xr + 1024 * j + 4 * i) + o;
            *(f32x4*)(x2r + 1024 * j + 4 * i) = r[i]; s2 += sumsq4(r[i]); r[i] = r[i] * *(const f32x4*)(gp + 1024 * j + 4 * i); }
        *(u32x4*)(xg + 1024 * j) = pack8(r[0], r[1]); *(u32x4*)(xg + 1024 * j + 8) = pack8(r[2], r[3]); }
    s2 = wave_sum(s2); if (lane == 0) WSP(float, WS_SSQ2)[t] = s2;
}
__device__ __forceinline__ void final_row(const Ctx& C, int t) {
    const int lane = C.lane; float pz = lane < 32 ? WSP(float, WS_SSQ3)[(size_t)t * 32 + lane] : 0.f;
    const float rs = __builtin_amdgcn_rsqf(wave_sum(pz) * (1.0f / DM) + EPS);
    f32x4* xr = (f32x4*)(C.out + (size_t)t * DM) + lane; const f32x4* gr = (const f32x4*)IP(23) + lane;
#pragma unroll
    for (int j = 0; j < 8; ++j) xr[64 * j] = xr[64 * j] * rs * gr[64 * j];
}

constexpr int NPHASE = 12;
#ifndef MK_ONE_LAUNCH
#define MK_ONE_LAUNCH 1
#endif
constexpr int LDS_BYTES = 147456;
constexpr int MISC_OFF = 131072 + 320;
struct Args { const void* in[24]; float* out; unsigned char* ws; int ph_lo, ph_hi; };
#define GEMM_ALIGN true
#define GEMM_SP2 true

__global__ void __launch_bounds__(512, 2) mk_fwd(Args args) {
    extern __shared__ __attribute__((aligned(16))) unsigned char lds_raw[];
    Ctx C;
    C.lds = (LAS unsigned char*)lds_raw; C.tid = threadIdx.x; C.lane = C.tid & 63; C.wave = __builtin_amdgcn_readfirstlane(C.tid >> 6); C.G = gridDim.x; C.bid = blockIdx.x;
    C.out = (float*)karg_ptr(24); C.ws = (unsigned char*)karg_ptr(25);
    volatile LAS unsigned* MISC = (volatile LAS unsigned*)(C.lds + MISC_OFF);
    if (C.tid < 32) MISC[C.tid] = 0u;
    __syncthreads();
    const int lo = ((const int __attribute__((address_space(4)))*)__builtin_amdgcn_kernarg_segment_ptr())[52], hi = ((const int __attribute__((address_space(4)))*)__builtin_amdgcn_kernarg_segment_ptr())[53];
    const bool multi = (hi - lo) > 1;
    XcdBarrier bar; bar.bar = (unsigned*)(C.ws + WS_CTL) + 1024; bar.x = 0; bar.st = nullptr;
    if (multi) bar = xcd_barrier_post((unsigned*)(C.ws + WS_CTL) + 1024, MISC + 8);
    LAS unsigned char* L = C.lds;
    const int gw = C.bid * 8 + C.wave, NGW = C.G * 8;

    if (lo <= 0 && 0 < hi) {
 phase_prep(C);
    }
    if (lo <= 0 && 1 < hi) xcd_barrier(bar);
    if (lo <= 1 && 1 < hi) {
        pg8::Gemm g{WSP(bf16_t, WS_ACTA), WSP(bf16_t, WS_WINT), T, INW_PAD, DM}; pg8::StaticOrder S; S.init(T, INW_PAD, C.G, C.bid);
        pg8::EpiProj E{WSP(bf16_t, WS_HQ), WSP(bf16_t, WS_HV), WSP(bf16_t, WS_HOG), WSP(bf16_t, WS_MQG), WSP(bf16_t, WS_MKVG), WSP(bf16_t, WS_GA), WSP(bf16_t, WS_GB), WSP(bf16_t, WS_K),
                       WSP(float, WS_F), WSP(float, WS_SSQQ), WSP(float, WS_SSQKV), WSP(float, WS_LB), IP(7), IP(8), WSP(pg8::f32x2, WS_CS)};
        pg8::gemm_phase<pg8::EpiProj, pg8::StaticOrder, GEMM_ALIGN, GEMM_SP2>(L, g, S, E);

    }
    if (lo <= 1 && 2 < hi) xcd_barrier(bar);
    if (lo <= 2 && 2 < hi) {
        { pg8::Gemm g{WSP(bf16_t, WS_MQG), WSP(bf16_t, WS_WUQT), T, MH * MQK, MQL}; pg8::StaticOrder S; S.init(T, MH * MQK, C.G, C.bid);
          pg8::EpiQ E{WSP(bf16_t, WS_Q), WSP(float, WS_SSQQ), WSP(pg8::f32x2, WS_CS)};
          pg8::gemm_phase<pg8::EpiQ, pg8::StaticOrder, GEMM_ALIGN, GEMM_SP2>(L, g, S, E); }
        { pg8::Gemm g{WSP(bf16_t, WS_MKVG), WSP(bf16_t, WS_WUKVT), T, 2048, MKVL}; pg8::StaticOrder S; S.init(T, 2048, C.G, C.bid);
          pg8::EpiKV E{WSP(bf16_t, WS_K), WSP(bf16_t, WS_V), WSP(float, WS_SSQKV)};
          pg8::gemm_phase<pg8::EpiKV, pg8::StaticOrder, GEMM_ALIGN, GEMM_SP2>(L, g, S, E); }
        __syncthreads();
        for (int u = C.bid; u < HGH * HGNC; u += C.G) hgrn_a_unit(C, u >> 7, u & 127);

    }
    if (lo <= 2 && 3 < hi) xcd_barrier(bar);
    if (lo <= 3 && 3 < hi) {
        hgrn_scan(C);
        for (int pr = C.bid; pr < 256; pr += C.G) { const int h = pr >> 5, s = pr & 31; attn_unit(C, h, 63 - s); attn_unit(C, h, s); }

    }
    if (lo <= 3 && 4 < hi) xcd_barrier(bar);
    if (lo <= 4 && 4 < hi) {
        __syncthreads();
        for (int u = C.bid; u < HGH * HGNC; u += C.G) hgrn_c_unit(C, u >> 7, u & 127);
        __syncthreads();
        pg8::Gemm g{WSP(bf16_t, WS_OB), WSP(bf16_t, WS_WBT), T, DM, HGW}; pg8::StaticOrder S; S.init(T, DM, C.G, C.bid);
        pg8::EpiYb E{WSP(bf16_t, WS_GB), WSP(bf16_t, WS_YB)};
        pg8::gemm_phase<pg8::EpiYb, pg8::StaticOrder, GEMM_ALIGN, GEMM_SP2>(L, g, S, E);

    }
    if (lo <= 4 && 5 < hi) xcd_barrier(bar);
    if (lo <= 5 && 5 < hi) {
        for (int r = gw; r < 2 * PNK * PNK; r += NGW) { if (r < PNK * PNK) fp8_row(IP(18), WSP(unsigned char, WS_U8), WSP(float, WS_SU), r, C.lane); else fp8_row(IP(19), WSP(unsigned char, WS_V8), WSP(float, WS_SV), r - PNK * PNK, C.lane); }
        pg8::Gemm g{WSP(bf16_t, WS_OA), WSP(bf16_t, WS_WAT), T, DM, HGW}; pg8::StaticOrder S; S.init(T, DM, C.G, C.bid);
        pg8::EpiY E{WSP(bf16_t, WS_GA), WSP(bf16_t, WS_YB), WSP(bf16_t, WS_Y)};
        pg8::gemm_phase<pg8::EpiY, pg8::StaticOrder, GEMM_ALIGN, GEMM_SP2>(L, g, S, E);

    }
    if (lo <= 5 && 6 < hi) xcd_barrier(bar);
    if (lo <= 6 && 6 < hi) {
        pg8::Gemm g{WSP(bf16_t, WS_Y), WSP(bf16_t, WS_WOT), T, DM, DM}; pg8::StaticOrder S; S.init(T, DM, C.G, C.bid);
        pg8::EpiX1 E{IP(0), IP(14), C.out, WSP(float, WS_SSQ1), WSP(bf16_t, WS_ACTA)};
        pg8::gemm_phase<pg8::EpiX1, pg8::StaticOrder, GEMM_ALIGN, GEMM_SP2>(L, g, S, E);

    }
    if (lo <= 6 && 7 < hi) xcd_barrier(bar);
    if (lo <= 7 && 7 < hi) {
        { pg8::Gemm g{WSP(bf16_t, WS_ACTA), WSP(bf16_t, WS_WQT), T, DM, DM}; pg8::StaticOrder S; S.init(T, DM, C.G, C.bid);
          pg8::EpiPlain E{WSP(bf16_t, WS_QP), DM};
          pg8::gemm_phase<pg8::EpiPlain, pg8::StaticOrder, GEMM_ALIGN, GEMM_SP2>(L, g, S, E); }
        { pg8::Gemm g{WSP(bf16_t, WS_PBF), WSP(bf16_t, WS_WPET), T, DM, PLE}; pg8::StaticOrder S; S.init(T, DM, C.G, C.bid);
          pg8::EpiPlain E{WSP(bf16_t, WS_PE), DM};
          pg8::gemm_phase<pg8::EpiPlain, pg8::StaticOrder, GEMM_ALIGN, GEMM_SP2>(L, g, S, E); }

    }
    if (lo <= 7 && 8 < hi) xcd_barrier(bar);
    if (lo <= 8 && 8 < hi) {
        __syncthreads();
        for (int u = C.bid; u < (T / 64) * PH; u += C.G) topk_unit(C, u >> 3, u & 7);

    }
    if (lo <= 8 && 9 < hi) xcd_barrier(bar);
    if (lo <= 9 && 9 < hi) {
        for (int t = gw; t < T; t += NGW) peer_token(C, t);

    }
    if (lo <= 9 && 10 < hi) xcd_barrier(bar);
    if (lo <= 10 && 10 < hi) {
        pg8::Gemm g{WSP(bf16_t, WS_ACTA), WSP(bf16_t, WS_WPGT), T, DM, DM}; pg8::StaticOrder S; S.init(T, DM, C.G, C.bid);
        pg8::EpiPle E{WSP(bf16_t, WS_PE), WSP(float, WS_SSQ2), WSP(float, WS_X2), C.out, WSP(float, WS_SSQ3)};
        pg8::gemm_phase<pg8::EpiPle, pg8::StaticOrder, GEMM_ALIGN, GEMM_SP2>(L, g, S, E);

    }
    if (lo <= 10 && 11 < hi) xcd_barrier(bar);
    if (lo <= 11 && 11 < hi) {
 for (int t = gw; t < T; t += NGW) final_row(C, t);
    }
    if (lo <= 11 && 12 < hi) xcd_barrier(bar);
}

extern "C" void kernel_launch(void* const* d_in, const int* in_sizes, int n_in, void* d_out, int out_size, void* d_ws, size_t ws_size, hipStream_t stream) {
    static int grid = 0;
    if (grid == 0) {
        if (n_in != 24 || out_size != T * DM || ws_size < WS_END) { fprintf(stderr, "kernel_launch: unexpected shapes: n_in %d out %d ws %zu (need %zu)\n", n_in, out_size, ws_size, (size_t)WS_END); grid = -1; return; }
        int dev = 0, cus = 0;
        if (hipGetDevice(&dev) != hipSuccess || hipDeviceGetAttribute(&cus, hipDeviceAttributeMultiprocessorCount, dev) != hipSuccess) { grid = -1; return; }
        if (hipFuncSetAttribute((const void*)mk_fwd, hipFuncAttributeMaxDynamicSharedMemorySize, LDS_BYTES) != hipSuccess) { fprintf(stderr, "kernel_launch: hipFuncSetAttribute failed\n"); grid = -1; return; }
        (void)hipGetLastError();
        grid = cus;
    }
    if (grid < 0) return;
    (void)hipMemsetAsync((char*)d_ws + WS_CTL, 0, CTL_ZERO_BYTES, stream);
    Args a{};
    for (int i = 0; i < 24; ++i) a.in[i] = d_in[i];
    a.out = (float*)d_out; a.ws = (unsigned char*)d_ws;
#if MK_ONE_LAUNCH
    a.ph_lo = 0; a.ph_hi = NPHASE;
    hipLaunchKernelGGL(mk_fwd, dim3(grid), dim3(512), LDS_BYTES, stream, a);
#else
    for (int ph = 0; ph < NPHASE; ++ph) { a.ph_lo = ph; a.ph_hi = ph + 1; hipLaunchKernelGGL(mk_fwd, dim3(grid), dim3(512), LDS_BYTES, stream, a); }
#endif
}
```

```cpp
#include <hip/hip_runtime.h>
#include <cstdio>
#include <cstdint>

constexpr int T = 8192, DM = 2048, PLE = 256;
constexpr int HGH = 8, HGD = 128, HGW = 1024, HGC = 64, HGNC = T / HGC;
constexpr int MH = 8, MNOPE = 128, MROPE = 64, MV = 128, MQL = 512, MKVL = 512, MQK = 192;
constexpr int PH = 8, PNK = 128, PQD = 256, PK = 16;
constexpr int INW = 9280, INW_PAD = 9472;
constexpr float EPS = 1e-6f;

namespace pg8 {
#define PG8_LAS __attribute__((address_space(3)))
typedef unsigned short bf16_t;
typedef short bf16x8 __attribute__((ext_vector_type(8)));
typedef float f32x4 __attribute__((ext_vector_type(4)));
typedef unsigned u32x4 __attribute__((ext_vector_type(4)));
constexpr int BM = 256, BK = 64, HALF = 128, HTB = HALF * BK * 2  , STAGE_BYTES = 8 * HTB, NXCD = 8, WGM = 8;

__host__ __device__ __forceinline__ int lds_byte(int r, int c) { const int st = (r >> 4) * 2 + (c >> 5), rr = r & 15, cc = c & 31, ob = rr * 64 + cc * 2; return st * 1024 + (ob ^ (((ob >> 9) & 1) << 5)); }
__host__ __device__ __forceinline__ void stage_rc(int b, int& R, int& C) { const int st = b / 1024, sb = b % 1024, swz = sb ^ (((sb >> 9) & 1) << 5); R = (st >> 1) * 16 + swz / 64; C = (st & 1) * 32 + (swz % 64) / 2; }
__host__ __device__ __forceinline__ int perm32(int rho) { const int n = rho >> 4, i = rho & 15; return 8 * (i >> 2) + 4 * n + (i & 3); }

struct Unit { int pm, pn; };
struct Gemm { const bf16_t* A; const bf16_t* Bt; int M, N, K; };

struct StaticOrder {
    int nM, nN, nwg, G, c;
    __host__ __device__ void init(int M, int N, int G_, int c_) { nM = M / BM; nN = N / BM; nwg = nM * nN; G = G_; c = c_; }
    __host__ __device__ bool next(int i, Unit& u) const {
        const long L = (long)i * G + c; if (L >= nwg) return false;
        int wgid = (int)L; { const int q = nwg / NXCD, r = nwg % NXCD, xcd = wgid % NXCD, off = wgid / NXCD; wgid = (xcd < r ? xcd * (q + 1) : r * (q + 1) + (xcd - r) * q) + off; }
        const int nig = WGM * nN, gid = wgid / nig, fm = gid * WGM, gsz = (nM - fm) < WGM ? (nM - fm) : WGM;
        u.pm = fm + ((wgid % nig) % gsz); u.pn = (wgid % nig) / gsz; return true;
    }
    __device__ __forceinline__ void a_ready(const Unit&) const {}
    __device__ __forceinline__ void done(const Unit&) const {}
};


typedef float f32x2 __attribute__((ext_vector_type(2)));
typedef __bf16 bf16x2_t __attribute__((ext_vector_type(2)));
__device__ __forceinline__ unsigned cvt_pk_bf16(float lo, float hi) { const f32x2 v = {lo, hi}; const bf16x2_t b = __builtin_convertvector(v, bf16x2_t); return __builtin_bit_cast(unsigned, b); }
__device__ __forceinline__ u32x4 pack8(const f32x4 a, const f32x4 b) { u32x4 w; w.x = cvt_pk_bf16(a[0], a[1]); w.y = cvt_pk_bf16(a[2], a[3]); w.z = cvt_pk_bf16(b[0], b[1]); w.w = cvt_pk_bf16(b[2], b[3]); return w; }
__device__ __forceinline__ void unpack8(const u32x4 w, f32x4& a, f32x4& b) {
    a[0] = __uint_as_float(w.x << 16); a[1] = __uint_as_float(w.x & 0xffff0000u); a[2] = __uint_as_float(w.y << 16); a[3] = __uint_as_float(w.y & 0xffff0000u);
    b[0] = __uint_as_float(w.z << 16); b[1] = __uint_as_float(w.z & 0xffff0000u); b[2] = __uint_as_float(w.w << 16); b[3] = __uint_as_float(w.w & 0xffff0000u); }
__device__ __forceinline__ float sigm(float v) { return __builtin_amdgcn_rcpf(1.0f + __expf(-v)); }
__device__ __forceinline__ f32x4 sigm4(const f32x4 v) { return (f32x4){sigm(v[0]), sigm(v[1]), sigm(v[2]), sigm(v[3])}; }
__device__ __forceinline__ float sumsq4(const f32x4 v) { return (v[0] * v[0] + v[1] * v[1]) + (v[2] * v[2] + v[3] * v[3]); }

#define EPI_ROWS_BEGIN _Pragma("unroll") for (int ai = 0; ai < 2; ++ai) _Pragma("unroll") for (int m = 0; m < 4; ++m) { const int row = u.pm * BM + ai * HALF + wr * 64 + m * 16 + fr;
#define EPI_COLS_BEGIN _Pragma("unroll") for (int bj = 0; bj < 2; ++bj) { const int col = u.pn * BM + bj * HALF + wc * 32 + 8 * fq; const f32x4 v0 = acc[ai][bj][m][0], v1 = acc[ai][bj][m][1];
#define EPI_COLS_END }
#define EPI_ROWS_END }
typedef const f32x4 (&AccRef)[2][2][4][2];

struct EpiProj {
    static constexpr bool PERM = true, AFTER_DRAIN = false;
    bf16_t *HQ, *HV, *HOG, *MQG, *MKVG, *GA, *GB, *KB; float *F, *SSQQ, *SSQKV; const float *lb, *qn, *kvn; const f32x2* CS;
    __device__ __forceinline__ void operator()(AccRef acc, const Unit& u, int wr, int wc, int fr, int fq) const {
        const int seg = u.pn;
        EPI_ROWS_BEGIN
            float ss = 0.f;
            EPI_COLS_BEGIN
                if (seg < 4) { *(u32x4*)(HQ + (size_t)row * 1024 + col) = pack8(v0, v1); }
                else if (seg < 8) { const int c = col - 1024; const f32x4 l0 = *(const f32x4*)(lb + c), l1 = *(const f32x4*)(lb + c + 4);
                    const f32x4 f0 = l0 + (1.0f - l0) * sigm4(v0), f1 = l1 + (1.0f - l1) * sigm4(v1);
                    *(f32x4*)(F + (size_t)row * 1024 + c) = f0; *(f32x4*)(F + (size_t)row * 1024 + c + 4) = f1; }
                else if (seg < 12) { *(u32x4*)(HV + (size_t)row * 1024 + (col - 2048)) = pack8(v0, v1); }
                else if (seg < 16) { *(u32x4*)(HOG + (size_t)row * 1024 + (col - 3072)) = pack8(v0 * sigm4(v0), v1 * sigm4(v1)); }
                else if (seg < 18) { const int c = col - 4096; ss += sumsq4(v0) + sumsq4(v1);
                    *(u32x4*)(MQG + (size_t)row * 512 + c) = pack8(v0 * *(const f32x4*)(qn + c), v1 * *(const f32x4*)(qn + c + 4)); }
                else if (seg < 20) { const int c = col - 4608; ss += sumsq4(v0) + sumsq4(v1);
                    *(u32x4*)(MKVG + (size_t)row * 512 + c) = pack8(v0 * *(const f32x4*)(kvn + c), v1 * *(const f32x4*)(kvn + c + 4)); }
                else if (seg < 28) { *(u32x4*)(GA + (size_t)row * 2048 + (col - 5120)) = pack8(sigm4(v0), sigm4(v1)); }
                else if (seg < 36) { *(u32x4*)(GB + (size_t)row * 2048 + (col - 7168)) = pack8(sigm4(v0), sigm4(v1)); }
                else { const int c = col - 9216;
                    if (c < 64) { const f32x2* cs = CS + (size_t)row * 32 + (c >> 1); const f32x2 c0 = cs[0], c1 = cs[1], c2 = cs[2], c3 = cs[3];
                        f32x4 o0, o1; o0[0] = v0[0] * c0.x - v0[1] * c0.y; o0[1] = v0[1] * c0.x + v0[0] * c0.y; o0[2] = v0[2] * c1.x - v0[3] * c1.y; o0[3] = v0[3] * c1.x + v0[2] * c1.y;
                        o1[0] = v1[0] * c2.x - v1[1] * c2.y; o1[1] = v1[1] * c2.x + v1[0] * c2.y; o1[2] = v1[2] * c3.x - v1[3] * c3.y; o1[3] = v1[3] * c3.x + v1[2] * c3.y;
                        const u32x4 w = pack8(o0, o1);
#pragma unroll
                        for (int h = 0; h < MH; ++h) *(u32x4*)(KB + ((size_t)h * T + row) * MQK + MNOPE + c) = w; } }
            EPI_COLS_END
            if (seg >= 16 && seg < 20) { ss += __shfl_xor(ss, 16); ss += __shfl_xor(ss, 32);
                if (fq == 0) { float* S = seg < 18 ? SSQQ : SSQKV; S[(size_t)row * 8 + (seg & 1) * 4 + wc] = ss; } }
        EPI_ROWS_END
    }
};
constexpr float QSCALE = 0.07216878364870323f * 1.4426950408889634f;
struct EpiQ {
    static constexpr bool PERM = true, AFTER_DRAIN = false;
    bf16_t* Q; const float* SSQQ; const f32x2* CS;
    __device__ __forceinline__ void operator()(AccRef acc, const Unit& u, int wr, int wc, int fr, int fq) const {
        EPI_ROWS_BEGIN
            const f32x4 s0 = *(const f32x4*)(SSQQ + (size_t)row * 8), s1 = *(const f32x4*)(SSQQ + (size_t)row * 8 + 4);
            const float rs = __builtin_amdgcn_rsqf(((s0[0] + s0[1]) + (s0[2] + s0[3]) + (s1[0] + s1[1]) + (s1[2] + s1[3])) * (1.0f / MQL) + EPS) * QSCALE;
            EPI_COLS_BEGIN
                const int head = col / MQK, d = col - head * MQK; f32x4 a = v0 * rs, b = v1 * rs;
                if (d >= MNOPE) { const f32x2* cs = CS + (size_t)row * 32 + ((d - MNOPE) >> 1); const f32x2 c0 = cs[0], c1 = cs[1], c2 = cs[2], c3 = cs[3];
                    f32x4 o0, o1; o0[0] = a[0] * c0.x - a[1] * c0.y; o0[1] = a[1] * c0.x + a[0] * c0.y; o0[2] = a[2] * c1.x - a[3] * c1.y; o0[3] = a[3] * c1.x + a[2] * c1.y;
                    o1[0] = b[0] * c2.x - b[1] * c2.y; o1[1] = b[1] * c2.x + b[0] * c2.y; o1[2] = b[2] * c3.x - b[3] * c3.y; o1[3] = b[3] * c3.x + b[2] * c3.y; a = o0; b = o1; }
                *(u32x4*)(Q + ((size_t)head * T + row) * MQK + d) = pack8(a, b);
            EPI_COLS_END
        EPI_ROWS_END
    }
};
struct EpiKV {
    static constexpr bool PERM = true, AFTER_DRAIN = false;
    bf16_t *K, *V; const float* SSQKV;
    __device__ __forceinline__ void operator()(AccRef acc, const Unit& u, int wr, int wc, int fr, int fq) const {
        EPI_ROWS_BEGIN
            const f32x4 s0 = *(const f32x4*)(SSQKV + (size_t)row * 8), s1 = *(const f32x4*)(SSQKV + (size_t)row * 8 + 4);
            const float rs = __builtin_amdgcn_rsqf(((s0[0] + s0[1]) + (s0[2] + s0[3]) + (s1[0] + s1[1]) + (s1[2] + s1[3])) * (1.0f / MKVL) + EPS);
            EPI_COLS_BEGIN
                const int head = col >> 8, d = col & 255; const u32x4 w = pack8(v0 * rs, v1 * rs);
                if (d < MNOPE) *(u32x4*)(K + ((size_t)head * T + row) * MQK + d) = w; else *(u32x4*)(V + ((size_t)head * T + row) * MV + (d - MNOPE)) = w;
            EPI_COLS_END
        EPI_ROWS_END
    }
};
struct EpiPlain {
    static constexpr bool PERM = true, AFTER_DRAIN = false;
    bf16_t* O; int ldc;
    __device__ __forceinline__ void operator()(AccRef acc, const Unit& u, int wr, int wc, int fr, int fq) const {
        EPI_ROWS_BEGIN EPI_COLS_BEGIN *(u32x4*)(O + (size_t)row * ldc + col) = pack8(v0, v1); EPI_COLS_END EPI_ROWS_END
    }
};
struct EpiYb {
    static constexpr bool PERM = true, AFTER_DRAIN = false;
    const bf16_t* GB; bf16_t* YB;
    __device__ __forceinline__ void operator()(AccRef acc, const Unit& u, int wr, int wc, int fr, int fq) const {
        EPI_ROWS_BEGIN EPI_COLS_BEGIN f32x4 g0, g1; unpack8(*(const u32x4*)(GB + (size_t)row * DM + col), g0, g1); *(u32x4*)(YB + (size_t)row * DM + col) = pack8(v0 * g0, v1 * g1); EPI_COLS_END EPI_ROWS_END
    }
};
struct EpiY {
    static constexpr bool PERM = true, AFTER_DRAIN = false;
    const bf16_t *GA, *YB; bf16_t* Y;
    __device__ __forceinline__ void operator()(AccRef acc, const Unit& u, int wr, int wc, int fr, int fq) const {
        EPI_ROWS_BEGIN EPI_COLS_BEGIN f32x4 g0, g1, y0, y1; unpack8(*(const u32x4*)(GA + (size_t)row * DM + col), g0, g1); unpack8(*(const u32x4*)(YB + (size_t)row * DM + col), y0, y1);
            *(u32x4*)(Y + (size_t)row * DM + col) = pack8(v0 * g0 + y0, v1 * g1 + y1); EPI_COLS_END EPI_ROWS_END
    }
};
struct EpiX1 {
    static constexpr bool PERM = true, AFTER_DRAIN = false;
    const float *X, *gain; float *OUT, *SSQ; bf16_t* XG;
    __device__ __forceinline__ void operator()(AccRef acc, const Unit& u, int wr, int wc, int fr, int fq) const {
        EPI_ROWS_BEGIN
            float ss = 0.f;
            EPI_COLS_BEGIN
                const size_t o = (size_t)row * DM + col; const f32x4 a = *(const f32x4*)(X + o) + v0, b = *(const f32x4*)(X + o + 4) + v1;
                *(f32x4*)(OUT + o) = a; *(f32x4*)(OUT + o + 4) = b; ss += sumsq4(a) + sumsq4(b);
                *(u32x4*)(XG + o) = pack8(a * *(const f32x4*)(gain + col), b * *(const f32x4*)(gain + col + 4));
            EPI_COLS_END
            ss += __shfl_xor(ss, 16); ss += __shfl_xor(ss, 32);
            if (fq == 0) SSQ[(size_t)row * 32 + u.pn * 4 + wc] = ss;
        EPI_ROWS_END
    }
};
struct EpiPle {
    static constexpr bool PERM = true, AFTER_DRAIN = false;
    const bf16_t* PE; const float *SSQ2, *X2; float *OUT, *SSQ;
    __device__ __forceinline__ void operator()(AccRef acc, const Unit& u, int wr, int wc, int fr, int fq) const {
        EPI_ROWS_BEGIN
            const float rs = __builtin_amdgcn_rsqf(SSQ2[row] * (1.0f / DM) + EPS); float ss = 0.f;
            EPI_COLS_BEGIN
                const size_t o = (size_t)row * DM + col; f32x4 p0, p1; unpack8(*(const u32x4*)(PE + o), p0, p1);
                const f32x4 a = *(const f32x4*)(X2 + o) + sigm4(v0 * rs) * p0, b = *(const f32x4*)(X2 + o + 4) + sigm4(v1 * rs) * p1;
                *(f32x4*)(OUT + o) = a; *(f32x4*)(OUT + o + 4) = b; ss += sumsq4(a) + sumsq4(b);
            EPI_COLS_END
            ss += __shfl_xor(ss, 16); ss += __shfl_xor(ss, 32);
            if (fq == 0) SSQ[(size_t)row * 32 + u.pn * 4 + wc] = ss;
        EPI_ROWS_END
    }
};

template <class Epi, class Sched, bool ALIGN_EPI = false, bool SP2 = false>
__device__ __forceinline__ void gemm_phase(PG8_LAS unsigned char* lds, const Gemm g, const Sched& S, const Epi& E) {
    const int tid = threadIdx.x, wid = __builtin_amdgcn_readfirstlane(tid >> 6), lane = tid & 63, wr = wid >> 2, wc = wid & 3, fr = lane & 15, fq = lane >> 4;
    const int K = g.K, nt = K / BK;
    unsigned voffA[2], voffB[2];
#pragma unroll
    for (int i = 0; i < 2; ++i) { int R, C; stage_rc(tid * 16 + i * 8192, R, C); const int Rb = Epi::PERM ? ((R & ~31) + perm32(R & 31)) : R;
        voffA[i] = (unsigned)(R * K + C) * 2u; voffB[i] = (unsigned)(Rb * K + C) * 2u; }
    const size_t kstep = (size_t)(BK * 2);
    const size_t hstep = (size_t)HALF * K * 2;
    const size_t tstep = 2 * hstep;
    const unsigned ldsw = (unsigned)wid * 1024u;
    const int aoff = lds_byte(wr * 64 + fr, fq * 8), boff = lds_byte(wc * 32 + fr, fq * 8);
#define PG8_SA(b, h) (((b) * 2 + (h)) * HTB)
#define PG8_SB(b, h) ((4 + (b) * 2 + (h)) * HTB)
#define PG8_STAGE(bufoff, gbase, voff) do { _Pragma("unroll") for (int _i = 0; _i < 2; ++_i) \
        __builtin_amdgcn_global_load_lds((const unsigned*)((const char*)(gbase) + (voff)[_i]), (PG8_LAS unsigned*)(lds + (bufoff) + ldsw + _i * 8192), 16, 0, 0); } while (0)
#define PG8_LDA(dst, b, h) do { _Pragma("unroll") for (int m = 0; m < 4; ++m) _Pragma("unroll") for (int k = 0; k < 2; ++k) dst[m][k] = *(const PG8_LAS bf16x8*)(lds + PG8_SA(b, h) + aoff + m * 2048 + k * 1024); } while (0)
#define PG8_LDB(dst, b, h) do { _Pragma("unroll") for (int n = 0; n < 2; ++n) _Pragma("unroll") for (int k = 0; k < 2; ++k) dst[n][k] = *(const PG8_LAS bf16x8*)(lds + PG8_SB(b, h) + boff + n * 2048 + k * 1024); } while (0)
#define PG8_MMA(ai, bj, At, Bt) do { __builtin_amdgcn_s_setprio(1); _Pragma("unroll") for (int m = 0; m < 4; ++m) _Pragma("unroll") for (int n = 0; n < 2; ++n) _Pragma("unroll") for (int k = 0; k < 2; ++k) \
        acc[ai][bj][m][n] = __builtin_amdgcn_mfma_f32_16x16x32_bf16(Bt[n][k], At[m][k], acc[ai][bj][m][n], 0, 0, 0); __builtin_amdgcn_s_setprio(0); } while (0)
#define PG8_WAIT_V(n) asm volatile("s_waitcnt vmcnt(" #n ")" ::: "memory")
#define PG8_WAIT_L(n) asm volatile("s_waitcnt lgkmcnt(" #n ")" ::: "memory")
#define PG8_BAR __builtin_amdgcn_s_barrier()
#define PG8_SCHED __builtin_amdgcn_sched_barrier(0)
    Unit cur, nxt; int ui = 0;
    if (!S.next(0, cur)) return;
    f32x4 acc[2][2][4][2];
#pragma unroll
    for (int a = 0; a < 2; ++a)
#pragma unroll
        for (int b = 0; b < 2; ++b)
#pragma unroll
            for (int m = 0; m < 4; ++m)
#pragma unroll
                for (int n = 0; n < 2; ++n) acc[a][b][m][n] = (f32x4){0.f, 0.f, 0.f, 0.f};
    bf16x8 At[4][2], B0[2][2], B1[2][2];
    const char* cA = (const char*)g.A + (size_t)cur.pm * tstep; const char* cB = (const char*)g.Bt + (size_t)cur.pn * tstep;
    S.a_ready(cur);
    if constexpr (SP2) {
        PG8_STAGE(PG8_SB(0, 0), cB, voffB); PG8_STAGE(PG8_SB(0, 1), cB + hstep, voffB); PG8_STAGE(PG8_SA(0, 0), cA, voffA); PG8_STAGE(PG8_SA(0, 1), cA + hstep, voffA);
        if (wr == 1) PG8_BAR;
        PG8_WAIT_V(2); PG8_BAR;
        PG8_STAGE(PG8_SB(1, 0), cB + kstep, voffB); PG8_STAGE(PG8_SA(1, 0), cA + kstep, voffA); PG8_STAGE(PG8_SB(1, 1), cB + hstep + kstep, voffB);
        PG8_WAIT_V(6); PG8_BAR;
    } else {
        PG8_STAGE(PG8_SB(0, 0), cB, voffB); PG8_STAGE(PG8_SA(0, 0), cA, voffA); PG8_STAGE(PG8_SB(0, 1), cB + hstep, voffB); PG8_STAGE(PG8_SA(0, 1), cA + hstep, voffA);
        if (wr == 1) PG8_BAR;
        PG8_WAIT_V(4); PG8_BAR;
        PG8_STAGE(PG8_SB(1, 0), cB + kstep, voffB); PG8_STAGE(PG8_SA(1, 0), cA + kstep, voffA); PG8_STAGE(PG8_SB(1, 1), cB + hstep + kstep, voffB);
        PG8_WAIT_V(6); PG8_BAR;
    }
    for (;;) {
        const bool has_next = S.next(ui + 1, nxt);
        const char* nA = has_next ? (const char*)g.A + (size_t)nxt.pm * tstep : cA; const char* nB = has_next ? (const char*)g.Bt + (size_t)nxt.pn * tstep : cB;
        for (int t = 0; t < nt; t += 2) {
            const bool last = (t == nt - 2);
            const char* a1 = cA + (size_t)(t + 1) * kstep;
            const char* a2 = last ? nA : cA + (size_t)(t + 2) * kstep; const char* b2 = last ? nB : cB + (size_t)(t + 2) * kstep;
            const char* a3 = a2 + kstep; const char* b3 = b2 + kstep;
            if (last && has_next) S.a_ready(nxt);
            if constexpr (SP2) {
            PG8_LDB(B0, 0, 0); PG8_LDB(B1, 0, 1); PG8_SCHED; PG8_LDA(At, 0, 0); PG8_STAGE(PG8_SA(1, 1), a1 + hstep, voffA);
            PG8_WAIT_V(8); PG8_WAIT_L(0); PG8_BAR; PG8_MMA(0, 0, At, B0); PG8_MMA(0, 1, At, B1); PG8_BAR; PG8_SCHED;
            PG8_LDA(At, 0, 1); PG8_STAGE(PG8_SB(0, 0), b2, voffB); PG8_STAGE(PG8_SB(0, 1), b2 + hstep, voffB); PG8_STAGE(PG8_SA(0, 0), a2, voffA);
            PG8_WAIT_V(8); PG8_WAIT_L(0); PG8_BAR; PG8_MMA(1, 0, At, B0); PG8_MMA(1, 1, At, B1); PG8_BAR; PG8_SCHED;
            PG8_LDB(B0, 1, 0); PG8_LDB(B1, 1, 1); PG8_SCHED; PG8_LDA(At, 1, 0); PG8_STAGE(PG8_SA(0, 1), a2 + hstep, voffA);
            PG8_WAIT_V(8); PG8_WAIT_L(0); PG8_BAR; PG8_MMA(0, 0, At, B0); PG8_MMA(0, 1, At, B1); PG8_BAR; PG8_SCHED;
            PG8_LDA(At, 1, 1); PG8_STAGE(PG8_SB(1, 0), b3, voffB); PG8_STAGE(PG8_SB(1, 1), b3 + hstep, voffB); PG8_STAGE(PG8_SA(1, 0), a3, voffA);
            PG8_WAIT_V(8); PG8_WAIT_L(0); PG8_BAR; PG8_MMA(1, 0, At, B0); PG8_MMA(1, 1, At, B1); PG8_BAR; PG8_SCHED;
            } else {
            PG8_LDB(B0, 0, 0); PG8_SCHED; PG8_LDA(At, 0, 0); PG8_STAGE(PG8_SA(1, 1), a1 + hstep, voffA);
            PG8_WAIT_L(8); PG8_BAR; PG8_WAIT_L(0); PG8_MMA(0, 0, At, B0); PG8_BAR; PG8_SCHED;
            PG8_LDB(B1, 0, 1); PG8_STAGE(PG8_SB(0, 0), b2, voffB);
            PG8_BAR; PG8_WAIT_L(0); PG8_MMA(0, 1, At, B1); PG8_BAR;
            PG8_LDA(At, 0, 1); PG8_STAGE(PG8_SA(0, 0), a2, voffA);
            PG8_BAR; PG8_WAIT_L(0); PG8_MMA(1, 0, At, B0); PG8_BAR; PG8_SCHED;
            PG8_STAGE(PG8_SB(0, 1), b2 + hstep, voffB);
            PG8_WAIT_V(6); PG8_BAR; PG8_MMA(1, 1, At, B1); PG8_BAR;
            PG8_LDB(B0, 1, 0); PG8_SCHED; PG8_LDA(At, 1, 0); PG8_STAGE(PG8_SA(0, 1), a2 + hstep, voffA);
            PG8_WAIT_L(8); PG8_BAR; PG8_WAIT_L(0); PG8_MMA(0, 0, At, B0); PG8_BAR; PG8_SCHED;
            PG8_LDB(B1, 1, 1); PG8_STAGE(PG8_SB(1, 0), b3, voffB);
            PG8_BAR; PG8_WAIT_L(0); PG8_MMA(0, 1, At, B1); PG8_BAR;
            PG8_LDA(At, 1, 1); PG8_STAGE(PG8_SA(1, 0), a3, voffA);
            PG8_BAR; PG8_WAIT_L(0); PG8_MMA(1, 0, At, B0); PG8_BAR; PG8_SCHED;
            PG8_STAGE(PG8_SB(1, 1), b3 + hstep, voffB);
            PG8_WAIT_V(6); PG8_BAR; PG8_MMA(1, 1, At, B1); PG8_BAR;
            }
        }
        if constexpr (ALIGN_EPI) { if (wr == 0) PG8_BAR; }
        if constexpr (!Epi::AFTER_DRAIN) { E(acc, cur, wr, wc, fr, fq); S.done(cur); }
        if (!has_next) break;
#pragma unroll
        for (int a = 0; a < 2; ++a)
#pragma unroll
            for (int b = 0; b < 2; ++b)
#pragma unroll
                for (int m = 0; m < 4; ++m)
#pragma unroll
                    for (int n = 0; n < 2; ++n) acc[a][b][m][n] = (f32x4){0.f, 0.f, 0.f, 0.f};
        cur = nxt; cA = nA; cB = nB; ++ui;
        if constexpr (ALIGN_EPI) { if (wr == 1) PG8_BAR; }
    }
    PG8_WAIT_V(0);
    if constexpr (!ALIGN_EPI) { if (wr == 0) PG8_BAR; }
    PG8_BAR;
    if constexpr (Epi::AFTER_DRAIN) { E.fused(acc, cur, wr, wc, fr, fq, lds, wid, lane); S.done(cur); }
#undef PG8_SA
#undef PG8_SB
#undef PG8_STAGE
#undef PG8_LDA
#undef PG8_LDB
#undef PG8_MMA
#undef PG8_WAIT_V
#undef PG8_WAIT_L
#undef PG8_BAR
#undef PG8_SCHED
}
}

#define LAS __attribute__((address_space(3)))
typedef unsigned short bf16_t;
typedef short bf16x8 __attribute__((ext_vector_type(8)));
typedef short s16x4 __attribute__((ext_vector_type(4)));
typedef float f32x2 __attribute__((ext_vector_type(2)));
typedef float f32x4 __attribute__((ext_vector_type(4)));
typedef float f32x16 __attribute__((ext_vector_type(16)));
typedef unsigned u32x2 __attribute__((ext_vector_type(2)));
typedef unsigned u32x4 __attribute__((ext_vector_type(4)));
using pg8::cvt_pk_bf16; using pg8::pack8; using pg8::unpack8; using pg8::sumsq4; using pg8::sigm;
#define LDS_WAIT() asm volatile("s_waitcnt lgkmcnt(0)" ::: "memory")
__device__ __forceinline__ float bf2f(unsigned short b) { return __uint_as_float((unsigned)b << 16); }
__device__ __forceinline__ unsigned short f2bf(float f) { return (unsigned short)(cvt_pk_bf16(f, 0.f) & 0xffffu); }
__device__ __forceinline__ float wave_sum(float v) {
#pragma unroll
    for (int o = 1; o < 64; o <<= 1) v += __shfl_xor(v, o);
    return v;
}

constexpr size_t MiB = 1u << 20;
constexpr size_t WS_CTL = 0, CTL_ZERO_BYTES = 64 * 1024;
constexpr size_t WS_LB = 1 * MiB;
constexpr size_t WS_K1B = WS_LB + 64 * 1024;
constexpr size_t WS_K2B = WS_K1B + 64 * 1024;
constexpr size_t WS_SSQQ = 2 * MiB;
constexpr size_t WS_SSQKV = WS_SSQQ + 256 * 1024;
constexpr size_t WS_SSQ2 = WS_SSQKV + 256 * 1024;
constexpr size_t WS_SSQ1 = 3 * MiB;
constexpr size_t WS_SSQ3 = 4 * MiB;
constexpr size_t WS_DECAY = 5 * MiB;
constexpr size_t WS_CS = 6 * MiB;
constexpr size_t WS_EIDX = 8 * MiB;
constexpr size_t WS_GATE = 12 * MiB;
constexpr size_t WS_WUQT = 16 * MiB, WS_WUKVT = 18 * MiB, WS_WAT = 20 * MiB, WS_WBT = 24 * MiB, WS_WOT = 28 * MiB, WS_WQT = 36 * MiB, WS_WPGT = 44 * MiB, WS_WPET = 52 * MiB, WS_PBF = 53 * MiB;
constexpr size_t WS_WINT = 58 * MiB;
constexpr size_t WS_SPT = 58 * MiB;
constexpr size_t WS_ACTA = 96 * MiB;
constexpr size_t WS_GA = 128 * MiB, WS_GB = 160 * MiB;
constexpr size_t WS_QP = WS_GA, WS_PE = WS_GB;
constexpr size_t WS_HQ = 192 * MiB, WS_F = 208 * MiB, WS_HV = 240 * MiB, WS_HOG = 256 * MiB, WS_Q = 272 * MiB, WS_K = 296 * MiB, WS_V = 320 * MiB;
constexpr size_t WS_U8 = 192 * MiB, WS_V8 = 224 * MiB;
constexpr size_t WS_SU = 1 * MiB + 256 * 1024, WS_SV = WS_SU + 64 * 1024;
constexpr size_t WS_MQG = 336 * MiB, WS_MKVG = 344 * MiB, WS_OB = 336 * MiB;
constexpr size_t WS_DST = 352 * MiB;
constexpr size_t WS_OA = 416 * MiB, WS_YB = 432 * MiB, WS_Y = 464 * MiB, WS_END = 496 * MiB;
constexpr size_t WS_X2 = 432 * MiB;

#define XB_TMO      128
#define XB_XCNT(j)  (256  + 64 * (j))
#define XB_XSUB(j)  (1280 + 64 * (j))
#define XB_XGEN(j)  (2304 + 64 * (j))
#define XB_TOP      3328
#define XB_TOPGEN   3392
#define XCD_BAR_WORDS 3456
#define XB_SPIN_CAP (1u << 18)

__device__ __forceinline__ unsigned xb_ld(unsigned* p)              { return __hip_atomic_load(p, __ATOMIC_RELAXED, __HIP_MEMORY_SCOPE_AGENT); }
__device__ __forceinline__ unsigned xb_add(unsigned* p, unsigned v) { return __hip_atomic_fetch_add(p, v, __ATOMIC_RELAXED, __HIP_MEMORY_SCOPE_AGENT); }
__device__ __forceinline__ unsigned xb_xcc_id() { return (unsigned)__builtin_amdgcn_s_getreg((3 << 11) | 20) & 0xFu; }
#define XB_SPIN(cond, bar) do { unsigned _sp = 0; while (cond) { __builtin_amdgcn_s_sleep(1); \
    if ((++_sp & 255u) == 0u) { if (xb_ld(&(bar)[XB_TMO])) break; if (_sp > XB_SPIN_CAP) { atomicAdd(&(bar)[XB_TMO], 1u); break; } } } } while (0)

struct XcdBarrier {
    unsigned* bar; unsigned x;
    volatile LAS unsigned* st;
};

__device__ __forceinline__ XcdBarrier xcd_barrier_post(unsigned* bar, volatile LAS unsigned* st) {
    XcdBarrier b; b.bar = bar; b.x = xb_xcc_id(); b.st = st;
    if (threadIdx.x == 0) (void)xb_add(&bar[XB_XCNT(b.x)], 1u);
    return b;
}
__device__ __forceinline__ void xcd_barrier_complete(unsigned* bar, unsigned x, unsigned& nloc, unsigned& nx) {
    const unsigned G = gridDim.x * gridDim.y * gridDim.z;
    unsigned sum, cnt, mine, sp = 0u;
    for (;;) {
        sum = 0u; cnt = 0u; mine = 0u;
#pragma unroll
        for (unsigned j = 0; j < 16; ++j) { const unsigned c = xb_ld(&bar[XB_XCNT(j)]); sum += c; cnt += (c > 0u) ? 1u : 0u; mine = (j == x) ? c : mine; }
        if (sum == G) break;
        __builtin_amdgcn_s_sleep(1);
        if ((++sp & 255u) == 0u) { if (xb_ld(&bar[XB_TMO])) break; if (sp > XB_SPIN_CAP) { atomicAdd(&bar[XB_TMO], 1u); break; } }
    }
    nloc = mine > 0u ? mine : 1u; nx = cnt > 0u ? cnt : 1u;
}

__device__ __forceinline__ void xcd_barrier(const XcdBarrier& b) {
    asm volatile("s_waitcnt vmcnt(0)" ::: "memory");
    __syncthreads();
    if (threadIdx.x == 0) {
        unsigned* bar = b.bar;
        __builtin_amdgcn_s_waitcnt(0);
        unsigned nloc = b.st[0], nx = b.st[1];
        if (nloc == 0u) { xcd_barrier_complete(bar, b.x, nloc, nx); b.st[0] = nloc; b.st[1] = nx; }
        const unsigned old = xb_add(&bar[XB_XSUB(b.x)], 1u);
        const unsigned gen = old / nloc;
        if (old + 1u == (gen + 1u) * nloc) {
            __builtin_amdgcn_fence(__ATOMIC_RELEASE, "agent");
            asm volatile("s_waitcnt vmcnt(0)" ::: "memory");
            const unsigned og = xb_add(&bar[XB_TOP], 1u);
            const unsigned tg = og / nx;
            if (og + 1u == (tg + 1u) * nx) xb_add(&bar[XB_TOPGEN], 1u);
            else XB_SPIN(xb_ld(&bar[XB_TOPGEN]) == tg, bar);
            __builtin_amdgcn_fence(__ATOMIC_ACQUIRE, "agent");
            xb_add(&bar[XB_XGEN(b.x)], 1u);
            asm volatile("s_waitcnt vmcnt(0)" ::: "memory");
        } else {
            XB_SPIN(xb_ld(&bar[XB_XGEN(b.x)]) == gen, bar);
            __builtin_amdgcn_fence(__ATOMIC_ACQUIRE, "agent");
            asm volatile("s_waitcnt vmcnt(0)" ::: "memory");
        }
    }
    __syncthreads();
}

struct Ctx { LAS unsigned char* lds; int tid, lane, wave, G, bid; float* out; unsigned char* ws; };
__device__ __forceinline__ const void* karg_ptr(int i) { return ((const void* const __attribute__((address_space(4)))*)__builtin_amdgcn_kernarg_segment_ptr())[i]; }
#define IP(i) ((const float*)karg_ptr(i))
#define WSP(type, off) ((type*)(C.ws + (off)))

__device__ __forceinline__ int ilv64(int i) { return i < 32 ? 2 * i : 2 * (i - 32) + 1; }
template <int MAP> __device__ __forceinline__ int colmap(int n) {
    if (MAP == 1) { if (n < 5120) return n; if (n < 5184) return 9216 + ilv64(n - 5120); return n - 64; }
    if (MAP == 2) { const int h = n / MQK, d = n - h * MQK; return d < MNOPE ? n : h * MQK + MNOPE + ilv64(d - MNOPE); }
    return n;
}
template <int MAP> __device__ __forceinline__ void p0_transpose_item(const float* W, int K, int N, bf16_t* WT, LAS float* scr, int item, int lane) {
    const int nblk = N / 32, kb = item / nblk, nb = item % nblk, k0 = 64 * kb, n0 = 32 * nb;
#pragma unroll 8
    for (int i = 0; i < 32; ++i) { const int kk = 2 * i + (lane >> 5); scr[kk * 33 + (lane & 31)] = W[(size_t)(k0 + kk) * N + n0 + (lane & 31)]; }
    LDS_WAIT(); asm volatile("" ::: "memory");
    const int c = lane & 7;
#pragma unroll
    for (int j = 0; j < 4; ++j) { const int n = (lane >> 3) + 8 * j; const LAS float* s = scr + (8 * c) * 33 + n;
        u32x4 o; o.x = cvt_pk_bf16(s[0 * 33], s[1 * 33]); o.y = cvt_pk_bf16(s[2 * 33], s[3 * 33]); o.z = cvt_pk_bf16(s[4 * 33], s[5 * 33]); o.w = cvt_pk_bf16(s[6 * 33], s[7 * 33]);
        *(u32x4*)(WT + (size_t)colmap<MAP>(n0 + n) * K + k0 + 8 * c) = o; }
    LDS_WAIT(); asm volatile("" ::: "memory");
}
__device__ __forceinline__ void rms_row_to_bf16(const float* xrow, const float* gain, bf16_t* orow, int lane) {
    const f32x4* xr = (const f32x4*)xrow + lane; const f32x4* gr = (const f32x4*)gain + lane;
    f32x4 v[8]; float s = 0.f;
#pragma unroll
    for (int j = 0; j < 8; ++j) { v[j] = xr[64 * j]; s += sumsq4(v[j]); }
    const float rs = __builtin_amdgcn_rsqf(wave_sum(s) * (1.0f / DM) + EPS);
    u32x2* o8 = (u32x2*)orow + lane;
#pragma unroll
    for (int j = 0; j < 8; ++j) { const f32x4 y = v[j] * rs * gr[64 * j]; u32x2 w; w.x = cvt_pk_bf16(y[0], y[1]); w.y = cvt_pk_bf16(y[2], y[3]); o8[64 * j] = w; }
}
__device__ __forceinline__ void cvt_copy(const float* src, bf16_t* dst, size_t n, size_t gtid, size_t nthr) {
    for (size_t i = gtid; i < n / 8; i += nthr) { const f32x4 a = ((const f32x4*)src)[2 * i], b = ((const f32x4*)src)[2 * i + 1]; ((u32x4*)dst)[i] = pack8(a, b); }
}

__device__ __forceinline__ void phase_prep(const Ctx& C) {
    LAS float* scr = (LAS float*)(C.lds + C.wave * 16384);
    const int gw = C.bid * 8 + C.wave, NGW = C.G * 8;
    constexpr int I_IN = (DM / 64) * (INW / 32), I_UQ = (MQL / 64) * (MH * MQK / 32), I_UKV = (MKVL / 64) * (2048 / 32), I_A = (HGW / 64) * (DM / 32), I_O = (DM / 64) * (DM / 32), I_PE = (PLE / 64) * (DM / 32);
    constexpr int NITEMS = I_IN + I_UQ + I_UKV + 2 * I_A + 3 * I_O + I_PE;
    for (int it = gw; it < NITEMS; it += NGW) {
        int r = it;
        if (r < I_IN) { p0_transpose_item<1>(IP(4), DM, INW, WSP(bf16_t, WS_WINT), scr, r, C.lane); continue; } r -= I_IN;
        if (r < I_UQ) { p0_transpose_item<2>(IP(9), MQL, MH * MQK, WSP(bf16_t, WS_WUQT), scr, r, C.lane); continue; } r -= I_UQ;
        if (r < I_UKV) { p0_transpose_item<0>(IP(10), MKVL, 2048, WSP(bf16_t, WS_WUKVT), scr, r, C.lane); continue; } r -= I_UKV;
        if (r < I_A) { p0_transpose_item<0>(IP(11), HGW, DM, WSP(bf16_t, WS_WAT), scr, r, C.lane); continue; } r -= I_A;
        if (r < I_A) { p0_transpose_item<0>(IP(12), HGW, DM, WSP(bf16_t, WS_WBT), scr, r, C.lane); continue; } r -= I_A;
        if (r < I_O) { p0_transpose_item<0>(IP(13), DM, DM, WSP(bf16_t, WS_WOT), scr, r, C.lane); continue; } r -= I_O;
        if (r < I_O) { p0_transpose_item<0>(IP(15), DM, DM, WSP(bf16_t, WS_WQT), scr, r, C.lane); continue; } r -= I_O;
        if (r < I_O) { p0_transpose_item<0>(IP(21), DM, DM, WSP(bf16_t, WS_WPGT), scr, r, C.lane); continue; } r -= I_O;
        p0_transpose_item<0>(IP(22), PLE, DM, WSP(bf16_t, WS_WPET), scr, r, C.lane);
    }
    for (int m = gw; m < T; m += NGW) rms_row_to_bf16(IP(0) + (size_t)m * DM, IP(3), WSP(bf16_t, WS_ACTA) + (size_t)m * DM, C.lane);
    const size_t gtid = (size_t)C.bid * 512 + C.tid, nthr = (size_t)C.G * 512;
    { u32x4* z = (u32x4*)(WSP(bf16_t, WS_WINT) + (size_t)INW * DM); for (size_t i = gtid; i < (size_t)(INW_PAD - INW) * DM / 8; i += nthr) z[i] = (u32x4){0u, 0u, 0u, 0u}; }
    cvt_copy(IP(1), WSP(bf16_t, WS_PBF), (size_t)T * PLE, gtid, nthr);
    cvt_copy(IP(16), WSP(bf16_t, WS_K1B), (size_t)PNK * 128, gtid, nthr);
    cvt_copy(IP(17), WSP(bf16_t, WS_K2B), (size_t)PNK * 128, gtid, nthr);
    for (size_t i = gtid; i < HGW; i += nthr) WSP(float, WS_LB)[i] = 1.0f / (1.0f + __expf(IP(5)[HGW + i] - IP(5)[i]));
    for (size_t e = gtid; e < (size_t)T * 32; e += nthr) { const int t = (int)(e >> 5), i = (int)(e & 31);
        double fr = 1.0; for (int k = 0; k < i; ++k) fr *= 0.74989420933245582;
        const float ang = (float)((const int*)karg_ptr(2))[t] * (float)fr; const double rev = (double)ang * 0.15915494309189535; const float fx = (float)(rev - floor(rev));
        WSP(f32x2, WS_CS)[e] = (f32x2){__builtin_amdgcn_cosf(fx), __builtin_amdgcn_sinf(fx)}; }
}

__device__ __forceinline__ void hgrn_cumsum(const Ctx& C, int h, int n, float (&fv)[16], float (&bb)[16], float& b_ref, float& b_last, LAS float* TOT) {
    const int d = C.tid & 127, rg = C.tid >> 7; const float* F = WSP(float, WS_F) + ((size_t)(n * HGC + rg * 16)) * HGW + h * HGD + d;
    float run = 0.f;
#pragma unroll
    for (int i = 0; i < 16; ++i) { fv[i] = F[(size_t)i * HGW]; run += __logf(fv[i]); bb[i] = run; }
    TOT[rg * 128 + d] = run; LDS_WAIT(); __syncthreads();
    const float t0 = TOT[d], t1 = TOT[128 + d], t2 = TOT[256 + d], t3 = TOT[384 + d];
    const float off = rg == 0 ? 0.f : rg == 1 ? t0 : rg == 2 ? t0 + t1 : (t0 + t1) + t2;
    b_ref = t0 + t1; b_last = ((t0 + t1) + t2) + t3;
#pragma unroll
    for (int i = 0; i < 16; ++i) bb[i] += off;
}
constexpr int HG_KDT = 0, HG_VT = 18432, HG_TOT = 36864;
__device__ __forceinline__ void hgrn_a_unit(const Ctx& C, int h, int n) {
    LAS bf16_t* KDT = (LAS bf16_t*)(C.lds + HG_KDT); LAS bf16_t* VT = (LAS bf16_t*)(C.lds + HG_VT); LAS float* TOT = (LAS float*)(C.lds + HG_TOT);
    const int d = C.tid & 127, rg = C.tid >> 7;
    float fv[16], bb[16], b_ref, b_last; hgrn_cumsum(C, h, n, fv, bb, b_ref, b_last, TOT);
    const bf16_t* HVp = WSP(bf16_t, WS_HV) + ((size_t)(n * HGC + rg * 16)) * HGW + h * HGD + d;
#pragma unroll
    for (int g = 0; g < 2; ++g) { float kd[8], vv[8];
#pragma unroll
        for (int i = 0; i < 8; ++i) { const int r = g * 8 + i; kd[i] = (1.0f - fv[r]) * __expf(b_last - bb[r]); vv[i] = bf2f(HVp[(size_t)r * HGW]); }
        u32x4 wk, wv; wk.x = cvt_pk_bf16(kd[0], kd[1]); wk.y = cvt_pk_bf16(kd[2], kd[3]); wk.z = cvt_pk_bf16(kd[4], kd[5]); wk.w = cvt_pk_bf16(kd[6], kd[7]);
        wv.x = cvt_pk_bf16(vv[0], vv[1]); wv.y = cvt_pk_bf16(vv[2], vv[3]); wv.z = cvt_pk_bf16(vv[4], vv[5]); wv.w = cvt_pk_bf16(vv[6], vv[7]);
        *(LAS u32x4*)(KDT + d * 72 + rg * 16 + g * 8) = wk; *(LAS u32x4*)(VT + d * 72 + rg * 16 + g * 8) = wv; }
    if (rg == 0) WSP(float, WS_DECAY)[((size_t)h * HGNC + n) * HGD + d] = __expf(b_last);
    LDS_WAIT(); __syncthreads();
    const int fr = C.lane & 15, fq = C.lane >> 4, w = C.wave;
    bf16x8 bfr[2];
#pragma unroll
    for (int ks = 0; ks < 2; ++ks) bfr[ks] = *(const LAS bf16x8*)(VT + (16 * w + fr) * 72 + 8 * fq + 32 * ks);
    float* DST = WSP(float, WS_DST) + (((size_t)h * HGNC + n) * HGD + 16 * w + fr) * HGD;
#pragma unroll
    for (int mt = 0; mt < 8; ++mt) { f32x4 acc = {0.f, 0.f, 0.f, 0.f};
#pragma unroll
        for (int ks = 0; ks < 2; ++ks) { const bf16x8 a = *(const LAS bf16x8*)(KDT + (16 * mt + fr) * 72 + 8 * fq + 32 * ks); acc = __builtin_amdgcn_mfma_f32_16x16x32_bf16(a, bfr[ks], acc, 0, 0, 0); }
        *(f32x4*)(DST + 16 * mt + 4 * fq) = acc; }
    LDS_WAIT(); __syncthreads();
}
__device__ __forceinline__ void hgrn_scan(const Ctx& C) {
    const float* DST = WSP(float, WS_DST); const float* DEC = WSP(float, WS_DECAY); bf16_t* SPT = WSP(bf16_t, WS_SPT);
    for (int e = C.bid * 512 + C.tid; e < HGH * HGD * HGD; e += C.G * 512) {
        const int h = e >> 14, dv = (e >> 7) & 127, dk = e & 127; float S = 0.f;
        const size_t base = ((size_t)h * HGNC * HGD + dv) * HGD + dk; const size_t dbase = (size_t)h * HGNC * HGD + dk;
#pragma unroll 8
        for (int n = 0; n < HGNC; ++n) { SPT[base + (size_t)n * HGD * HGD] = f2bf(S); S = DEC[dbase + (size_t)n * HGD] * S + DST[base + (size_t)n * HGD * HGD]; }
    }
}
constexpr int HC_QIN = 0, HC_KIN = 17408, HC_QE = 34816, HC_VT = 52224, HC_AQ = 70656, HC_TOT = 79872, HC_OL = 81920;
__device__ __forceinline__ void hgrn_c_unit(const Ctx& C, int h, int n) {
    LAS bf16_t* QIN = (LAS bf16_t*)(C.lds + HC_QIN); LAS bf16_t* KIN = (LAS bf16_t*)(C.lds + HC_KIN); LAS bf16_t* QE = (LAS bf16_t*)(C.lds + HC_QE);
    LAS bf16_t* VT = (LAS bf16_t*)(C.lds + HC_VT); LAS bf16_t* AQ = (LAS bf16_t*)(C.lds + HC_AQ); LAS float* TOT = (LAS float*)(C.lds + HC_TOT); LAS float* OL = (LAS float*)(C.lds + HC_OL);
    const int d = C.tid & 127, rg = C.tid >> 7;
    float fv[16], bb[16], b_ref, b_last; hgrn_cumsum(C, h, n, fv, bb, b_ref, b_last, TOT);
    const size_t gro = ((size_t)(n * HGC + rg * 16)) * HGW + h * HGD + d; const bf16_t* HVp = WSP(bf16_t, WS_HV) + gro; const bf16_t* HQp = WSP(bf16_t, WS_HQ) + gro;
#pragma unroll
    for (int g = 0; g < 2; ++g) { float vv[8];
#pragma unroll
        for (int i = 0; i < 8; ++i) { const int r = g * 8 + i, c = rg * 16 + r; const float q = bf2f(HQp[(size_t)r * HGW]), k = 1.0f - fv[r];
            QIN[c * 136 + d] = f2bf(q * __expf(bb[r] - b_ref)); KIN[c * 136 + d] = f2bf(k * __expf(b_ref - bb[r])); QE[c * 136 + d] = f2bf(q * __expf(bb[r])); vv[i] = bf2f(HVp[(size_t)r * HGW]); }
        u32x4 wv; wv.x = cvt_pk_bf16(vv[0], vv[1]); wv.y = cvt_pk_bf16(vv[2], vv[3]); wv.z = cvt_pk_bf16(vv[4], vv[5]); wv.w = cvt_pk_bf16(vv[6], vv[7]);
        *(LAS u32x4*)(VT + d * 72 + rg * 16 + g * 8) = wv; }
    LDS_WAIT(); __syncthreads();
    const int fr = C.lane & 15, fq = C.lane >> 4, w = C.wave;
    { const int mt = w >> 1;
#pragma unroll
      for (int j = 0; j < 2; ++j) { const int nt = 2 * (w & 1) + j; f32x4 acc = {0.f, 0.f, 0.f, 0.f};
#pragma unroll
        for (int ks = 0; ks < 4; ++ks) { const bf16x8 a = *(const LAS bf16x8*)(QIN + (16 * mt + fr) * 136 + 8 * fq + 32 * ks), b = *(const LAS bf16x8*)(KIN + (16 * nt + fr) * 136 + 8 * fq + 32 * ks);
            acc = __builtin_amdgcn_mfma_f32_16x16x32_bf16(a, b, acc, 0, 0, 0); }
        const int s = 16 * nt + fr;
#pragma unroll
        for (int i = 0; i < 4; ++i) { const int c = 16 * mt + 4 * fq + i; AQ[c * 72 + s] = f2bf(s <= c ? acc[i] : 0.f); } } }
    LDS_WAIT(); __syncthreads();
    { bf16x8 bv[2], bs[4]; const bf16_t* SP = WSP(bf16_t, WS_SPT) + (((size_t)h * HGNC + n) * HGD + 16 * w + fr) * HGD;
#pragma unroll
      for (int ks = 0; ks < 2; ++ks) bv[ks] = *(const LAS bf16x8*)(VT + (16 * w + fr) * 72 + 8 * fq + 32 * ks);
#pragma unroll
      for (int ks = 0; ks < 4; ++ks) bs[ks] = *(const bf16x8*)(SP + 8 * fq + 32 * ks);
#pragma unroll
      for (int mt = 0; mt < 4; ++mt) { f32x4 acc = {0.f, 0.f, 0.f, 0.f};
#pragma unroll
        for (int ks = 0; ks < 2; ++ks) { const bf16x8 a = *(const LAS bf16x8*)(AQ + (16 * mt + fr) * 72 + 8 * fq + 32 * ks); acc = __builtin_amdgcn_mfma_f32_16x16x32_bf16(a, bv[ks], acc, 0, 0, 0); }
#pragma unroll
        for (int ks = 0; ks < 4; ++ks) { const bf16x8 a = *(const LAS bf16x8*)(QE + (16 * mt + fr) * 136 + 8 * fq + 32 * ks); acc = __builtin_amdgcn_mfma_f32_16x16x32_bf16(a, bs[ks], acc, 0, 0, 0); }
#pragma unroll
        for (int i = 0; i < 4; ++i) OL[(16 * mt + 4 * fq + i) * 132 + 16 * w + fr] = acc[i]; } }
    LDS_WAIT(); __syncthreads();
    { const int c = C.tid >> 3, j = C.tid & 7; f32x4 o[4]; float ss = 0.f;
#pragma unroll
      for (int i = 0; i < 4; ++i) { o[i] = *(const LAS f32x4*)(OL + c * 132 + 16 * j + 4 * i); ss += sumsq4(o[i]); }
      ss += __shfl_xor(ss, 1); ss += __shfl_xor(ss, 2); ss += __shfl_xor(ss, 4);
      const float rs = __builtin_amdgcn_rsqf(ss * (1.0f / HGD) + EPS); const size_t go = (size_t)(n * HGC + c) * HGW + h * HGD + 16 * j;
      const float* gn = IP(6) + h * HGD + 16 * j; const bf16_t* HOG = WSP(bf16_t, WS_HOG) + go; bf16_t* OA = WSP(bf16_t, WS_OA) + go;
#pragma unroll
      for (int i = 0; i < 2; ++i) { f32x4 s0, s1; unpack8(*(const u32x4*)(HOG + 8 * i), s0, s1);
          *(u32x4*)(OA + 8 * i) = pack8(o[2 * i] * rs * *(const f32x4*)(gn + 8 * i) * s0, o[2 * i + 1] * rs * *(const f32x4*)(gn + 8 * i + 4) * s1); } }
    LDS_WAIT(); __syncthreads();
}

constexpr int AT_K = 0, AT_KSTR = 400, AT_V = 25600, AT_MRG = 0, AT_MRG_STRIDE = 16384 + 256;
typedef short v4i16_t __attribute__((ext_vector_type(4)));
__device__ __forceinline__ s16x4 vtr(const LAS unsigned char* p) { return __builtin_bit_cast(s16x4, __builtin_amdgcn_ds_read_tr16_b64_v4i16((LAS v4i16_t*)p)); }
__device__ __forceinline__ int crow(int r, int hi) { return (r & 3) + 8 * (r >> 2) + 4 * hi; }
__device__ __forceinline__ void attn_unit(const Ctx& C, int h, int qb) {
    const int lane = C.lane, ql = lane & 31, hi = lane >> 5, kg = C.wave >> 2, qw = C.wave & 3, tid = C.tid;
    const int q0 = qb * 128, ntiles = 2 * (qb + 1), qpos = q0 + 32 * qw + ql;
    const bf16_t* Qp = WSP(bf16_t, WS_Q) + ((size_t)h * T + qpos) * MQK + 8 * hi; const bf16_t* Kp = WSP(bf16_t, WS_K) + (size_t)h * T * MQK; const bf16_t* Vp = WSP(bf16_t, WS_V) + (size_t)h * T * MV;
    bf16x8 qf[12];
#pragma unroll
    for (int ks = 0; ks < 12; ++ks) qf[ks] = *(const bf16x8*)(Qp + 16 * ks);
    float m_run = -1e30f, l_run = 0.f; f32x16 oT[4];
#pragma unroll
    for (int nb = 0; nb < 4; ++nb) oT[nb] = (f32x16){0.f, 0.f, 0.f, 0.f, 0.f, 0.f, 0.f, 0.f, 0.f, 0.f, 0.f, 0.f, 0.f, 0.f, 0.f, 0.f};
    const LAS unsigned char* kfrag = C.lds + AT_K + (32 * kg + ql) * AT_KSTR + 16 * hi;
    const LAS unsigned char* vfrag = C.lds + AT_V + (16 * kg) * 512 + (4 * hi + ((lane & 15) >> 2)) * 64 + ((lane >> 4) & 1) * 32 + (lane & 3) * 8;
    for (int j = 0; j < ntiles; ++j) {
        const int k0 = 64 * j;
        __syncthreads();
#pragma unroll
        for (int i = 0; i < 3; ++i) { const int cid = tid + 512 * i, r = cid / 24, cc = cid - r * 24; *(LAS u32x4*)(C.lds + AT_K + r * AT_KSTR + cc * 16) = *(const u32x4*)(Kp + (size_t)(k0 + r) * MQK + cc * 8); }
#pragma unroll
        for (int i = 0; i < 2; ++i) { const int cid = tid + 512 * i, r = cid >> 4, cc = cid & 15; *(LAS u32x4*)(C.lds + AT_V + ((r >> 3) * 4 + (cc >> 2)) * 512 + (r & 7) * 64 + (cc & 3) * 16) = *(const u32x4*)(Vp + (size_t)(k0 + r) * MV + cc * 8); }
        LDS_WAIT(); __syncthreads();
        const int kbase = k0 + 32 * kg;
        if (kbase <= q0 + 32 * qw + 31) {
            f32x16 st = (f32x16){0.f, 0.f, 0.f, 0.f, 0.f, 0.f, 0.f, 0.f, 0.f, 0.f, 0.f, 0.f, 0.f, 0.f, 0.f, 0.f};
#pragma unroll
            for (int ks = 0; ks < 12; ++ks) { const bf16x8 a = *(const LAS bf16x8*)(kfrag + 32 * ks); st = __builtin_amdgcn_mfma_f32_32x32x16_bf16(a, qf[ks], st, 0, 0, 0); }
            if (kbase + 31 > q0 + 32 * qw) {
#pragma unroll
                for (int r = 0; r < 16; ++r) if (kbase + crow(r, hi) > qpos) st[r] = -__builtin_inff();
            }
            float mx = st[0];
#pragma unroll
            for (int r = 1; r < 16; ++r) mx = fmaxf(mx, st[r]);
            mx = fmaxf(mx, __shfl_xor(mx, 32));
            const float m_new = fmaxf(m_run, mx), alpha = __builtin_amdgcn_exp2f(m_run - m_new); m_run = m_new;
            float ps = 0.f;
#pragma unroll
            for (int r = 0; r < 16; ++r) { st[r] = __builtin_amdgcn_exp2f(st[r] - m_new); ps += st[r]; }
            ps += __shfl_xor(ps, 32); l_run = l_run * alpha + ps;
#pragma unroll
            for (int nb = 0; nb < 4; ++nb) oT[nb] *= alpha;
            bf16x8 pf[2];
#pragma unroll
            for (int s2 = 0; s2 < 2; ++s2) { u32x4 w; w.x = cvt_pk_bf16(st[8 * s2 + 0], st[8 * s2 + 1]); w.y = cvt_pk_bf16(st[8 * s2 + 2], st[8 * s2 + 3]); w.z = cvt_pk_bf16(st[8 * s2 + 4], st[8 * s2 + 5]); w.w = cvt_pk_bf16(st[8 * s2 + 6], st[8 * s2 + 7]); pf[s2] = __builtin_bit_cast(bf16x8, w); }
#pragma unroll
            for (int nb = 0; nb < 4; ++nb)
#pragma unroll
                for (int s2 = 0; s2 < 2; ++s2) { const s16x4 lo = vtr(vfrag + (8 * s2) * 512 + nb * 512), hh = vtr(vfrag + (8 * s2 + 4) * 512 + nb * 512);
                    const bf16x8 vf = (bf16x8){lo[0], lo[1], lo[2], lo[3], hh[0], hh[1], hh[2], hh[3]};
                    oT[nb] = __builtin_amdgcn_mfma_f32_32x32x16_bf16(vf, pf[s2], oT[nb], 0, 0, 0); }
        }
    }
    __syncthreads();
    LAS float* MG = (LAS float*)(C.lds + AT_MRG + qw * AT_MRG_STRIDE);
    if (kg == 1) { if (hi == 0) { MG[2 * ql] = m_run; MG[2 * ql + 1] = l_run; }
#pragma unroll
        for (int nb = 0; nb < 4; ++nb)
#pragma unroll
            for (int r = 0; r < 16; ++r) MG[64 + (nb * 16 + r) * 64 + lane] = oT[nb][r]; }
    LDS_WAIT(); __syncthreads();
    if (kg == 0) { const float m2 = MG[2 * ql], l2 = MG[2 * ql + 1], mm = fmaxf(m_run, m2), a1 = __builtin_amdgcn_exp2f(m_run - mm), a2 = __builtin_amdgcn_exp2f(m2 - mm);
        const float inv = 1.0f / (a1 * l_run + a2 * l2); const float c1 = a1 * inv, c2 = a2 * inv;
        bf16_t* O = WSP(bf16_t, WS_OB) + (size_t)qpos * HGW + h * MV + 4 * hi;
#pragma unroll
        for (int nb = 0; nb < 4; ++nb)
#pragma unroll
            for (int g = 0; g < 4; ++g) { float o[4];
#pragma unroll
                for (int i = 0; i < 4; ++i) { const int r = 4 * g + i; o[i] = c1 * oT[nb][r] + c2 * MG[64 + (nb * 16 + r) * 64 + lane]; }
                u32x2 w; w.x = cvt_pk_bf16(o[0], o[1]); w.y = cvt_pk_bf16(o[2], o[3]); *(u32x2*)(O + 32 * nb + 8 * g) = w; } }
    LDS_WAIT();
}

constexpr int TK_K1 = 0, TK_K2 = 34816, TK_KSTR = 272, TK_IDX = 69632;
__device__ __forceinline__ int f2ord(float f) { const int i = __float_as_int(f); return i >= 0 ? i : (i ^ 0x7fffffff); }
__device__ __forceinline__ float ord2f(int k) { return __int_as_float(k >= 0 ? k : (k ^ 0x7fffffff)); }
#define TK_INS(L, x) do { int _x = (x); _Pragma("unroll") for (int _i = 0; _i < 16; ++_i) { const int _t = max(L[_i], _x); _x = min(L[_i], _x); L[_i] = _t; } } while (0)
__device__ __forceinline__ void topk_stage_keys(const Ctx& C) {
#pragma unroll
    for (int i = 0; i < 8; ++i) { const int cid = C.tid + 512 * i, tb = cid >> 11, r = (cid >> 4) & 127, cc = cid & 15;
        *(LAS u32x4*)(C.lds + tb * TK_K2 + r * TK_KSTR + cc * 16) = *(const u32x4*)(WSP(bf16_t, tb ? WS_K2B : WS_K1B) + r * 128 + cc * 8); }
    LDS_WAIT(); __syncthreads();
}
__device__ __forceinline__ void topk_wave(const Ctx& C, int tb, int head) {
    const int lane = C.lane, tl = lane & 31, hi = lane >> 5, t = tb * 32 + tl;
    int v12[2][16];
#pragma unroll
    for (int half = 0; half < 2; ++half) {
        f32x16 acc[4];
#pragma unroll
        for (int kt = 0; kt < 4; ++kt) acc[kt] = (f32x16){0.f, 0.f, 0.f, 0.f, 0.f, 0.f, 0.f, 0.f, 0.f, 0.f, 0.f, 0.f, 0.f, 0.f, 0.f, 0.f};
        const bf16_t* qp = WSP(bf16_t, WS_QP) + (size_t)t * DM + head * PQD + half * 128 + 8 * hi; const LAS unsigned char* kp = C.lds + half * TK_K2 + tl * TK_KSTR + 16 * hi;
#pragma unroll
        for (int ks = 0; ks < 8; ++ks) { const bf16x8 bq = *(const bf16x8*)(qp + 16 * ks);
#pragma unroll
            for (int kt = 0; kt < 4; ++kt) { const bf16x8 ak = *(const LAS bf16x8*)(kp + kt * 32 * TK_KSTR + 32 * ks); acc[kt] = __builtin_amdgcn_mfma_f32_32x32x16_bf16(ak, bq, acc[kt], 0, 0, 0); } }
        int L[16];
#pragma unroll
        for (int i = 0; i < 16; ++i) L[i] = (int)0x80000000;
#pragma unroll
        for (int kt = 0; kt < 4; ++kt)
#pragma unroll
            for (int r = 0; r < 16; ++r) { const int key = 32 * kt + (r & 3) + 8 * (r >> 2) + 4 * hi; TK_INS(L, (f2ord(acc[kt][r]) & ~127) | (127 - key)); }
        int P[16];
#pragma unroll
        for (int i = 0; i < 16; ++i) P[i] = __shfl_xor(L[i], 32);
#pragma unroll
        for (int i = 0; i < 16; ++i) TK_INS(L, P[i]);
#pragma unroll
        for (int i = 0; i < 16; ++i) v12[half][i] = L[i];
    }
    LAS int* IDX = (LAS int*)(C.lds + TK_IDX + 4096 * C.wave) + tl * 32;
#pragma unroll
    for (int g = 0; g < 4; ++g) { u32x4 w;
#pragma unroll
        for (int i = 0; i < 4; ++i) w[i] = (unsigned)(127 - ((hi ? v12[1][4 * g + i] : v12[0][4 * g + i]) & 127));
        *(LAS u32x4*)(IDX + 16 * hi + 4 * g) = w; }
    float f1[16], f2[16];
#pragma unroll
    for (int i = 0; i < 16; ++i) { f1[i] = ord2f(v12[0][i] & ~127); f2[i] = ord2f(v12[1][i] & ~127); }
    int CL[16];
#pragma unroll
    for (int i = 0; i < 16; ++i) CL[i] = (int)0x80000000;
#pragma unroll
    for (int ca = 0; ca < 16; ++ca)
#pragma unroll
        for (int cb = 0; cb < 16; ++cb) if ((ca + 1) * (cb + 1) <= 16) TK_INS(CL, (f2ord(f1[ca] + f2[cb]) & ~255) | (255 - (ca * 16 + cb)));
    float rs;
    { const f32x4* sp = (const f32x4*)(WSP(float, WS_SSQ1) + (size_t)t * 32 + 16 * hi); const f32x4 s0 = sp[0], s1 = sp[1], s2 = sp[2], s3 = sp[3];
      float ss = ((s0[0] + s0[1]) + (s0[2] + s0[3])) + ((s1[0] + s1[1]) + (s1[2] + s1[3])) + ((s2[0] + s2[1]) + (s2[2] + s2[3])) + ((s3[0] + s3[1]) + (s3[2] + s3[3]));
      ss += __shfl_xor(ss, 32); rs = __builtin_amdgcn_rsqf(ss * (1.0f / DM) + EPS); }
    float ev[16], sm = 0.f; const float mx = ord2f(CL[0] & ~255);
#pragma unroll
    for (int i = 0; i < 16; ++i) { ev[i] = __expf((ord2f(CL[i] & ~255) - mx) * rs); sm += ev[i]; }
    const float inv = 1.0f / sm;
    LDS_WAIT();
    int eo[8]; float go[8];
#pragma unroll
    for (int i = 0; i < 8; ++i) { const int ck = hi ? CL[8 + i] : CL[i]; const int ab = 255 - (ck & 255); eo[i] = IDX[ab >> 4] * PNK + IDX[16 + (ab & 15)]; go[i] = (hi ? ev[8 + i] : ev[i]) * inv; }
    int* ep = WSP(int, WS_EIDX) + (size_t)t * 128 + head * 16 + 8 * hi; float* gp = WSP(float, WS_GATE) + (size_t)t * 128 + head * 16 + 8 * hi;
    *(u32x4*)ep = (u32x4){(unsigned)eo[0], (unsigned)eo[1], (unsigned)eo[2], (unsigned)eo[3]}; *(u32x4*)(ep + 4) = (u32x4){(unsigned)eo[4], (unsigned)eo[5], (unsigned)eo[6], (unsigned)eo[7]};
    *(f32x4*)gp = (f32x4){go[0], go[1], go[2], go[3]}; *(f32x4*)(gp + 4) = (f32x4){go[4], go[5], go[6], go[7]};
    LDS_WAIT();
}

__device__ __forceinline__ void fp8_row(const float* src, unsigned char* dst, float* scale, int row, int lane) {
    const float* xr = src + (size_t)row * DM + 16 * lane; f32x4 v[8]; float am = 0.f;
#pragma unroll
    for (int j = 0; j < 2; ++j)
#pragma unroll
        for (int i = 0; i < 4; ++i) { v[4 * j + i] = *(const f32x4*)(xr + 1024 * j + 4 * i); am = fmaxf(am, fmaxf(fmaxf(fabsf(v[4 * j + i][0]), fabsf(v[4 * j + i][1])), fmaxf(fabsf(v[4 * j + i][2]), fabsf(v[4 * j + i][3])))); }
#pragma unroll
    for (int o = 1; o < 64; o <<= 1) am = fmaxf(am, __shfl_xor(am, o));
    const float sc = am > 0.f ? am * (1.0f / 240.0f) : 1.0f, inv = am > 0.f ? 240.0f / am : 1.0f;
    if (lane == 0) scale[row] = sc;
#pragma unroll
    for (int j = 0; j < 2; ++j) { u32x4 w;
#pragma unroll
        for (int i = 0; i < 4; ++i) { const f32x4 y = v[4 * j + i] * inv; int p = 0; p = __builtin_amdgcn_cvt_pk_fp8_f32(y[0], y[1], p, false); p = __builtin_amdgcn_cvt_pk_fp8_f32(y[2], y[3], p, true); w[i] = (unsigned)p; }
        *(u32x4*)(dst + (size_t)row * DM + 1024 * j + 16 * lane) = w; }
}
__device__ __forceinline__ float gelu_erf(float z) { return 0.5f * z * (1.0f + erff(z * 0.70710678118654752f)); }
__device__ __forceinline__ void peer_token(const Ctx& C, int t) {
    const int lane = C.lane; const float* xr = C.out + (size_t)t * DM + 16 * lane;
    f32x2 hn[16]; float ss = 0.f;
    { const float* gn = IP(14) + 16 * lane; f32x4 xv[8];
#pragma unroll
      for (int j = 0; j < 2; ++j)
#pragma unroll
        for (int i = 0; i < 4; ++i) { xv[4 * j + i] = *(const f32x4*)(xr + 1024 * j + 4 * i); ss += sumsq4(xv[4 * j + i]); }
      const float rs = __builtin_amdgcn_rsqf(wave_sum(ss) * (1.0f / DM) + EPS);
#pragma unroll
      for (int j = 0; j < 2; ++j)
#pragma unroll
        for (int i = 0; i < 4; ++i) { const f32x4 y = xv[4 * j + i] * rs * *(const f32x4*)(gn + 1024 * j + 4 * i); hn[8 * j + 2 * i] = (f32x2){y[0], y[1]}; hn[8 * j + 2 * i + 1] = (f32x2){y[2], y[3]}; } }
    const int e0 = WSP(int, WS_EIDX)[(size_t)t * 128 + lane], e1 = WSP(int, WS_EIDX)[(size_t)t * 128 + 64 + lane];
    const float g0 = WSP(float, WS_GATE)[(size_t)t * 128 + lane], g1 = WSP(float, WS_GATE)[(size_t)t * 128 + 64 + lane];
    const float su0 = WSP(float, WS_SU)[e0], su1 = WSP(float, WS_SU)[e1];
    const float gv0 = g0 * WSP(float, WS_SV)[e0], gv1 = g1 * WSP(float, WS_SV)[e1];
    f32x2 oa[16];
#pragma unroll
    for (int j = 0; j < 16; ++j) oa[j] = (f32x2){0.f, 0.f};
    const unsigned char* U = WSP(unsigned char, WS_U8) + 16 * lane; const unsigned char* V = WSP(unsigned char, WS_V8) + 16 * lane;
    constexpr int EB = 4;
    for (int eb = 0; eb < 128; eb += EB) {
        u32x4 uw[EB][2], vw[EB][2]; float z[EB], cf[EB], us[EB];
#pragma unroll
        for (int k = 0; k < EB; ++k) { const int ei = eb + k; const int e = ei < 64 ? __builtin_amdgcn_readlane(e0, ei) : __builtin_amdgcn_readlane(e1, ei - 64);
            us[k] = __int_as_float(ei < 64 ? __builtin_amdgcn_readlane(__float_as_int(su0), ei) : __builtin_amdgcn_readlane(__float_as_int(su1), ei - 64));
            cf[k] = __int_as_float(ei < 64 ? __builtin_amdgcn_readlane(__float_as_int(gv0), ei) : __builtin_amdgcn_readlane(__float_as_int(gv1), ei - 64));
#pragma unroll
            for (int j = 0; j < 2; ++j) { uw[k][j] = *(const u32x4*)(U + (size_t)e * DM + 1024 * j); vw[k][j] = *(const u32x4*)(V + (size_t)e * DM + 1024 * j); } }
#pragma unroll
        for (int k = 0; k < EB; ++k) { f32x2 s = {0.f, 0.f};
#pragma unroll
            for (int j = 0; j < 2; ++j)
#pragma unroll
                for (int i = 0; i < 4; ++i) { const int w = (int)uw[k][j][i]; s += __builtin_amdgcn_cvt_pk_f32_fp8(w, false) * hn[8 * j + 2 * i]; s += __builtin_amdgcn_cvt_pk_f32_fp8(w, true) * hn[8 * j + 2 * i + 1]; }
            z[k] = s.x + s.y; }
#pragma unroll
        for (int o = 1; o < 64; o <<= 1) {
#pragma unroll
            for (int k = 0; k < EB; ++k) z[k] += __shfl_xor(z[k], o); }
#pragma unroll
        for (int k = 0; k < EB; ++k) { const float a = gelu_erf(z[k] * us[k]) * cf[k];
#pragma unroll
            for (int j = 0; j < 2; ++j)
#pragma unroll
                for (int i = 0; i < 4; ++i) { const int w = (int)vw[k][j][i]; oa[8 * j + 2 * i] += __builtin_amdgcn_cvt_pk_f32_fp8(w, false) * a; oa[8 * j + 2 * i + 1] += __builtin_amdgcn_cvt_pk_f32_fp8(w, true) * a; } }
    }
    float s2 = 0.f; bf16_t* xg = WSP(bf16_t, WS_ACTA) + (size_t)t * DM + 16 * lane; float* x2r = WSP(float, WS_X2) + (size_t)t * DM + 16 * lane; const float* gp = IP(20) + 16 * lane;
#pragma unroll
    for (int j = 0; j < 2; ++j) { f32x4 r[4];
#pragma unroll
        for (int i = 0; i < 4; ++i) { const f32x4 o = {oa[8 * j + 2 * i].x, oa[8 * j + 2 * i].y, oa[8 * j + 2 * i + 1].x, oa[8 * j + 2 * i + 1].y}; r[i] = *(const f32x4*)(xr + 1024 * j + 4 * i) + o;
            *(f32x4*)(x2r + 1024 * j + 4 * i) = r[i]; s2 += sumsq4(r[i]); r[i] = r[i] * *(const f32x4*)(gp + 1024 * j + 4 * i); }
        *(u32x4*)(xg + 1024 * j) = pack8(r[0], r[1]); *(u32x4*)(xg + 1024 * j + 8) = pack8(r[2], r[3]); }
    s2 = wave_sum(s2); if (lane == 0) WSP(float, WS_SSQ2)[t] = s2;
}
__device__ __forceinline__ void final_row(const Ctx& C, int t) {
    const int lane = C.lane; float pz = lane < 32 ? WSP(float, WS_SSQ3)[(size_t)t * 32 + lane] : 0.f;
    const float rs = __builtin_amdgcn_rsqf(wave_sum(pz) * (1.0f / DM) + EPS);
    f32x4* xr = (f32x4*)(C.out + (size_t)t * DM) + lane; const f32x4* gr = (const f32x4*)IP(23) + lane;
#pragma unroll
    for (int j = 0; j < 8; ++j) xr[64 * j] = xr[64 * j] * rs * gr[64 * j];
}

constexpr int NPHASE = 12;
#ifndef MK_ONE_LAUNCH
#define MK_ONE_LAUNCH 1
#endif
constexpr int LDS_BYTES = 147456;
constexpr int MISC_OFF = 131072 + 320;
struct Args { const void* in[24]; float* out; unsigned char* ws; int ph_lo, ph_hi; };
#define GEMM_ALIGN true
#define GEMM_SP2 true

__global__ void __launch_bounds__(512, 2) mk_fwd(Args args) {
    extern __shared__ __attribute__((aligned(16))) unsigned char lds_raw[];
    Ctx C;
    C.lds = (LAS unsigned char*)lds_raw; C.tid = threadIdx.x; C.lane = C.tid & 63; C.wave = __builtin_amdgcn_readfirstlane(C.tid >> 6); C.G = gridDim.x; C.bid = blockIdx.x;
    C.out = (float*)karg_ptr(24); C.ws = (unsigned char*)karg_ptr(25);
    volatile LAS unsigned* MISC = (volatile LAS unsigned*)(C.lds + MISC_OFF);
    if (C.tid < 32) MISC[C.tid] = 0u;
    __syncthreads();
    const int lo = ((const int __attribute__((address_space(4)))*)__builtin_amdgcn_kernarg_segment_ptr())[52], hi = ((const int __attribute__((address_space(4)))*)__builtin_amdgcn_kernarg_segment_ptr())[53];
    const bool multi = (hi - lo) > 1;
    XcdBarrier bar; bar.bar = (unsigned*)(C.ws + WS_CTL) + 1024; bar.x = 0; bar.st = nullptr;
    if (multi) bar = xcd_barrier_post((unsigned*)(C.ws + WS_CTL) + 1024, MISC + 8);
    LAS unsigned char* L = C.lds;
    const int gw = C.bid * 8 + C.wave, NGW = C.G * 8;

    if (lo <= 0 && 0 < hi) {
 phase_prep(C);
    }
    if (lo <= 0 && 1 < hi) xcd_barrier(bar);
    if (lo <= 1 && 1 < hi) {
        pg8::Gemm g{WSP(bf16_t, WS_ACTA), WSP(bf16_t, WS_WINT), T, INW_PAD, DM}; pg8::StaticOrder S; S.init(T, INW_PAD, C.G, C.bid);
        pg8::EpiProj E{WSP(bf16_t, WS_HQ), WSP(bf16_t, WS_HV), WSP(bf16_t, WS_HOG), WSP(bf16_t, WS_MQG), WSP(bf16_t, WS_MKVG), WSP(bf16_t, WS_GA), WSP(bf16_t, WS_GB), WSP(bf16_t, WS_K),
                       WSP(float, WS_F), WSP(float, WS_SSQQ), WSP(float, WS_SSQKV), WSP(float, WS_LB), IP(7), IP(8), WSP(pg8::f32x2, WS_CS)};
        pg8::gemm_phase<pg8::EpiProj, pg8::StaticOrder, GEMM_ALIGN, GEMM_SP2>(L, g, S, E);

    }
    if (lo <= 1 && 2 < hi) xcd_barrier(bar);
    if (lo <= 2 && 2 < hi) {
        { pg8::Gemm g{WSP(bf16_t, WS_MQG), WSP(bf16_t, WS_WUQT), T, MH * MQK, MQL}; pg8::StaticOrder S; S.init(T, MH * MQK, C.G, C.bid);
          pg8::EpiQ E{WSP(bf16_t, WS_Q), WSP(float, WS_SSQQ), WSP(pg8::f32x2, WS_CS)};
          pg8::gemm_phase<pg8::EpiQ, pg8::StaticOrder, GEMM_ALIGN, GEMM_SP2>(L, g, S, E); }
        { pg8::Gemm g{WSP(bf16_t, WS_MKVG), WSP(bf16_t, WS_WUKVT), T, 2048, MKVL}; pg8::StaticOrder S; S.init(T, 2048, C.G, C.bid);
          pg8::EpiKV E{WSP(bf16_t, WS_K), WSP(bf16_t, WS_V), WSP(float, WS_SSQKV)};
          pg8::gemm_phase<pg8::EpiKV, pg8::StaticOrder, GEMM_ALIGN, GEMM_SP2>(L, g, S, E); }
        __syncthreads();
        for (int u = C.bid; u < HGH * HGNC; u += C.G) hgrn_a_unit(C, u >> 7, u & 127);

    }
    if (lo <= 2 && 3 < hi) xcd_barrier(bar);
    if (lo <= 3 && 3 < hi) {
        hgrn_scan(C);
        for (int pr = C.bid; pr < 256; pr += C.G) { const int h = pr >> 5, s = pr & 31; attn_unit(C, h, 63 - s); attn_unit(C, h, s); }

    }
    if (lo <= 3 && 4 < hi) xcd_barrier(bar);
    if (lo <= 4 && 4 < hi) {
        __syncthreads();
        for (int u = C.bid; u < HGH * HGNC; u += C.G) hgrn_c_unit(C, u >> 7, u & 127);
        __syncthreads();
        pg8::Gemm g{WSP(bf16_t, WS_OB), WSP(bf16_t, WS_WBT), T, DM, HGW}; pg8::StaticOrder S; S.init(T, DM, C.G, C.bid);
        pg8::EpiYb E{WSP(bf16_t, WS_GB), WSP(bf16_t, WS_YB)};
        pg8::gemm_phase<pg8::EpiYb, pg8::StaticOrder, GEMM_ALIGN, GEMM_SP2>(L, g, S, E);

    }
    if (lo <= 4 && 5 < hi) xcd_barrier(bar);
    if (lo <= 5 && 5 < hi) {
        for (int r = gw; r < 2 * PNK * PNK; r += NGW) { if (r < PNK * PNK) fp8_row(IP(18), WSP(unsigned char, WS_U8), WSP(float, WS_SU), r, C.lane); else fp8_row(IP(19), WSP(unsigned char, WS_V8), WSP(float, WS_SV), r - PNK * PNK, C.lane); }
        pg8::Gemm g{WSP(bf16_t, WS_OA), WSP(bf16_t, WS_WAT), T, DM, HGW}; pg8::StaticOrder S; S.init(T, DM, C.G, C.bid);
        pg8::EpiY E{WSP(bf16_t, WS_GA), WSP(bf16_t, WS_YB), WSP(bf16_t, WS_Y)};
        pg8::gemm_phase<pg8::EpiY, pg8::StaticOrder, GEMM_ALIGN, GEMM_SP2>(L, g, S, E);

    }
    if (lo <= 5 && 6 < hi) xcd_barrier(bar);
    if (lo <= 6 && 6 < hi) {
        pg8::Gemm g{WSP(bf16_t, WS_Y), WSP(bf16_t, WS_WOT), T, DM, DM}; pg8::StaticOrder S; S.init(T, DM, C.G, C.bid);
        pg8::EpiX1 E{IP(0), IP(14), C.out, WSP(float, WS_SSQ1), WSP(bf16_t, WS_ACTA)};
        pg8::gemm_phase<pg8::EpiX1, pg8::StaticOrder, GEMM_ALIGN, GEMM_SP2>(L, g, S, E);

    }
    if (lo <= 6 && 7 < hi) xcd_barrier(bar);
    if (lo <= 7 && 7 < hi) {
        { pg8::Gemm g{WSP(bf16_t, WS_ACTA), WSP(bf16_t, WS_WQT), T, DM, DM}; pg8::StaticOrder S; S.init(T, DM, C.G, C.bid);
          pg8::EpiPlain E{WSP(bf16_t, WS_QP), DM};
          pg8::gemm_phase<pg8::EpiPlain, pg8::StaticOrder, GEMM_ALIGN, GEMM_SP2>(L, g, S, E); }
        { pg8::Gemm g{WSP(bf16_t, WS_PBF), WSP(bf16_t, WS_WPET), T, DM, PLE}; pg8::StaticOrder S; S.init(T, DM, C.G, C.bid);
          pg8::EpiPlain E{WSP(bf16_t, WS_PE), DM};
          pg8::gemm_phase<pg8::EpiPlain, pg8::StaticOrder, GEMM_ALIGN, GEMM_SP2>(L, g, S, E); }

    }
    if (lo <= 7 && 8 < hi) xcd_barrier(bar);
    if (lo <= 8 && 8 < hi) {
        __syncthreads();
        topk_stage_keys(C);
        for (int wu = gw; wu < (T / 32) * PH; wu += NGW) topk_wave(C, wu >> 3, wu & 7);
        __syncthreads();

    }
    if (lo <= 8 && 9 < hi) xcd_barrier(bar);
    if (lo <= 9 && 9 < hi) {
        for (int t = gw; t < T; t += NGW) peer_token(C, t);

    }
    if (lo <= 9 && 10 < hi) xcd_barrier(bar);
    if (lo <= 10 && 10 < hi) {
        pg8::Gemm g{WSP(bf16_t, WS_ACTA), WSP(bf16_t, WS_WPGT), T, DM, DM}; pg8::StaticOrder S; S.init(T, DM, C.G, C.bid);
        pg8::EpiPle E{WSP(bf16_t, WS_PE), WSP(float, WS_SSQ2), WSP(float, WS_X2), C.out, WSP(float, WS_SSQ3)};
        pg8::gemm_phase<pg8::EpiPle, pg8::StaticOrder, GEMM_ALIGN, GEMM_SP2>(L, g, S, E);

    }
    if (lo <= 10 && 11 < hi) xcd_barrier(bar);
    if (lo <= 11 && 11 < hi) {
 for (int t = gw; t < T; t += NGW) final_row(C, t);
    }
    if (lo <= 11 && 12 < hi) xcd_barrier(bar);
}

extern "C" void kernel_launch(void* const* d_in, const int* in_sizes, int n_in, void* d_out, int out_size, void* d_ws, size_t ws_size, hipStream_t stream) {
    static int grid = 0;
    if (grid == 0) {
        if (n_in != 24 || out_size != T * DM || ws_size < WS_END) { fprintf(stderr, "kernel_launch: unexpected shapes: n_in %d out %d ws %zu (need %zu)\n", n_in, out_size, ws_size, (size_t)WS_END); grid = -1; return; }
        int dev = 0, cus = 0;
        if (hipGetDevice(&dev) != hipSuccess || hipDeviceGetAttribute(&cus, hipDeviceAttributeMultiprocessorCount, dev) != hipSuccess) { grid = -1; return; }
        if (hipFuncSetAttribute((const void*)mk_fwd, hipFuncAttributeMaxDynamicSharedMemorySize, LDS_BYTES) != hipSuccess) { fprintf(stderr, "kernel_launch: hipFuncSetAttribute failed\n"); grid = -1; return; }
        (void)hipGetLastError();
        grid = cus;
    }
    if (grid < 0) return;
    (void)hipMemsetAsync((char*)d_ws + WS_CTL, 0, CTL_ZERO_BYTES, stream);
    Args a{};
    for (int i = 0; i < 24; ++i) a.in[i] = d_in[i];
    a.out = (float*)d_out; a.ws = (unsigned char*)d_ws;
#if MK_ONE_LAUNCH
    a.ph_lo = 0; a.ph_hi = NPHASE;
    hipLaunchKernelGGL(mk_fwd, dim3(grid), dim3(512), LDS_BYTES, stream, a);
#else
    for (int ph = 0; ph < NPHASE; ++ph) { a.ph_lo = ph; a.ph_hi = ph + 1; hipLaunchKernelGGL(mk_fwd, dim3(grid), dim3(512), LDS_BYTES, stream, a); }
#endif
}
```

```cpp
#include <hip/hip_runtime.h>
#include <cstdio>
#include <cstdint>

constexpr int T = 8192, DM = 2048, PLE = 256;
constexpr int HGH = 8, HGD = 128, HGW = 1024, HGC = 64, HGNC = T / HGC;
constexpr int MH = 8, MNOPE = 128, MROPE = 64, MV = 128, MQL = 512, MKVL = 512, MQK = 192;
constexpr int PH = 8, PNK = 128, PQD = 256, PK = 16;
constexpr int INW = 9280, INW_PAD = 9472;
constexpr float EPS = 1e-6f;

namespace pg8 {
#define PG8_LAS __attribute__((address_space(3)))
typedef unsigned short bf16_t;
typedef short bf16x8 __attribute__((ext_vector_type(8)));
typedef float f32x4 __attribute__((ext_vector_type(4)));
typedef unsigned u32x4 __attribute__((ext_vector_type(4)));
constexpr int BM = 256, BK = 64, HALF = 128, HTB = HALF * BK * 2  , STAGE_BYTES = 8 * HTB, NXCD = 8, WGM = 8;

__host__ __device__ __forceinline__ int lds_byte(int r, int c) { const int st = (r >> 4) * 2 + (c >> 5), rr = r & 15, cc = c & 31, ob = rr * 64 + cc * 2; return st * 1024 + (ob ^ (((ob >> 9) & 1) << 5)); }
__host__ __device__ __forceinline__ void stage_rc(int b, int& R, int& C) { const int st = b / 1024, sb = b % 1024, swz = sb ^ (((sb >> 9) & 1) << 5); R = (st >> 1) * 16 + swz / 64; C = (st & 1) * 32 + (swz % 64) / 2; }
__host__ __device__ __forceinline__ int perm32(int rho) { const int n = rho >> 4, i = rho & 15; return 8 * (i >> 2) + 4 * n + (i & 3); }

struct Unit { int pm, pn; };
struct Gemm { const bf16_t* A; const bf16_t* Bt; int M, N, K; };

struct StaticOrder {
    int nM, nN, nwg, G, c;
    __host__ __device__ void init(int M, int N, int G_, int c_) { nM = M / BM; nN = N / BM; nwg = nM * nN; G = G_; c = c_; }
    __host__ __device__ bool next(int i, Unit& u) const {
        const long L = (long)i * G + c; if (L >= nwg) return false;
        int wgid = (int)L; { const int q = nwg / NXCD, r = nwg % NXCD, xcd = wgid % NXCD, off = wgid / NXCD; wgid = (xcd < r ? xcd * (q + 1) : r * (q + 1) + (xcd - r) * q) + off; }
        const int nig = WGM * nN, gid = wgid / nig, fm = gid * WGM, gsz = (nM - fm) < WGM ? (nM - fm) : WGM;
        u.pm = fm + ((wgid % nig) % gsz); u.pn = (wgid % nig) / gsz; return true;
    }
    __device__ __forceinline__ void a_ready(const Unit&) const {}
    __device__ __forceinline__ void done(const Unit&) const {}
};


typedef float f32x2 __attribute__((ext_vector_type(2)));
typedef __bf16 bf16x2_t __attribute__((ext_vector_type(2)));
__device__ __forceinline__ unsigned cvt_pk_bf16(float lo, float hi) { const f32x2 v = {lo, hi}; const bf16x2_t b = __builtin_convertvector(v, bf16x2_t); return __builtin_bit_cast(unsigned, b); }
__device__ __forceinline__ u32x4 pack8(const f32x4 a, const f32x4 b) { u32x4 w; w.x = cvt_pk_bf16(a[0], a[1]); w.y = cvt_pk_bf16(a[2], a[3]); w.z = cvt_pk_bf16(b[0], b[1]); w.w = cvt_pk_bf16(b[2], b[3]); return w; }
__device__ __forceinline__ void unpack8(const u32x4 w, f32x4& a, f32x4& b) {
    a[0] = __uint_as_float(w.x << 16); a[1] = __uint_as_float(w.x & 0xffff0000u); a[2] = __uint_as_float(w.y << 16); a[3] = __uint_as_float(w.y & 0xffff0000u);
    b[0] = __uint_as_float(w.z << 16); b[1] = __uint_as_float(w.z & 0xffff0000u); b[2] = __uint_as_float(w.w << 16); b[3] = __uint_as_float(w.w & 0xffff0000u); }
__device__ __forceinline__ float sigm(float v) { return __builtin_amdgcn_rcpf(1.0f + __expf(-v)); }
__device__ __forceinline__ f32x4 sigm4(const f32x4 v) { return (f32x4){sigm(v[0]), sigm(v[1]), sigm(v[2]), sigm(v[3])}; }
__device__ __forceinline__ float sumsq4(const f32x4 v) { return (v[0] * v[0] + v[1] * v[1]) + (v[2] * v[2] + v[3] * v[3]); }

#define EPI_ROWS_BEGIN _Pragma("unroll") for (int ai = 0; ai < 2; ++ai) _Pragma("unroll") for (int m = 0; m < 4; ++m) { const int row = u.pm * BM + ai * HALF + wr * 64 + m * 16 + fr;
#define EPI_COLS_BEGIN _Pragma("unroll") for (int bj = 0; bj < 2; ++bj) { const int col = u.pn * BM + bj * HALF + wc * 32 + 8 * fq; const f32x4 v0 = acc[ai][bj][m][0], v1 = acc[ai][bj][m][1];
#define EPI_COLS_END }
#define EPI_ROWS_END }
typedef const f32x4 (&AccRef)[2][2][4][2];

struct EpiProj {
    static constexpr bool PERM = true, AFTER_DRAIN = false;
    bf16_t *HQ, *HV, *HOG, *MQG, *MKVG, *GA, *GB, *KB; float *F, *SSQQ, *SSQKV; const float *lb, *qn, *kvn; const f32x2* CS;
    __device__ __forceinline__ void operator()(AccRef acc, const Unit& u, int wr, int wc, int fr, int fq) const {
        const int seg = u.pn;
        EPI_ROWS_BEGIN
            float ss = 0.f;
            EPI_COLS_BEGIN
                if (seg < 4) { *(u32x4*)(HQ + (size_t)row * 1024 + col) = pack8(v0, v1); }
                else if (seg < 8) { const int c = col - 1024; const f32x4 l0 = *(const f32x4*)(lb + c), l1 = *(const f32x4*)(lb + c + 4);
                    const f32x4 f0 = l0 + (1.0f - l0) * sigm4(v0), f1 = l1 + (1.0f - l1) * sigm4(v1);
                    *(f32x4*)(F + (size_t)row * 1024 + c) = f0; *(f32x4*)(F + (size_t)row * 1024 + c + 4) = f1; }
                else if (seg < 12) { *(u32x4*)(HV + (size_t)row * 1024 + (col - 2048)) = pack8(v0, v1); }
                else if (seg < 16) { *(u32x4*)(HOG + (size_t)row * 1024 + (col - 3072)) = pack8(v0 * sigm4(v0), v1 * sigm4(v1)); }
                else if (seg < 18) { const int c = col - 4096; ss += sumsq4(v0) + sumsq4(v1);
                    *(u32x4*)(MQG + (size_t)row * 512 + c) = pack8(v0 * *(const f32x4*)(qn + c), v1 * *(const f32x4*)(qn + c + 4)); }
                else if (seg < 20) { const int c = col - 4608; ss += sumsq4(v0) + sumsq4(v1);
                    *(u32x4*)(MKVG + (size_t)row * 512 + c) = pack8(v0 * *(const f32x4*)(kvn + c), v1 * *(const f32x4*)(kvn + c + 4)); }
                else if (seg < 28) { *(u32x4*)(GA + (size_t)row * 2048 + (col - 5120)) = pack8(sigm4(v0), sigm4(v1)); }
                else if (seg < 36) { *(u32x4*)(GB + (size_t)row * 2048 + (col - 7168)) = pack8(sigm4(v0), sigm4(v1)); }
                else { const int c = col - 9216;
                    if (c < 64) { const f32x2* cs = CS + (size_t)row * 32 + (c >> 1); const f32x2 c0 = cs[0], c1 = cs[1], c2 = cs[2], c3 = cs[3];
                        f32x4 o0, o1; o0[0] = v0[0] * c0.x - v0[1] * c0.y; o0[1] = v0[1] * c0.x + v0[0] * c0.y; o0[2] = v0[2] * c1.x - v0[3] * c1.y; o0[3] = v0[3] * c1.x + v0[2] * c1.y;
                        o1[0] = v1[0] * c2.x - v1[1] * c2.y; o1[1] = v1[1] * c2.x + v1[0] * c2.y; o1[2] = v1[2] * c3.x - v1[3] * c3.y; o1[3] = v1[3] * c3.x + v1[2] * c3.y;
                        const u32x4 w = pack8(o0, o1);
#pragma unroll
                        for (int h = 0; h < MH; ++h) *(u32x4*)(KB + ((size_t)h * T + row) * MQK + MNOPE + c) = w; } }
            EPI_COLS_END
            if (seg >= 16 && seg < 20) { ss += __shfl_xor(ss, 16); ss += __shfl_xor(ss, 32);
                if (fq == 0) { float* S = seg < 18 ? SSQQ : SSQKV; S[(size_t)row * 8 + (seg & 1) * 4 + wc] = ss; } }
        EPI_ROWS_END
    }
};
constexpr float QSCALE = 0.07216878364870323f * 1.4426950408889634f;
struct EpiQ {
    static constexpr bool PERM = true, AFTER_DRAIN = false;
    bf16_t* Q; const float* SSQQ; const f32x2* CS;
    __device__ __forceinline__ void operator()(AccRef acc, const Unit& u, int wr, int wc, int fr, int fq) const {
        EPI_ROWS_BEGIN
            const f32x4 s0 = *(const f32x4*)(SSQQ + (size_t)row * 8), s1 = *(const f32x4*)(SSQQ + (size_t)row * 8 + 4);
            const float rs = __builtin_amdgcn_rsqf(((s0[0] + s0[1]) + (s0[2] + s0[3]) + (s1[0] + s1[1]) + (s1[2] + s1[3])) * (1.0f / MQL) + EPS) * QSCALE;
            EPI_COLS_BEGIN
                const int head = col / MQK, d = col - head * MQK; f32x4 a = v0 * rs, b = v1 * rs;
                if (d >= MNOPE) { const f32x2* cs = CS + (size_t)row * 32 + ((d - MNOPE) >> 1); const f32x2 c0 = cs[0], c1 = cs[1], c2 = cs[2], c3 = cs[3];
                    f32x4 o0, o1; o0[0] = a[0] * c0.x - a[1] * c0.y; o0[1] = a[1] * c0.x + a[0] * c0.y; o0[2] = a[2] * c1.x - a[3] * c1.y; o0[3] = a[3] * c1.x + a[2] * c1.y;
                    o1[0] = b[0] * c2.x - b[1] * c2.y; o1[1] = b[1] * c2.x + b[0] * c2.y; o1[2] = b[2] * c3.x - b[3] * c3.y; o1[3] = b[3] * c3.x + b[2] * c3.y; a = o0; b = o1; }
                *(u32x4*)(Q + ((size_t)head * T + row) * MQK + d) = pack8(a, b);
            EPI_COLS_END
        EPI_ROWS_END
    }
};
struct EpiKV {
    static constexpr bool PERM = true, AFTER_DRAIN = false;
    bf16_t *K, *V; const float* SSQKV;
    __device__ __forceinline__ void operator()(AccRef acc, const Unit& u, int wr, int wc, int fr, int fq) const {
        EPI_ROWS_BEGIN
            const f32x4 s0 = *(const f32x4*)(SSQKV + (size_t)row * 8), s1 = *(const f32x4*)(SSQKV + (size_t)row * 8 + 4);
            const float rs = __builtin_amdgcn_rsqf(((s0[0] + s0[1]) + (s0[2] + s0[3]) + (s1[0] + s1[1]) + (s1[2] + s1[3])) * (1.0f / MKVL) + EPS);
            EPI_COLS_BEGIN
                const int head = col >> 8, d = col & 255; const u32x4 w = pack8(v0 * rs, v1 * rs);
                if (d < MNOPE) *(u32x4*)(K + ((size_t)head * T + row) * MQK + d) = w; else *(u32x4*)(V + ((size_t)head * T + row) * MV + (d - MNOPE)) = w;
            EPI_COLS_END
        EPI_ROWS_END
    }
};
struct EpiPlain {
    static constexpr bool PERM = true, AFTER_DRAIN = false;
    bf16_t* O; int ldc;
    __device__ __forceinline__ void operator()(AccRef acc, const Unit& u, int wr, int wc, int fr, int fq) const {
        EPI_ROWS_BEGIN EPI_COLS_BEGIN *(u32x4*)(O + (size_t)row * ldc + col) = pack8(v0, v1); EPI_COLS_END EPI_ROWS_END
    }
};
struct EpiYb {
    static constexpr bool PERM = true, AFTER_DRAIN = false;
    const bf16_t* GB; bf16_t* YB;
    __device__ __forceinline__ void operator()(AccRef acc, const Unit& u, int wr, int wc, int fr, int fq) const {
        EPI_ROWS_BEGIN EPI_COLS_BEGIN f32x4 g0, g1; unpack8(*(const u32x4*)(GB + (size_t)row * DM + col), g0, g1); *(u32x4*)(YB + (size_t)row * DM + col) = pack8(v0 * g0, v1 * g1); EPI_COLS_END EPI_ROWS_END
    }
};
struct EpiY {
    static constexpr bool PERM = true, AFTER_DRAIN = false;
    const bf16_t *GA, *YB; bf16_t* Y;
    __device__ __forceinline__ void operator()(AccRef acc, const Unit& u, int wr, int wc, int fr, int fq) const {
        EPI_ROWS_BEGIN EPI_COLS_BEGIN f32x4 g0, g1, y0, y1; unpack8(*(const u32x4*)(GA + (size_t)row * DM + col), g0, g1); unpack8(*(const u32x4*)(YB + (size_t)row * DM + col), y0, y1);
            *(u32x4*)(Y + (size_t)row * DM + col) = pack8(v0 * g0 + y0, v1 * g1 + y1); EPI_COLS_END EPI_ROWS_END
    }
};
struct EpiX1 {
    static constexpr bool PERM = true, AFTER_DRAIN = false;
    const float *X, *gain; float *OUT, *SSQ; bf16_t* XG;
    __device__ __forceinline__ void operator()(AccRef acc, const Unit& u, int wr, int wc, int fr, int fq) const {
        EPI_ROWS_BEGIN
            float ss = 0.f;
            EPI_COLS_BEGIN
                const size_t o = (size_t)row * DM + col; const f32x4 a = *(const f32x4*)(X + o) + v0, b = *(const f32x4*)(X + o + 4) + v1;
                *(f32x4*)(OUT + o) = a; *(f32x4*)(OUT + o + 4) = b; ss += sumsq4(a) + sumsq4(b);
                *(u32x4*)(XG + o) = pack8(a * *(const f32x4*)(gain + col), b * *(const f32x4*)(gain + col + 4));
            EPI_COLS_END
            ss += __shfl_xor(ss, 16); ss += __shfl_xor(ss, 32);
            if (fq == 0) SSQ[(size_t)row * 32 + u.pn * 4 + wc] = ss;
        EPI_ROWS_END
    }
};
struct EpiPle {
    static constexpr bool PERM = true, AFTER_DRAIN = false;
    const bf16_t* PE; const float *SSQ2, *X2; float *OUT, *SSQ;
    __device__ __forceinline__ void operator()(AccRef acc, const Unit& u, int wr, int wc, int fr, int fq) const {
        EPI_ROWS_BEGIN
            const f32x4 q0 = *(const f32x4*)(SSQ2 + (size_t)row * 8), q1 = *(const f32x4*)(SSQ2 + (size_t)row * 8 + 4);
            const float rs = __builtin_amdgcn_rsqf((((q0[0] + q0[1]) + (q0[2] + q0[3])) + ((q1[0] + q1[1]) + (q1[2] + q1[3]))) * (1.0f / DM) + EPS); float ss = 0.f;
            EPI_COLS_BEGIN
                const size_t o = (size_t)row * DM + col; f32x4 p0, p1; unpack8(*(const u32x4*)(PE + o), p0, p1);
                const f32x4 a = *(const f32x4*)(X2 + o) + sigm4(v0 * rs) * p0, b = *(const f32x4*)(X2 + o + 4) + sigm4(v1 * rs) * p1;
                *(f32x4*)(OUT + o) = a; *(f32x4*)(OUT + o + 4) = b; ss += sumsq4(a) + sumsq4(b);
            EPI_COLS_END
            ss += __shfl_xor(ss, 16); ss += __shfl_xor(ss, 32);
            if (fq == 0) SSQ[(size_t)row * 32 + u.pn * 4 + wc] = ss;
        EPI_ROWS_END
    }
};

template <class Epi, class Sched, bool ALIGN_EPI = false, bool SP2 = false>
__device__ __forceinline__ void gemm_phase(PG8_LAS unsigned char* lds, const Gemm g, const Sched& S, const Epi& E) {
    const int tid = threadIdx.x, wid = __builtin_amdgcn_readfirstlane(tid >> 6), lane = tid & 63, wr = wid >> 2, wc = wid & 3, fr = lane & 15, fq = lane >> 4;
    const int K = g.K, nt = K / BK;
    unsigned voffA[2], voffB[2];
#pragma unroll
    for (int i = 0; i < 2; ++i) { int R, C; stage_rc(tid * 16 + i * 8192, R, C); const int Rb = Epi::PERM ? ((R & ~31) + perm32(R & 31)) : R;
        voffA[i] = (unsigned)(R * K + C) * 2u; voffB[i] = (unsigned)(Rb * K + C) * 2u; }
    const size_t kstep = (size_t)(BK * 2);
    const size_t hstep = (size_t)HALF * K * 2;
    const size_t tstep = 2 * hstep;
    const unsigned ldsw = (unsigned)wid * 1024u;
    const int aoff = lds_byte(wr * 64 + fr, fq * 8), boff = lds_byte(wc * 32 + fr, fq * 8);
#define PG8_SA(b, h) (((b) * 2 + (h)) * HTB)
#define PG8_SB(b, h) ((4 + (b) * 2 + (h)) * HTB)
#define PG8_STAGE(bufoff, gbase, voff) do { _Pragma("unroll") for (int _i = 0; _i < 2; ++_i) \
        __builtin_amdgcn_global_load_lds((const unsigned*)((const char*)(gbase) + (voff)[_i]), (PG8_LAS unsigned*)(lds + (bufoff) + ldsw + _i * 8192), 16, 0, 0); } while (0)
#define PG8_LDA(dst, b, h) do { _Pragma("unroll") for (int m = 0; m < 4; ++m) _Pragma("unroll") for (int k = 0; k < 2; ++k) dst[m][k] = *(const PG8_LAS bf16x8*)(lds + PG8_SA(b, h) + aoff + m * 2048 + k * 1024); } while (0)
#define PG8_LDB(dst, b, h) do { _Pragma("unroll") for (int n = 0; n < 2; ++n) _Pragma("unroll") for (int k = 0; k < 2; ++k) dst[n][k] = *(const PG8_LAS bf16x8*)(lds + PG8_SB(b, h) + boff + n * 2048 + k * 1024); } while (0)
#define PG8_MMA(ai, bj, At, Bt) do { __builtin_amdgcn_s_setprio(1); _Pragma("unroll") for (int m = 0; m < 4; ++m) _Pragma("unroll") for (int n = 0; n < 2; ++n) _Pragma("unroll") for (int k = 0; k < 2; ++k) \
        acc[ai][bj][m][n] = __builtin_amdgcn_mfma_f32_16x16x32_bf16(Bt[n][k], At[m][k], acc[ai][bj][m][n], 0, 0, 0); __builtin_amdgcn_s_setprio(0); } while (0)
#define PG8_WAIT_V(n) asm volatile("s_waitcnt vmcnt(" #n ")" ::: "memory")
#define PG8_WAIT_L(n) asm volatile("s_waitcnt lgkmcnt(" #n ")" ::: "memory")
#define PG8_BAR __builtin_amdgcn_s_barrier()
#define PG8_SCHED __builtin_amdgcn_sched_barrier(0)
    Unit cur, nxt; int ui = 0;
    if (!S.next(0, cur)) return;
    f32x4 acc[2][2][4][2];
#pragma unroll
    for (int a = 0; a < 2; ++a)
#pragma unroll
        for (int b = 0; b < 2; ++b)
#pragma unroll
            for (int m = 0; m < 4; ++m)
#pragma unroll
                for (int n = 0; n < 2; ++n) acc[a][b][m][n] = (f32x4){0.f, 0.f, 0.f, 0.f};
    bf16x8 At[4][2], B0[2][2], B1[2][2];
    const char* cA = (const char*)g.A + (size_t)cur.pm * tstep; const char* cB = (const char*)g.Bt + (size_t)cur.pn * tstep;
    S.a_ready(cur);
    if constexpr (SP2) {
        PG8_STAGE(PG8_SB(0, 0), cB, voffB); PG8_STAGE(PG8_SB(0, 1), cB + hstep, voffB); PG8_STAGE(PG8_SA(0, 0), cA, voffA); PG8_STAGE(PG8_SA(0, 1), cA + hstep, voffA);
        if (wr == 1) PG8_BAR;
        PG8_WAIT_V(2); PG8_BAR;
        PG8_STAGE(PG8_SB(1, 0), cB + kstep, voffB); PG8_STAGE(PG8_SA(1, 0), cA + kstep, voffA); PG8_STAGE(PG8_SB(1, 1), cB + hstep + kstep, voffB);
        PG8_WAIT_V(6); PG8_BAR;
    } else {
        PG8_STAGE(PG8_SB(0, 0), cB, voffB); PG8_STAGE(PG8_SA(0, 0), cA, voffA); PG8_STAGE(PG8_SB(0, 1), cB + hstep, voffB); PG8_STAGE(PG8_SA(0, 1), cA + hstep, voffA);
        if (wr == 1) PG8_BAR;
        PG8_WAIT_V(4); PG8_BAR;
        PG8_STAGE(PG8_SB(1, 0), cB + kstep, voffB); PG8_STAGE(PG8_SA(1, 0), cA + kstep, voffA); PG8_STAGE(PG8_SB(1, 1), cB + hstep + kstep, voffB);
        PG8_WAIT_V(6); PG8_BAR;
    }
    for (;;) {
        const bool has_next = S.next(ui + 1, nxt);
        const char* nA = has_next ? (const char*)g.A + (size_t)nxt.pm * tstep : cA; const char* nB = has_next ? (const char*)g.Bt + (size_t)nxt.pn * tstep : cB;
        for (int t = 0; t < nt; t += 2) {
            const bool last = (t == nt - 2);
            const char* a1 = cA + (size_t)(t + 1) * kstep;
            const char* a2 = last ? nA : cA + (size_t)(t + 2) * kstep; const char* b2 = last ? nB : cB + (size_t)(t + 2) * kstep;
            const char* a3 = a2 + kstep; const char* b3 = b2 + kstep;
            if (last && has_next) S.a_ready(nxt);
            if constexpr (SP2) {
            PG8_LDB(B0, 0, 0); PG8_LDB(B1, 0, 1); PG8_SCHED; PG8_LDA(At, 0, 0); PG8_STAGE(PG8_SA(1, 1), a1 + hstep, voffA);
            PG8_WAIT_V(8); PG8_WAIT_L(0); PG8_BAR; PG8_MMA(0, 0, At, B0); PG8_MMA(0, 1, At, B1); PG8_BAR; PG8_SCHED;
            PG8_LDA(At, 0, 1); PG8_STAGE(PG8_SB(0, 0), b2, voffB); PG8_STAGE(PG8_SB(0, 1), b2 + hstep, voffB); PG8_STAGE(PG8_SA(0, 0), a2, voffA);
            PG8_WAIT_V(8); PG8_WAIT_L(0); PG8_BAR; PG8_MMA(1, 0, At, B0); PG8_MMA(1, 1, At, B1); PG8_BAR; PG8_SCHED;
            PG8_LDB(B0, 1, 0); PG8_LDB(B1, 1, 1); PG8_SCHED; PG8_LDA(At, 1, 0); PG8_STAGE(PG8_SA(0, 1), a2 + hstep, voffA);
            PG8_WAIT_V(8); PG8_WAIT_L(0); PG8_BAR; PG8_MMA(0, 0, At, B0); PG8_MMA(0, 1, At, B1); PG8_BAR; PG8_SCHED;
            PG8_LDA(At, 1, 1); PG8_STAGE(PG8_SB(1, 0), b3, voffB); PG8_STAGE(PG8_SB(1, 1), b3 + hstep, voffB); PG8_STAGE(PG8_SA(1, 0), a3, voffA);
            PG8_WAIT_V(8); PG8_WAIT_L(0); PG8_BAR; PG8_MMA(1, 0, At, B0); PG8_MMA(1, 1, At, B1); PG8_BAR; PG8_SCHED;
            } else {
            PG8_LDB(B0, 0, 0); PG8_SCHED; PG8_LDA(At, 0, 0); PG8_STAGE(PG8_SA(1, 1), a1 + hstep, voffA);
            PG8_WAIT_L(8); PG8_BAR; PG8_WAIT_L(0); PG8_MMA(0, 0, At, B0); PG8_BAR; PG8_SCHED;
            PG8_LDB(B1, 0, 1); PG8_STAGE(PG8_SB(0, 0), b2, voffB);
            PG8_BAR; PG8_WAIT_L(0); PG8_MMA(0, 1, At, B1); PG8_BAR;
            PG8_LDA(At, 0, 1); PG8_STAGE(PG8_SA(0, 0), a2, voffA);
            PG8_BAR; PG8_WAIT_L(0); PG8_MMA(1, 0, At, B0); PG8_BAR; PG8_SCHED;
            PG8_STAGE(PG8_SB(0, 1), b2 + hstep, voffB);
            PG8_WAIT_V(6); PG8_BAR; PG8_MMA(1, 1, At, B1); PG8_BAR;
            PG8_LDB(B0, 1, 0); PG8_SCHED; PG8_LDA(At, 1, 0); PG8_STAGE(PG8_SA(0, 1), a2 + hstep, voffA);
            PG8_WAIT_L(8); PG8_BAR; PG8_WAIT_L(0); PG8_MMA(0, 0, At, B0); PG8_BAR; PG8_SCHED;
            PG8_LDB(B1, 1, 1); PG8_STAGE(PG8_SB(1, 0), b3, voffB);
            PG8_BAR; PG8_WAIT_L(0); PG8_MMA(0, 1, At, B1); PG8_BAR;
            PG8_LDA(At, 1, 1); PG8_STAGE(PG8_SA(1, 0), a3, voffA);
            PG8_BAR; PG8_WAIT_L(0); PG8_MMA(1, 0, At, B0); PG8_BAR; PG8_SCHED;
            PG8_STAGE(PG8_SB(1, 1), b3 + hstep, voffB);
            PG8_WAIT_V(6); PG8_BAR; PG8_MMA(1, 1, At, B1); PG8_BAR;
            }
        }
        if constexpr (ALIGN_EPI) { if (wr == 0) PG8_BAR; }
        if constexpr (!Epi::AFTER_DRAIN) { E(acc, cur, wr, wc, fr, fq); S.done(cur); }
        if (!has_next) break;
#pragma unroll
        for (int a = 0; a < 2; ++a)
#pragma unroll
            for (int b = 0; b < 2; ++b)
#pragma unroll
                for (int m = 0; m < 4; ++m)
#pragma unroll
                    for (int n = 0; n < 2; ++n) acc[a][b][m][n] = (f32x4){0.f, 0.f, 0.f, 0.f};
        cur = nxt; cA = nA; cB = nB; ++ui;
        if constexpr (ALIGN_EPI) { if (wr == 1) PG8_BAR; }
    }
    PG8_WAIT_V(0);
    if constexpr (!ALIGN_EPI) { if (wr == 0) PG8_BAR; }
    PG8_BAR;
    if constexpr (Epi::AFTER_DRAIN) { E.fused(acc, cur, wr, wc, fr, fq, lds, wid, lane); S.done(cur); }
#undef PG8_SA
#undef PG8_SB
#undef PG8_STAGE
#undef PG8_LDA
#undef PG8_LDB
#undef PG8_MMA
#undef PG8_WAIT_V
#undef PG8_WAIT_L
#undef PG8_BAR
#undef PG8_SCHED
}
}

#define LAS __attribute__((address_space(3)))
typedef unsigned short bf16_t;
typedef short bf16x8 __attribute__((ext_vector_type(8)));
typedef short s16x4 __attribute__((ext_vector_type(4)));
typedef float f32x2 __attribute__((ext_vector_type(2)));
typedef float f32x4 __attribute__((ext_vector_type(4)));
typedef float f32x16 __attribute__((ext_vector_type(16)));
typedef unsigned u32x2 __attribute__((ext_vector_type(2)));
typedef unsigned u32x4 __attribute__((ext_vector_type(4)));
using pg8::cvt_pk_bf16; using pg8::pack8; using pg8::unpack8; using pg8::sumsq4; using pg8::sigm;
#define LDS_WAIT() asm volatile("s_waitcnt lgkmcnt(0)" ::: "memory")
__device__ __forceinline__ float bf2f(unsigned short b) { return __uint_as_float((unsigned)b << 16); }
__device__ __forceinline__ unsigned short f2bf(float f) { return (unsigned short)(cvt_pk_bf16(f, 0.f) & 0xffffu); }
__device__ __forceinline__ float wave_sum(float v) {
#pragma unroll
    for (int o = 1; o < 64; o <<= 1) v += __shfl_xor(v, o);
    return v;
}

constexpr size_t MiB = 1u << 20;
constexpr size_t WS_CTL = 0, CTL_ZERO_BYTES = 64 * 1024;
constexpr size_t WS_LB = 1 * MiB;
constexpr size_t WS_K1B = WS_LB + 64 * 1024;
constexpr size_t WS_K2B = WS_K1B + 64 * 1024;
constexpr size_t WS_SSQQ = 2 * MiB;
constexpr size_t WS_SSQKV = WS_SSQQ + 256 * 1024;
constexpr size_t WS_SSQ2 = WS_SSQKV + 256 * 1024;
constexpr size_t WS_SSQ1 = 3 * MiB;
constexpr size_t WS_SSQ3 = 4 * MiB;
constexpr size_t WS_DECAY = 5 * MiB;
constexpr size_t WS_CS = 6 * MiB;
constexpr size_t WS_EIDX = 8 * MiB;
constexpr size_t WS_GATE = 12 * MiB;
constexpr size_t WS_WUQT = 16 * MiB, WS_WUKVT = 18 * MiB, WS_WAT = 20 * MiB, WS_WBT = 24 * MiB, WS_WOT = 28 * MiB, WS_WQT = 36 * MiB, WS_WPGT = 44 * MiB, WS_WPET = 52 * MiB, WS_PBF = 53 * MiB;
constexpr size_t WS_WINT = 58 * MiB;
constexpr size_t WS_SPT = 58 * MiB;
constexpr size_t WS_ACTA = 96 * MiB;
constexpr size_t WS_GA = 128 * MiB, WS_GB = 160 * MiB;
constexpr size_t WS_QP = WS_GA, WS_PE = WS_GB;
constexpr size_t WS_HQ = 192 * MiB, WS_F = 208 * MiB, WS_HV = 240 * MiB, WS_HOG = 256 * MiB, WS_Q = 272 * MiB, WS_K = 296 * MiB, WS_V = 320 * MiB;
constexpr size_t WS_U8 = 192 * MiB, WS_V8 = 224 * MiB;
constexpr size_t WS_SU = 1 * MiB + 256 * 1024, WS_SV = WS_SU + 64 * 1024;
constexpr size_t WS_MQG = 336 * MiB, WS_MKVG = 344 * MiB, WS_OB = 336 * MiB;
constexpr size_t WS_DST = 352 * MiB;
constexpr size_t WS_OA = 416 * MiB, WS_YB = 432 * MiB, WS_Y = 464 * MiB, WS_END = 496 * MiB;
constexpr size_t WS_ZP = 256 * MiB;
constexpr size_t WS_X2 = 432 * MiB;

#define XB_TMO      128
#define XB_XCNT(j)  (256  + 64 * (j))
#define XB_XSUB(j)  (1280 + 64 * (j))
#define XB_XGEN(j)  (2304 + 64 * (j))
#define XB_TOP      3328
#define XB_TOPGEN   3392
#define XCD_BAR_WORDS 3456
#define XB_SPIN_CAP (1u << 18)

__device__ __forceinline__ unsigned xb_ld(unsigned* p)              { return __hip_atomic_load(p, __ATOMIC_RELAXED, __HIP_MEMORY_SCOPE_AGENT); }
__device__ __forceinline__ unsigned xb_add(unsigned* p, unsigned v) { return __hip_atomic_fetch_add(p, v, __ATOMIC_RELAXED, __HIP_MEMORY_SCOPE_AGENT); }
__device__ __forceinline__ unsigned xb_xcc_id() { return (unsigned)__builtin_amdgcn_s_getreg((3 << 11) | 20) & 0xFu; }
#define XB_SPIN(cond, bar) do { unsigned _sp = 0; while (cond) { __builtin_amdgcn_s_sleep(1); \
    if ((++_sp & 255u) == 0u) { if (xb_ld(&(bar)[XB_TMO])) break; if (_sp > XB_SPIN_CAP) { atomicAdd(&(bar)[XB_TMO], 1u); break; } } } } while (0)

struct XcdBarrier {
    unsigned* bar; unsigned x;
    volatile LAS unsigned* st;
};

__device__ __forceinline__ XcdBarrier xcd_barrier_post(unsigned* bar, volatile LAS unsigned* st) {
    XcdBarrier b; b.bar = bar; b.x = xb_xcc_id(); b.st = st;
    if (threadIdx.x == 0) (void)xb_add(&bar[XB_XCNT(b.x)], 1u);
    return b;
}
__device__ __forceinline__ void xcd_barrier_complete(unsigned* bar, unsigned x, unsigned& nloc, unsigned& nx) {
    const unsigned G = gridDim.x * gridDim.y * gridDim.z;
    unsigned sum, cnt, mine, sp = 0u;
    for (;;) {
        sum = 0u; cnt = 0u; mine = 0u;
#pragma unroll
        for (unsigned j = 0; j < 16; ++j) { const unsigned c = xb_ld(&bar[XB_XCNT(j)]); sum += c; cnt += (c > 0u) ? 1u : 0u; mine = (j == x) ? c : mine; }
        if (sum == G) break;
        __builtin_amdgcn_s_sleep(1);
        if ((++sp & 255u) == 0u) { if (xb_ld(&bar[XB_TMO])) break; if (sp > XB_SPIN_CAP) { atomicAdd(&bar[XB_TMO], 1u); break; } }
    }
    nloc = mine > 0u ? mine : 1u; nx = cnt > 0u ? cnt : 1u;
}

__device__ __forceinline__ void xcd_barrier(const XcdBarrier& b) {
    asm volatile("s_waitcnt vmcnt(0)" ::: "memory");
    __syncthreads();
    if (threadIdx.x == 0) {
        unsigned* bar = b.bar;
        __builtin_amdgcn_s_waitcnt(0);
        unsigned nloc = b.st[0], nx = b.st[1];
        if (nloc == 0u) { xcd_barrier_complete(bar, b.x, nloc, nx); b.st[0] = nloc; b.st[1] = nx; }
        const unsigned old = xb_add(&bar[XB_XSUB(b.x)], 1u);
        const unsigned gen = old / nloc;
        if (old + 1u == (gen + 1u) * nloc) {
            __builtin_amdgcn_fence(__ATOMIC_RELEASE, "agent");
            asm volatile("s_waitcnt vmcnt(0)" ::: "memory");
            const unsigned og = xb_add(&bar[XB_TOP], 1u);
            const unsigned tg = og / nx;
            if (og + 1u == (tg + 1u) * nx) xb_add(&bar[XB_TOPGEN], 1u);
            else XB_SPIN(xb_ld(&bar[XB_TOPGEN]) == tg, bar);
            __builtin_amdgcn_fence(__ATOMIC_ACQUIRE, "agent");
            xb_add(&bar[XB_XGEN(b.x)], 1u);
            asm volatile("s_waitcnt vmcnt(0)" ::: "memory");
        } else {
            XB_SPIN(xb_ld(&bar[XB_XGEN(b.x)]) == gen, bar);
            __builtin_amdgcn_fence(__ATOMIC_ACQUIRE, "agent");
            asm volatile("s_waitcnt vmcnt(0)" ::: "memory");
        }
    }
    __syncthreads();
}

struct Ctx { LAS unsigned char* lds; int tid, lane, wave, G, bid; float* out; unsigned char* ws; };
__device__ __forceinline__ const void* karg_ptr(int i) { return ((const void* const __attribute__((address_space(4)))*)__builtin_amdgcn_kernarg_segment_ptr())[i]; }
#define IP(i) ((const float*)karg_ptr(i))
#define WSP(type, off) ((type*)(C.ws + (off)))

__device__ __forceinline__ int ilv64(int i) { return i < 32 ? 2 * i : 2 * (i - 32) + 1; }
template <int MAP> __device__ __forceinline__ int colmap(int n) {
    if (MAP == 1) { if (n < 5120) return n; if (n < 5184) return 9216 + ilv64(n - 5120); return n - 64; }
    if (MAP == 2) { const int h = n / MQK, d = n - h * MQK; return d < MNOPE ? n : h * MQK + MNOPE + ilv64(d - MNOPE); }
    return n;
}
template <int MAP> __device__ __forceinline__ void p0_transpose_item(const float* W, int K, int N, bf16_t* WT, LAS float* scr, int item, int lane) {
    const int nblk = N / 32, kb = item / nblk, nb = item % nblk, k0 = 64 * kb, n0 = 32 * nb;
#pragma unroll 8
    for (int i = 0; i < 32; ++i) { const int kk = 2 * i + (lane >> 5); scr[kk * 33 + (lane & 31)] = W[(size_t)(k0 + kk) * N + n0 + (lane & 31)]; }
    LDS_WAIT(); asm volatile("" ::: "memory");
    const int c = lane & 7;
#pragma unroll
    for (int j = 0; j < 4; ++j) { const int n = (lane >> 3) + 8 * j; const LAS float* s = scr + (8 * c) * 33 + n;
        u32x4 o; o.x = cvt_pk_bf16(s[0 * 33], s[1 * 33]); o.y = cvt_pk_bf16(s[2 * 33], s[3 * 33]); o.z = cvt_pk_bf16(s[4 * 33], s[5 * 33]); o.w = cvt_pk_bf16(s[6 * 33], s[7 * 33]);
        *(u32x4*)(WT + (size_t)colmap<MAP>(n0 + n) * K + k0 + 8 * c) = o; }
    LDS_WAIT(); asm volatile("" ::: "memory");
}
__device__ __forceinline__ void rms_row_to_bf16(const float* xrow, const float* gain, bf16_t* orow, int lane) {
    const f32x4* xr = (const f32x4*)xrow + lane; const f32x4* gr = (const f32x4*)gain + lane;
    f32x4 v[8]; float s = 0.f;
#pragma unroll
    for (int j = 0; j < 8; ++j) { v[j] = xr[64 * j]; s += sumsq4(v[j]); }
    const float rs = __builtin_amdgcn_rsqf(wave_sum(s) * (1.0f / DM) + EPS);
    u32x2* o8 = (u32x2*)orow + lane;
#pragma unroll
    for (int j = 0; j < 8; ++j) { const f32x4 y = v[j] * rs * gr[64 * j]; u32x2 w; w.x = cvt_pk_bf16(y[0], y[1]); w.y = cvt_pk_bf16(y[2], y[3]); o8[64 * j] = w; }
}
__device__ __forceinline__ void cvt_copy(const float* src, bf16_t* dst, size_t n, size_t gtid, size_t nthr) {
    for (size_t i = gtid; i < n / 8; i += nthr) { const f32x4 a = ((const f32x4*)src)[2 * i], b = ((const f32x4*)src)[2 * i + 1]; ((u32x4*)dst)[i] = pack8(a, b); }
}

__device__ __forceinline__ void phase_prep(const Ctx& C) {
    LAS float* scr = (LAS float*)(C.lds + C.wave * 16384);
    const int gw = C.bid * 8 + C.wave, NGW = C.G * 8;
    constexpr int I_IN = (DM / 64) * (INW / 32), I_UQ = (MQL / 64) * (MH * MQK / 32), I_UKV = (MKVL / 64) * (2048 / 32), I_A = (HGW / 64) * (DM / 32), I_O = (DM / 64) * (DM / 32), I_PE = (PLE / 64) * (DM / 32);
    constexpr int NITEMS = I_IN + I_UQ + I_UKV + 2 * I_A + 3 * I_O + I_PE;
    for (int it = gw; it < NITEMS; it += NGW) {
        int r = it;
        if (r < I_IN) { p0_transpose_item<1>(IP(4), DM, INW, WSP(bf16_t, WS_WINT), scr, r, C.lane); continue; } r -= I_IN;
        if (r < I_UQ) { p0_transpose_item<2>(IP(9), MQL, MH * MQK, WSP(bf16_t, WS_WUQT), scr, r, C.lane); continue; } r -= I_UQ;
        if (r < I_UKV) { p0_transpose_item<0>(IP(10), MKVL, 2048, WSP(bf16_t, WS_WUKVT), scr, r, C.lane); continue; } r -= I_UKV;
        if (r < I_A) { p0_transpose_item<0>(IP(11), HGW, DM, WSP(bf16_t, WS_WAT), scr, r, C.lane); continue; } r -= I_A;
        if (r < I_A) { p0_transpose_item<0>(IP(12), HGW, DM, WSP(bf16_t, WS_WBT), scr, r, C.lane); continue; } r -= I_A;
        if (r < I_O) { p0_transpose_item<0>(IP(13), DM, DM, WSP(bf16_t, WS_WOT), scr, r, C.lane); continue; } r -= I_O;
        if (r < I_O) { p0_transpose_item<0>(IP(15), DM, DM, WSP(bf16_t, WS_WQT), scr, r, C.lane); continue; } r -= I_O;
        if (r < I_O) { p0_transpose_item<0>(IP(21), DM, DM, WSP(bf16_t, WS_WPGT), scr, r, C.lane); continue; } r -= I_O;
        p0_transpose_item<0>(IP(22), PLE, DM, WSP(bf16_t, WS_WPET), scr, r, C.lane);
    }
    for (int m = gw; m < T; m += NGW) rms_row_to_bf16(IP(0) + (size_t)m * DM, IP(3), WSP(bf16_t, WS_ACTA) + (size_t)m * DM, C.lane);
    const size_t gtid = (size_t)C.bid * 512 + C.tid, nthr = (size_t)C.G * 512;
    { u32x4* z = (u32x4*)(WSP(bf16_t, WS_WINT) + (size_t)INW * DM); for (size_t i = gtid; i < (size_t)(INW_PAD - INW) * DM / 8; i += nthr) z[i] = (u32x4){0u, 0u, 0u, 0u}; }
    cvt_copy(IP(1), WSP(bf16_t, WS_PBF), (size_t)T * PLE, gtid, nthr);
    cvt_copy(IP(16), WSP(bf16_t, WS_K1B), (size_t)PNK * 128, gtid, nthr);
    cvt_copy(IP(17), WSP(bf16_t, WS_K2B), (size_t)PNK * 128, gtid, nthr);
    for (size_t i = gtid; i < HGW; i += nthr) WSP(float, WS_LB)[i] = 1.0f / (1.0f + __expf(IP(5)[HGW + i] - IP(5)[i]));
    for (size_t e = gtid; e < (size_t)T * 32; e += nthr) { const int t = (int)(e >> 5), i = (int)(e & 31);
        double fr = 1.0; for (int k = 0; k < i; ++k) fr *= 0.74989420933245582;
        const float ang = (float)((const int*)karg_ptr(2))[t] * (float)fr; const double rev = (double)ang * 0.15915494309189535; const float fx = (float)(rev - floor(rev));
        WSP(f32x2, WS_CS)[e] = (f32x2){__builtin_amdgcn_cosf(fx), __builtin_amdgcn_sinf(fx)}; }
}

__device__ __forceinline__ void hgrn_cumsum(const Ctx& C, int h, int n, float (&fv)[16], float (&bb)[16], float& b_ref, float& b_last, LAS float* TOT) {
    const int d = C.tid & 127, rg = C.tid >> 7; const float* F = WSP(float, WS_F) + ((size_t)(n * HGC + rg * 16)) * HGW + h * HGD + d;
    float run = 0.f;
#pragma unroll
    for (int i = 0; i < 16; ++i) { fv[i] = F[(size_t)i * HGW]; run += __logf(fv[i]); bb[i] = run; }
    TOT[rg * 128 + d] = run; LDS_WAIT(); __syncthreads();
    const float t0 = TOT[d], t1 = TOT[128 + d], t2 = TOT[256 + d], t3 = TOT[384 + d];
    const float off = rg == 0 ? 0.f : rg == 1 ? t0 : rg == 2 ? t0 + t1 : (t0 + t1) + t2;
    b_ref = t0 + t1; b_last = ((t0 + t1) + t2) + t3;
#pragma unroll
    for (int i = 0; i < 16; ++i) bb[i] += off;
}
constexpr int HG_KDT = 0, HG_VT = 18432, HG_TOT = 36864;
__device__ __forceinline__ void hgrn_a_unit(const Ctx& C, int h, int n) {
    LAS bf16_t* KDT = (LAS bf16_t*)(C.lds + HG_KDT); LAS bf16_t* VT = (LAS bf16_t*)(C.lds + HG_VT); LAS float* TOT = (LAS float*)(C.lds + HG_TOT);
    const int d = C.tid & 127, rg = C.tid >> 7;
    float fv[16], bb[16], b_ref, b_last; hgrn_cumsum(C, h, n, fv, bb, b_ref, b_last, TOT);
    const bf16_t* HVp = WSP(bf16_t, WS_HV) + ((size_t)(n * HGC + rg * 16)) * HGW + h * HGD + d;
#pragma unroll
    for (int g = 0; g < 2; ++g) { float kd[8], vv[8];
#pragma unroll
        for (int i = 0; i < 8; ++i) { const int r = g * 8 + i; kd[i] = (1.0f - fv[r]) * __expf(b_last - bb[r]); vv[i] = bf2f(HVp[(size_t)r * HGW]); }
        u32x4 wk, wv; wk.x = cvt_pk_bf16(kd[0], kd[1]); wk.y = cvt_pk_bf16(kd[2], kd[3]); wk.z = cvt_pk_bf16(kd[4], kd[5]); wk.w = cvt_pk_bf16(kd[6], kd[7]);
        wv.x = cvt_pk_bf16(vv[0], vv[1]); wv.y = cvt_pk_bf16(vv[2], vv[3]); wv.z = cvt_pk_bf16(vv[4], vv[5]); wv.w = cvt_pk_bf16(vv[6], vv[7]);
        *(LAS u32x4*)(KDT + d * 72 + rg * 16 + g * 8) = wk; *(LAS u32x4*)(VT + d * 72 + rg * 16 + g * 8) = wv; }
    if (rg == 0) WSP(float, WS_DECAY)[((size_t)h * HGNC + n) * HGD + d] = __expf(b_last);
    LDS_WAIT(); __syncthreads();
    const int fr = C.lane & 15, fq = C.lane >> 4, w = C.wave;
    bf16x8 bfr[2];
#pragma unroll
    for (int ks = 0; ks < 2; ++ks) bfr[ks] = *(const LAS bf16x8*)(VT + (16 * w + fr) * 72 + 8 * fq + 32 * ks);
    float* DST = WSP(float, WS_DST) + (((size_t)h * HGNC + n) * HGD + 16 * w + fr) * HGD;
#pragma unroll
    for (int mt = 0; mt < 8; ++mt) { f32x4 acc = {0.f, 0.f, 0.f, 0.f};
#pragma unroll
        for (int ks = 0; ks < 2; ++ks) { const bf16x8 a = *(const LAS bf16x8*)(KDT + (16 * mt + fr) * 72 + 8 * fq + 32 * ks); acc = __builtin_amdgcn_mfma_f32_16x16x32_bf16(a, bfr[ks], acc, 0, 0, 0); }
        *(f32x4*)(DST + 16 * mt + 4 * fq) = acc; }
    LDS_WAIT(); __syncthreads();
}
__device__ __forceinline__ void hgrn_scan(const Ctx& C) {
    const float* DST = WSP(float, WS_DST); const float* DEC = WSP(float, WS_DECAY); bf16_t* SPT = WSP(bf16_t, WS_SPT);
    for (int e = C.bid * 512 + C.tid; e < HGH * HGD * HGD; e += C.G * 512) {
        const int h = e >> 14, dv = (e >> 7) & 127, dk = e & 127; float S = 0.f;
        const size_t base = ((size_t)h * HGNC * HGD + dv) * HGD + dk; const size_t dbase = (size_t)h * HGNC * HGD + dk;
#pragma unroll 8
        for (int n = 0; n < HGNC; ++n) { SPT[base + (size_t)n * HGD * HGD] = f2bf(S); S = DEC[dbase + (size_t)n * HGD] * S + DST[base + (size_t)n * HGD * HGD]; }
    }
}
constexpr int HC_QIN = 0, HC_KIN = 17408, HC_QE = 34816, HC_VT = 52224, HC_AQ = 70656, HC_TOT = 79872, HC_OL = 81920;
__device__ __forceinline__ void hgrn_c_unit(const Ctx& C, int h, int n) {
    LAS bf16_t* QIN = (LAS bf16_t*)(C.lds + HC_QIN); LAS bf16_t* KIN = (LAS bf16_t*)(C.lds + HC_KIN); LAS bf16_t* QE = (LAS bf16_t*)(C.lds + HC_QE);
    LAS bf16_t* VT = (LAS bf16_t*)(C.lds + HC_VT); LAS bf16_t* AQ = (LAS bf16_t*)(C.lds + HC_AQ); LAS float* TOT = (LAS float*)(C.lds + HC_TOT); LAS float* OL = (LAS float*)(C.lds + HC_OL);
    const int d = C.tid & 127, rg = C.tid >> 7;
    float fv[16], bb[16], b_ref, b_last; hgrn_cumsum(C, h, n, fv, bb, b_ref, b_last, TOT);
    const size_t gro = ((size_t)(n * HGC + rg * 16)) * HGW + h * HGD + d; const bf16_t* HVp = WSP(bf16_t, WS_HV) + gro; const bf16_t* HQp = WSP(bf16_t, WS_HQ) + gro;
#pragma unroll
    for (int g = 0; g < 2; ++g) { float vv[8];
#pragma unroll
        for (int i = 0; i < 8; ++i) { const int r = g * 8 + i, c = rg * 16 + r; const float q = bf2f(HQp[(size_t)r * HGW]), k = 1.0f - fv[r];
            QIN[c * 136 + d] = f2bf(q * __expf(bb[r] - b_ref)); KIN[c * 136 + d] = f2bf(k * __expf(b_ref - bb[r])); QE[c * 136 + d] = f2bf(q * __expf(bb[r])); vv[i] = bf2f(HVp[(size_t)r * HGW]); }
        u32x4 wv; wv.x = cvt_pk_bf16(vv[0], vv[1]); wv.y = cvt_pk_bf16(vv[2], vv[3]); wv.z = cvt_pk_bf16(vv[4], vv[5]); wv.w = cvt_pk_bf16(vv[6], vv[7]);
        *(LAS u32x4*)(VT + d * 72 + rg * 16 + g * 8) = wv; }
    LDS_WAIT(); __syncthreads();
    const int fr = C.lane & 15, fq = C.lane >> 4, w = C.wave;
    { const int mt = w >> 1;
#pragma unroll
      for (int j = 0; j < 2; ++j) { const int nt = 2 * (w & 1) + j; f32x4 acc = {0.f, 0.f, 0.f, 0.f};
#pragma unroll
        for (int ks = 0; ks < 4; ++ks) { const bf16x8 a = *(const LAS bf16x8*)(QIN + (16 * mt + fr) * 136 + 8 * fq + 32 * ks), b = *(const LAS bf16x8*)(KIN + (16 * nt + fr) * 136 + 8 * fq + 32 * ks);
            acc = __builtin_amdgcn_mfma_f32_16x16x32_bf16(a, b, acc, 0, 0, 0); }
        const int s = 16 * nt + fr;
#pragma unroll
        for (int i = 0; i < 4; ++i) { const int c = 16 * mt + 4 * fq + i; AQ[c * 72 + s] = f2bf(s <= c ? acc[i] : 0.f); } } }
    LDS_WAIT(); __syncthreads();
    { bf16x8 bv[2], bs[4]; const bf16_t* SP = WSP(bf16_t, WS_SPT) + (((size_t)h * HGNC + n) * HGD + 16 * w + fr) * HGD;
#pragma unroll
      for (int ks = 0; ks < 2; ++ks) bv[ks] = *(const LAS bf16x8*)(VT + (16 * w + fr) * 72 + 8 * fq + 32 * ks);
#pragma unroll
      for (int ks = 0; ks < 4; ++ks) bs[ks] = *(const bf16x8*)(SP + 8 * fq + 32 * ks);
#pragma unroll
      for (int mt = 0; mt < 4; ++mt) { f32x4 acc = {0.f, 0.f, 0.f, 0.f};
#pragma unroll
        for (int ks = 0; ks < 2; ++ks) { const bf16x8 a = *(const LAS bf16x8*)(AQ + (16 * mt + fr) * 72 + 8 * fq + 32 * ks); acc = __builtin_amdgcn_mfma_f32_16x16x32_bf16(a, bv[ks], acc, 0, 0, 0); }
#pragma unroll
        for (int ks = 0; ks < 4; ++ks) { const bf16x8 a = *(const LAS bf16x8*)(QE + (16 * mt + fr) * 136 + 8 * fq + 32 * ks); acc = __builtin_amdgcn_mfma_f32_16x16x32_bf16(a, bs[ks], acc, 0, 0, 0); }
#pragma unroll
        for (int i = 0; i < 4; ++i) OL[(16 * mt + 4 * fq + i) * 132 + 16 * w + fr] = acc[i]; } }
    LDS_WAIT(); __syncthreads();
    { const int c = C.tid >> 3, j = C.tid & 7; f32x4 o[4]; float ss = 0.f;
#pragma unroll
      for (int i = 0; i < 4; ++i) { o[i] = *(const LAS f32x4*)(OL + c * 132 + 16 * j + 4 * i); ss += sumsq4(o[i]); }
      ss += __shfl_xor(ss, 1); ss += __shfl_xor(ss, 2); ss += __shfl_xor(ss, 4);
      const float rs = __builtin_amdgcn_rsqf(ss * (1.0f / HGD) + EPS); const size_t go = (size_t)(n * HGC + c) * HGW + h * HGD + 16 * j;
      const float* gn = IP(6) + h * HGD + 16 * j; const bf16_t* HOG = WSP(bf16_t, WS_HOG) + go; bf16_t* OA = WSP(bf16_t, WS_OA) + go;
#pragma unroll
      for (int i = 0; i < 2; ++i) { f32x4 s0, s1; unpack8(*(const u32x4*)(HOG + 8 * i), s0, s1);
          *(u32x4*)(OA + 8 * i) = pack8(o[2 * i] * rs * *(const f32x4*)(gn + 8 * i) * s0, o[2 * i + 1] * rs * *(const f32x4*)(gn + 8 * i + 4) * s1); } }
    LDS_WAIT(); __syncthreads();
}

constexpr int AT_K = 0, AT_KSTR = 400, AT_V = 25600, AT_MRG = 0, AT_MRG_STRIDE = 16384 + 256;
typedef short v4i16_t __attribute__((ext_vector_type(4)));
__device__ __forceinline__ s16x4 vtr(const LAS unsigned char* p) { return __builtin_bit_cast(s16x4, __builtin_amdgcn_ds_read_tr16_b64_v4i16((LAS v4i16_t*)p)); }
__device__ __forceinline__ int crow(int r, int hi) { return (r & 3) + 8 * (r >> 2) + 4 * hi; }
__device__ __forceinline__ void attn_unit(const Ctx& C, int h, int qb) {
    const int lane = C.lane, ql = lane & 31, hi = lane >> 5, kg = C.wave >> 2, qw = C.wave & 3, tid = C.tid;
    const int q0 = qb * 128, ntiles = 2 * (qb + 1), qpos = q0 + 32 * qw + ql;
    const bf16_t* Qp = WSP(bf16_t, WS_Q) + ((size_t)h * T + qpos) * MQK + 8 * hi; const bf16_t* Kp = WSP(bf16_t, WS_K) + (size_t)h * T * MQK; const bf16_t* Vp = WSP(bf16_t, WS_V) + (size_t)h * T * MV;
    bf16x8 qf[12];
#pragma unroll
    for (int ks = 0; ks < 12; ++ks) qf[ks] = *(const bf16x8*)(Qp + 16 * ks);
    float m_run = -1e30f, l_run = 0.f; f32x16 oT[4];
#pragma unroll
    for (int nb = 0; nb < 4; ++nb) oT[nb] = (f32x16){0.f, 0.f, 0.f, 0.f, 0.f, 0.f, 0.f, 0.f, 0.f, 0.f, 0.f, 0.f, 0.f, 0.f, 0.f, 0.f};
    const LAS unsigned char* kfrag = C.lds + AT_K + (32 * kg + ql) * AT_KSTR + 16 * hi;
    const LAS unsigned char* vfrag = C.lds + AT_V + (16 * kg) * 512 + (4 * hi + ((lane & 15) >> 2)) * 64 + ((lane >> 4) & 1) * 32 + (lane & 3) * 8;
    for (int j = 0; j < ntiles; ++j) {
        const int k0 = 64 * j;
        __syncthreads();
#pragma unroll
        for (int i = 0; i < 3; ++i) { const int cid = tid + 512 * i, r = cid / 24, cc = cid - r * 24; *(LAS u32x4*)(C.lds + AT_K + r * AT_KSTR + cc * 16) = *(const u32x4*)(Kp + (size_t)(k0 + r) * MQK + cc * 8); }
#pragma unroll
        for (int i = 0; i < 2; ++i) { const int cid = tid + 512 * i, r = cid >> 4, cc = cid & 15; *(LAS u32x4*)(C.lds + AT_V + ((r >> 3) * 4 + (cc >> 2)) * 512 + (r & 7) * 64 + (cc & 3) * 16) = *(const u32x4*)(Vp + (size_t)(k0 + r) * MV + cc * 8); }
        LDS_WAIT(); __syncthreads();
        const int kbase = k0 + 32 * kg;
        if (kbase <= q0 + 32 * qw + 31) {
            f32x16 st = (f32x16){0.f, 0.f, 0.f, 0.f, 0.f, 0.f, 0.f, 0.f, 0.f, 0.f, 0.f, 0.f, 0.f, 0.f, 0.f, 0.f};
#pragma unroll
            for (int ks = 0; ks < 12; ++ks) { const bf16x8 a = *(const LAS bf16x8*)(kfrag + 32 * ks); st = __builtin_amdgcn_mfma_f32_32x32x16_bf16(a, qf[ks], st, 0, 0, 0); }
            if (kbase + 31 > q0 + 32 * qw) {
#pragma unroll
                for (int r = 0; r < 16; ++r) if (kbase + crow(r, hi) > qpos) st[r] = -__builtin_inff();
            }
            float mx = st[0];
#pragma unroll
            for (int r = 1; r < 16; ++r) mx = fmaxf(mx, st[r]);
            mx = fmaxf(mx, __shfl_xor(mx, 32));
            const float m_new = fmaxf(m_run, mx), alpha = __builtin_amdgcn_exp2f(m_run - m_new); m_run = m_new;
            float ps = 0.f;
#pragma unroll
            for (int r = 0; r < 16; ++r) { st[r] = __builtin_amdgcn_exp2f(st[r] - m_new); ps += st[r]; }
            ps += __shfl_xor(ps, 32); l_run = l_run * alpha + ps;
#pragma unroll
            for (int nb = 0; nb < 4; ++nb) oT[nb] *= alpha;
            bf16x8 pf[2];
#pragma unroll
            for (int s2 = 0; s2 < 2; ++s2) { u32x4 w; w.x = cvt_pk_bf16(st[8 * s2 + 0], st[8 * s2 + 1]); w.y = cvt_pk_bf16(st[8 * s2 + 2], st[8 * s2 + 3]); w.z = cvt_pk_bf16(st[8 * s2 + 4], st[8 * s2 + 5]); w.w = cvt_pk_bf16(st[8 * s2 + 6], st[8 * s2 + 7]); pf[s2] = __builtin_bit_cast(bf16x8, w); }
#pragma unroll
            for (int nb = 0; nb < 4; ++nb)
#pragma unroll
                for (int s2 = 0; s2 < 2; ++s2) { const s16x4 lo = vtr(vfrag + (8 * s2) * 512 + nb * 512), hh = vtr(vfrag + (8 * s2 + 4) * 512 + nb * 512);
                    const bf16x8 vf = (bf16x8){lo[0], lo[1], lo[2], lo[3], hh[0], hh[1], hh[2], hh[3]};
                    oT[nb] = __builtin_amdgcn_mfma_f32_32x32x16_bf16(vf, pf[s2], oT[nb], 0, 0, 0); }
        }
    }
    __syncthreads();
    LAS float* MG = (LAS float*)(C.lds + AT_MRG + qw * AT_MRG_STRIDE);
    if (kg == 1) { if (hi == 0) { MG[2 * ql] = m_run; MG[2 * ql + 1] = l_run; }
#pragma unroll
        for (int nb = 0; nb < 4; ++nb)
#pragma unroll
            for (int r = 0; r < 16; ++r) MG[64 + (nb * 16 + r) * 64 + lane] = oT[nb][r]; }
    LDS_WAIT(); __syncthreads();
    if (kg == 0) { const float m2 = MG[2 * ql], l2 = MG[2 * ql + 1], mm = fmaxf(m_run, m2), a1 = __builtin_amdgcn_exp2f(m_run - mm), a2 = __builtin_amdgcn_exp2f(m2 - mm);
        const float inv = 1.0f / (a1 * l_run + a2 * l2); const float c1 = a1 * inv, c2 = a2 * inv;
        bf16_t* O = WSP(bf16_t, WS_OB) + (size_t)qpos * HGW + h * MV + 4 * hi;
#pragma unroll
        for (int nb = 0; nb < 4; ++nb)
#pragma unroll
            for (int g = 0; g < 4; ++g) { float o[4];
#pragma unroll
                for (int i = 0; i < 4; ++i) { const int r = 4 * g + i; o[i] = c1 * oT[nb][r] + c2 * MG[64 + (nb * 16 + r) * 64 + lane]; }
                u32x2 w; w.x = cvt_pk_bf16(o[0], o[1]); w.y = cvt_pk_bf16(o[2], o[3]); *(u32x2*)(O + 32 * nb + 8 * g) = w; } }
    LDS_WAIT();
}

constexpr int TK_K1 = 0, TK_K2 = 34816, TK_KSTR = 272, TK_IDX = 69632;
__device__ __forceinline__ int f2ord(float f) { const int i = __float_as_int(f); return i >= 0 ? i : (i ^ 0x7fffffff); }
__device__ __forceinline__ float ord2f(int k) { return __int_as_float(k >= 0 ? k : (k ^ 0x7fffffff)); }
#define TK_INS(L, x) do { int _x = (x); _Pragma("unroll") for (int _i = 0; _i < 16; ++_i) { const int _t = max(L[_i], _x); _x = min(L[_i], _x); L[_i] = _t; } } while (0)
__device__ __forceinline__ void topk_stage_keys(const Ctx& C) {
#pragma unroll
    for (int i = 0; i < 8; ++i) { const int cid = C.tid + 512 * i, tb = cid >> 11, r = (cid >> 4) & 127, cc = cid & 15;
        *(LAS u32x4*)(C.lds + tb * TK_K2 + r * TK_KSTR + cc * 16) = *(const u32x4*)(WSP(bf16_t, tb ? WS_K2B : WS_K1B) + r * 128 + cc * 8); }
    LDS_WAIT(); __syncthreads();
}
__device__ __forceinline__ void topk_wave(const Ctx& C, int tb, int head) {
    const int lane = C.lane, tl = lane & 31, hi = lane >> 5, t = tb * 32 + tl;
    int v12[2][16];
#pragma unroll
    for (int half = 0; half < 2; ++half) {
        f32x16 acc[4];
#pragma unroll
        for (int kt = 0; kt < 4; ++kt) acc[kt] = (f32x16){0.f, 0.f, 0.f, 0.f, 0.f, 0.f, 0.f, 0.f, 0.f, 0.f, 0.f, 0.f, 0.f, 0.f, 0.f, 0.f};
        const bf16_t* qp = WSP(bf16_t, WS_QP) + (size_t)t * DM + head * PQD + half * 128 + 8 * hi; const LAS unsigned char* kp = C.lds + half * TK_K2 + tl * TK_KSTR + 16 * hi;
#pragma unroll
        for (int ks = 0; ks < 8; ++ks) { const bf16x8 bq = *(const bf16x8*)(qp + 16 * ks);
#pragma unroll
            for (int kt = 0; kt < 4; ++kt) { const bf16x8 ak = *(const LAS bf16x8*)(kp + kt * 32 * TK_KSTR + 32 * ks); acc[kt] = __builtin_amdgcn_mfma_f32_32x32x16_bf16(ak, bq, acc[kt], 0, 0, 0); } }
        int L[16];
#pragma unroll
        for (int i = 0; i < 16; ++i) L[i] = (int)0x80000000;
#pragma unroll
        for (int kt = 0; kt < 4; ++kt)
#pragma unroll
            for (int r = 0; r < 16; ++r) { const int key = 32 * kt + (r & 3) + 8 * (r >> 2) + 4 * hi; TK_INS(L, (f2ord(acc[kt][r]) & ~127) | (127 - key)); }
        int P[16];
#pragma unroll
        for (int i = 0; i < 16; ++i) P[i] = __shfl_xor(L[i], 32);
#pragma unroll
        for (int i = 0; i < 16; ++i) TK_INS(L, P[i]);
#pragma unroll
        for (int i = 0; i < 16; ++i) v12[half][i] = L[i];
    }
    LAS int* IDX = (LAS int*)(C.lds + TK_IDX + 4096 * C.wave) + tl * 32;
#pragma unroll
    for (int g = 0; g < 4; ++g) { u32x4 w;
#pragma unroll
        for (int i = 0; i < 4; ++i) w[i] = (unsigned)(127 - ((hi ? v12[1][4 * g + i] : v12[0][4 * g + i]) & 127));
        *(LAS u32x4*)(IDX + 16 * hi + 4 * g) = w; }
    float f1[16], f2[16];
#pragma unroll
    for (int i = 0; i < 16; ++i) { f1[i] = ord2f(v12[0][i] & ~127); f2[i] = ord2f(v12[1][i] & ~127); }
    int CL[16];
#pragma unroll
    for (int i = 0; i < 16; ++i) CL[i] = (int)0x80000000;
#pragma unroll
    for (int ca = 0; ca < 16; ++ca)
#pragma unroll
        for (int cb = 0; cb < 16; ++cb) if ((ca + 1) * (cb + 1) <= 16) TK_INS(CL, (f2ord(f1[ca] + f2[cb]) & ~255) | (255 - (ca * 16 + cb)));
    float rs;
    { const f32x4* sp = (const f32x4*)(WSP(float, WS_SSQ1) + (size_t)t * 32 + 16 * hi); const f32x4 s0 = sp[0], s1 = sp[1], s2 = sp[2], s3 = sp[3];
      float ss = ((s0[0] + s0[1]) + (s0[2] + s0[3])) + ((s1[0] + s1[1]) + (s1[2] + s1[3])) + ((s2[0] + s2[1]) + (s2[2] + s2[3])) + ((s3[0] + s3[1]) + (s3[2] + s3[3]));
      ss += __shfl_xor(ss, 32); rs = __builtin_amdgcn_rsqf(ss * (1.0f / DM) + EPS); }
    float ev[16], sm = 0.f; const float mx = ord2f(CL[0] & ~255);
#pragma unroll
    for (int i = 0; i < 16; ++i) { ev[i] = __expf((ord2f(CL[i] & ~255) - mx) * rs); sm += ev[i]; }
    const float inv = 1.0f / sm;
    LDS_WAIT();
    int eo[8]; float go[8];
#pragma unroll
    for (int i = 0; i < 8; ++i) { const int ck = hi ? CL[8 + i] : CL[i]; const int ab = 255 - (ck & 255); eo[i] = IDX[ab >> 4] * PNK + IDX[16 + (ab & 15)]; go[i] = (hi ? ev[8 + i] : ev[i]) * inv; }
    int* ep = WSP(int, WS_EIDX) + (size_t)t * 128 + head * 16 + 8 * hi; float* gp = WSP(float, WS_GATE) + (size_t)t * 128 + head * 16 + 8 * hi;
    *(u32x4*)ep = (u32x4){(unsigned)eo[0], (unsigned)eo[1], (unsigned)eo[2], (unsigned)eo[3]}; *(u32x4*)(ep + 4) = (u32x4){(unsigned)eo[4], (unsigned)eo[5], (unsigned)eo[6], (unsigned)eo[7]};
    *(f32x4*)gp = (f32x4){go[0], go[1], go[2], go[3]}; *(f32x4*)(gp + 4) = (f32x4){go[4], go[5], go[6], go[7]};
    LDS_WAIT();
}

__device__ __forceinline__ void fp8_row(const float* src, unsigned char* dst, float* scale, int row, int lane) {
    const float* xr = src + (size_t)row * DM + 16 * lane; f32x4 v[8]; float am = 0.f;
#pragma unroll
    for (int j = 0; j < 2; ++j)
#pragma unroll
        for (int i = 0; i < 4; ++i) { v[4 * j + i] = *(const f32x4*)(xr + 1024 * j + 4 * i); am = fmaxf(am, fmaxf(fmaxf(fabsf(v[4 * j + i][0]), fabsf(v[4 * j + i][1])), fmaxf(fabsf(v[4 * j + i][2]), fabsf(v[4 * j + i][3])))); }
#pragma unroll
    for (int o = 1; o < 64; o <<= 1) am = fmaxf(am, __shfl_xor(am, o));
    const float sc = am > 0.f ? am * (1.0f / 240.0f) : 1.0f, inv = am > 0.f ? 240.0f / am : 1.0f;
    if (lane == 0) scale[row] = sc;
#pragma unroll
    for (int j = 0; j < 2; ++j) { u32x4 w;
#pragma unroll
        for (int i = 0; i < 4; ++i) { const f32x4 y = v[4 * j + i] * inv; int p = 0; p = __builtin_amdgcn_cvt_pk_fp8_f32(y[0], y[1], p, false); p = __builtin_amdgcn_cvt_pk_fp8_f32(y[2], y[3], p, true); w[i] = (unsigned)p; }
        *(u32x4*)(dst + (size_t)row * DM + 1024 * j + 16 * lane) = w; }
}
__device__ __forceinline__ float gelu_erf(float z) { return 0.5f * z * (1.0f + erff(z * 0.70710678118654752f)); }
__device__ __forceinline__ void cvt16(const u32x4 w, f32x2 (&o)[8]) {
#pragma unroll
    for (int i = 0; i < 4; ++i) { o[2 * i] = __builtin_amdgcn_cvt_pk_f32_fp8((int)w[i], false); o[2 * i + 1] = __builtin_amdgcn_cvt_pk_f32_fp8((int)w[i], true); }
}
__device__ __forceinline__ void peer_z(const Ctx& C, int t, int s) {
    const int lane = C.lane, g = lane >> 4, c = lane & 15, col0 = 256 * s + 16 * c;
    float pz = lane < 32 ? WSP(float, WS_SSQ1)[(size_t)t * 32 + lane] : 0.f; const float rs = __builtin_amdgcn_rsqf(wave_sum(pz) * (1.0f / DM) + EPS);
    f32x2 h[8];
    { const float* xr = C.out + (size_t)t * DM + col0; const float* gn = IP(14) + col0;
#pragma unroll
      for (int i = 0; i < 4; ++i) { const f32x4 y = *(const f32x4*)(xr + 4 * i) * rs * *(const f32x4*)(gn + 4 * i); h[2 * i] = (f32x2){y[0], y[1]}; h[2 * i + 1] = (f32x2){y[2], y[3]}; } }
    const int e0 = WSP(int, WS_EIDX)[(size_t)t * 128 + lane], e1 = WSP(int, WS_EIDX)[(size_t)t * 128 + 64 + lane];
    const unsigned char* U = WSP(unsigned char, WS_U8) + 256 * s + 16 * c; float* zp = WSP(float, WS_ZP) + ((size_t)t * 8 + s) * 128;
#pragma unroll
    for (int bt = 0; bt < 2; ++bt) { u32x4 uw[16]; const int eb = bt ? e1 : e0;
#pragma unroll
        for (int i = 0; i < 16; ++i) { const int e = __shfl(eb, 4 * i + g); uw[i] = *(const u32x4*)(U + (size_t)e * DM); }
        float zk = 0.f;
#pragma unroll
        for (int i = 0; i < 16; ++i) { f32x2 uf[8]; cvt16(uw[i], uf); f32x2 a = uf[0] * h[0];
#pragma unroll
            for (int k = 1; k < 8; ++k) a += uf[k] * h[k];
            float d = a.x + a.y; d += __shfl_xor(d, 1); d += __shfl_xor(d, 2); d += __shfl_xor(d, 4); d += __shfl_xor(d, 8);
            zk = (c == i) ? d : zk; }
        zp[64 * bt + 4 * c + g] = zk; }
}
__device__ __forceinline__ void peer_out(const Ctx& C, int t, int s) {
    const int lane = C.lane, g = lane >> 4, c = lane & 15;
    const int e0 = WSP(int, WS_EIDX)[(size_t)t * 128 + lane], e1 = WSP(int, WS_EIDX)[(size_t)t * 128 + 64 + lane];
    float z0 = 0.f, z1 = 0.f; const float* zp = WSP(float, WS_ZP) + (size_t)t * 8 * 128;
#pragma unroll
    for (int q = 0; q < 8; ++q) { z0 += zp[q * 128 + lane]; z1 += zp[q * 128 + 64 + lane]; }
    const float a0 = gelu_erf(z0 * WSP(float, WS_SU)[e0]) * WSP(float, WS_GATE)[(size_t)t * 128 + lane] * WSP(float, WS_SV)[e0];
    const float a1 = gelu_erf(z1 * WSP(float, WS_SU)[e1]) * WSP(float, WS_GATE)[(size_t)t * 128 + 64 + lane] * WSP(float, WS_SV)[e1];
    const unsigned char* V = WSP(unsigned char, WS_V8) + 256 * s + 16 * c;
    f32x2 acc[8];
#pragma unroll
    for (int k = 0; k < 8; ++k) acc[k] = (f32x2){0.f, 0.f};
#pragma unroll
    for (int bt = 0; bt < 2; ++bt) { u32x4 vw[16]; float av[16]; const int eb = bt ? e1 : e0; const float ab = bt ? a1 : a0;
#pragma unroll
        for (int i = 0; i < 16; ++i) { const int e = __shfl(eb, 4 * i + g); av[i] = __shfl(ab, 4 * i + g); vw[i] = *(const u32x4*)(V + (size_t)e * DM); }
#pragma unroll
        for (int i = 0; i < 16; ++i) { f32x2 vf[8]; cvt16(vw[i], vf);
#pragma unroll
            for (int k = 0; k < 8; ++k) acc[k] += vf[k] * av[i]; } }
#pragma unroll
    for (int k = 0; k < 8; ++k) { acc[k].x += __shfl_xor(acc[k].x, 16); acc[k].y += __shfl_xor(acc[k].y, 16); acc[k].x += __shfl_xor(acc[k].x, 32); acc[k].y += __shfl_xor(acc[k].y, 32); }
    const f32x2 p0 = g == 0 ? acc[0] : g == 1 ? acc[2] : g == 2 ? acc[4] : acc[6], p1 = g == 0 ? acc[1] : g == 1 ? acc[3] : g == 2 ? acc[5] : acc[7];
    const size_t o = (size_t)t * DM + 256 * s + 16 * c + 4 * g;
    const f32x4 x2 = *(const f32x4*)(C.out + o) + (f32x4){p0.x, p0.y, p1.x, p1.y};
    *(f32x4*)(WSP(float, WS_X2) + o) = x2;
    const f32x4 y = x2 * *(const f32x4*)(IP(20) + 256 * s + 16 * c + 4 * g); u32x2 w; w.x = cvt_pk_bf16(y[0], y[1]); w.y = cvt_pk_bf16(y[2], y[3]); *(u32x2*)(WSP(bf16_t, WS_ACTA) + o) = w;
    const float s2 = wave_sum(sumsq4(x2)); if (lane == 0) WSP(float, WS_SSQ2)[(size_t)t * 8 + s] = s2;
}
__device__ __forceinline__ void final_row(const Ctx& C, int t) {
    const int lane = C.lane; float pz = lane < 32 ? WSP(float, WS_SSQ3)[(size_t)t * 32 + lane] : 0.f;
    const float rs = __builtin_amdgcn_rsqf(wave_sum(pz) * (1.0f / DM) + EPS);
    f32x4* xr = (f32x4*)(C.out + (size_t)t * DM) + lane; const f32x4* gr = (const f32x4*)IP(23) + lane;
#pragma unroll
    for (int j = 0; j < 8; ++j) xr[64 * j] = xr[64 * j] * rs * gr[64 * j];
}

constexpr int NPHASE = 12;
#ifndef MK_ONE_LAUNCH
#define MK_ONE_LAUNCH 1
#endif
constexpr int LDS_BYTES = 147456;
constexpr int MISC_OFF = 131072 + 320;
struct Args { const void* in[24]; float* out; unsigned char* ws; int ph_lo, ph_hi; };
#define GEMM_ALIGN true
#define GEMM_SP2 true

__global__ void __launch_bounds__(512, 2) mk_fwd(Args args) {
    extern __shared__ __attribute__((aligned(16))) unsigned char lds_raw[];
    Ctx C;
    C.lds = (LAS unsigned char*)lds_raw; C.tid = threadIdx.x; C.lane = C.tid & 63; C.wave = __builtin_amdgcn_readfirstlane(C.tid >> 6); C.G = gridDim.x; C.bid = blockIdx.x;
    C.out = (float*)karg_ptr(24); C.ws = (unsigned char*)karg_ptr(25);
    volatile LAS unsigned* MISC = (volatile LAS unsigned*)(C.lds + MISC_OFF);
    if (C.tid < 32) MISC[C.tid] = 0u;
    __syncthreads();
    const int lo = ((const int __attribute__((address_space(4)))*)__builtin_amdgcn_kernarg_segment_ptr())[52], hi = ((const int __attribute__((address_space(4)))*)__builtin_amdgcn_kernarg_segment_ptr())[53];
    const bool multi = (hi - lo) > 1;
    XcdBarrier bar; bar.bar = (unsigned*)(C.ws + WS_CTL) + 1024; bar.x = 0; bar.st = nullptr;
    if (multi) bar = xcd_barrier_post((unsigned*)(C.ws + WS_CTL) + 1024, MISC + 8);
    LAS unsigned char* L = C.lds;
    const int gw = C.bid * 8 + C.wave, NGW = C.G * 8;

    if (lo <= 0 && 0 < hi) {
 phase_prep(C);
    }
    if (lo <= 0 && 1 < hi) xcd_barrier(bar);
    if (lo <= 1 && 1 < hi) {
        pg8::Gemm g{WSP(bf16_t, WS_ACTA), WSP(bf16_t, WS_WINT), T, INW_PAD, DM}; pg8::StaticOrder S; S.init(T, INW_PAD, C.G, C.bid);
        pg8::EpiProj E{WSP(bf16_t, WS_HQ), WSP(bf16_t, WS_HV), WSP(bf16_t, WS_HOG), WSP(bf16_t, WS_MQG), WSP(bf16_t, WS_MKVG), WSP(bf16_t, WS_GA), WSP(bf16_t, WS_GB), WSP(bf16_t, WS_K),
                       WSP(float, WS_F), WSP(float, WS_SSQQ), WSP(float, WS_SSQKV), WSP(float, WS_LB), IP(7), IP(8), WSP(pg8::f32x2, WS_CS)};
        pg8::gemm_phase<pg8::EpiProj, pg8::StaticOrder, GEMM_ALIGN, GEMM_SP2>(L, g, S, E);

    }
    if (lo <= 1 && 2 < hi) xcd_barrier(bar);
    if (lo <= 2 && 2 < hi) {
        { pg8::Gemm g{WSP(bf16_t, WS_MQG), WSP(bf16_t, WS_WUQT), T, MH * MQK, MQL}; pg8::StaticOrder S; S.init(T, MH * MQK, C.G, C.bid);
          pg8::EpiQ E{WSP(bf16_t, WS_Q), WSP(float, WS_SSQQ), WSP(pg8::f32x2, WS_CS)};
          pg8::gemm_phase<pg8::EpiQ, pg8::StaticOrder, GEMM_ALIGN, GEMM_SP2>(L, g, S, E); }
        { pg8::Gemm g{WSP(bf16_t, WS_MKVG), WSP(bf16_t, WS_WUKVT), T, 2048, MKVL}; pg8::StaticOrder S; S.init(T, 2048, C.G, C.bid);
          pg8::EpiKV E{WSP(bf16_t, WS_K), WSP(bf16_t, WS_V), WSP(float, WS_SSQKV)};
          pg8::gemm_phase<pg8::EpiKV, pg8::StaticOrder, GEMM_ALIGN, GEMM_SP2>(L, g, S, E); }
        __syncthreads();
        for (int u = C.bid; u < HGH * HGNC; u += C.G) hgrn_a_unit(C, u >> 7, u & 127);

    }
    if (lo <= 2 && 3 < hi) xcd_barrier(bar);
    if (lo <= 3 && 3 < hi) {
        hgrn_scan(C);
        for (int pr = C.bid; pr < 256; pr += C.G) { const int h = pr >> 5, s = pr & 31; attn_unit(C, h, 63 - s); attn_unit(C, h, s); }

    }
    if (lo <= 3 && 4 < hi) xcd_barrier(bar);
    if (lo <= 4 && 4 < hi) {
        __syncthreads();
        for (int u = C.bid; u < HGH * HGNC; u += C.G) hgrn_c_unit(C, u >> 7, u & 127);
        __syncthreads();
        pg8::Gemm g{WSP(bf16_t, WS_OB), WSP(bf16_t, WS_WBT), T, DM, HGW}; pg8::StaticOrder S; S.init(T, DM, C.G, C.bid);
        pg8::EpiYb E{WSP(bf16_t, WS_GB), WSP(bf16_t, WS_YB)};
        pg8::gemm_phase<pg8::EpiYb, pg8::StaticOrder, GEMM_ALIGN, GEMM_SP2>(L, g, S, E);

    }
    if (lo <= 4 && 5 < hi) xcd_barrier(bar);
    if (lo <= 5 && 5 < hi) {
        for (int r = gw; r < 2 * PNK * PNK; r += NGW) { if (r < PNK * PNK) fp8_row(IP(18), WSP(unsigned char, WS_U8), WSP(float, WS_SU), r, C.lane); else fp8_row(IP(19), WSP(unsigned char, WS_V8), WSP(float, WS_SV), r - PNK * PNK, C.lane); }
        pg8::Gemm g{WSP(bf16_t, WS_OA), WSP(bf16_t, WS_WAT), T, DM, HGW}; pg8::StaticOrder S; S.init(T, DM, C.G, C.bid);
        pg8::EpiY E{WSP(bf16_t, WS_GA), WSP(bf16_t, WS_YB), WSP(bf16_t, WS_Y)};
        pg8::gemm_phase<pg8::EpiY, pg8::StaticOrder, GEMM_ALIGN, GEMM_SP2>(L, g, S, E);

    }
    if (lo <= 5 && 6 < hi) xcd_barrier(bar);
    if (lo <= 6 && 6 < hi) {
        pg8::Gemm g{WSP(bf16_t, WS_Y), WSP(bf16_t, WS_WOT), T, DM, DM}; pg8::StaticOrder S; S.init(T, DM, C.G, C.bid);
        pg8::EpiX1 E{IP(0), IP(14), C.out, WSP(float, WS_SSQ1), WSP(bf16_t, WS_ACTA)};
        pg8::gemm_phase<pg8::EpiX1, pg8::StaticOrder, GEMM_ALIGN, GEMM_SP2>(L, g, S, E);

    }
    if (lo <= 6 && 7 < hi) xcd_barrier(bar);
    if (lo <= 7 && 7 < hi) {
        { pg8::Gemm g{WSP(bf16_t, WS_ACTA), WSP(bf16_t, WS_WQT), T, DM, DM}; pg8::StaticOrder S; S.init(T, DM, C.G, C.bid);
          pg8::EpiPlain E{WSP(bf16_t, WS_QP), DM};
          pg8::gemm_phase<pg8::EpiPlain, pg8::StaticOrder, GEMM_ALIGN, GEMM_SP2>(L, g, S, E); }
        { pg8::Gemm g{WSP(bf16_t, WS_PBF), WSP(bf16_t, WS_WPET), T, DM, PLE}; pg8::StaticOrder S; S.init(T, DM, C.G, C.bid);
          pg8::EpiPlain E{WSP(bf16_t, WS_PE), DM};
          pg8::gemm_phase<pg8::EpiPlain, pg8::StaticOrder, GEMM_ALIGN, GEMM_SP2>(L, g, S, E); }

    }
    if (lo <= 7 && 8 < hi) xcd_barrier(bar);
    if (lo <= 8 && 8 < hi) {
        __syncthreads();
        topk_stage_keys(C);
        for (int wu = gw; wu < (T / 32) * PH; wu += NGW) topk_wave(C, wu >> 3, wu & 7);
        __syncthreads();

    }
    if (lo <= 8 && 9 < hi) xcd_barrier(bar);
    if (lo <= 9 && 9 < hi) {
        { const int sl = C.bid & 7, wsl = (C.bid >> 3) * 8 + C.wave, nws = (C.G >> 3) * 8;
          if (C.bid < (C.G & ~7)) for (int t = wsl; t < T; t += nws) peer_z(C, t, sl);
          xcd_barrier(bar);
          if (C.bid < (C.G & ~7)) for (int t = wsl; t < T; t += nws) peer_out(C, t, sl); }

    }
    if (lo <= 9 && 10 < hi) xcd_barrier(bar);
    if (lo <= 10 && 10 < hi) {
        pg8::Gemm g{WSP(bf16_t, WS_ACTA), WSP(bf16_t, WS_WPGT), T, DM, DM}; pg8::StaticOrder S; S.init(T, DM, C.G, C.bid);
        pg8::EpiPle E{WSP(bf16_t, WS_PE), WSP(float, WS_SSQ2), WSP(float, WS_X2), C.out, WSP(float, WS_SSQ3)};
        pg8::gemm_phase<pg8::EpiPle, pg8::StaticOrder, GEMM_ALIGN, GEMM_SP2>(L, g, S, E);

    }
    if (lo <= 10 && 11 < hi) xcd_barrier(bar);
    if (lo <= 11 && 11 < hi) {
 for (int t = gw; t < T; t += NGW) final_row(C, t);
    }
    if (lo <= 11 && 12 < hi) xcd_barrier(bar);
}

extern "C" void kernel_launch(void* const* d_in, const int* in_sizes, int n_in, void* d_out, int out_size, void* d_ws, size_t ws_size, hipStream_t stream) {
    static int grid = 0;
    if (grid == 0) {
        if (n_in != 24 || out_size != T * DM || ws_size < WS_END) { fprintf(stderr, "kernel_launch: unexpected shapes: n_in %d out %d ws %zu (need %zu)\n", n_in, out_size, ws_size, (size_t)WS_END); grid = -1; return; }
        int dev = 0, cus = 0;
        if (hipGetDevice(&dev) != hipSuccess || hipDeviceGetAttribute(&cus, hipDeviceAttributeMultiprocessorCount, dev) != hipSuccess) { grid = -1; return; }
        if (hipFuncSetAttribute((const void*)mk_fwd, hipFuncAttributeMaxDynamicSharedMemorySize, LDS_BYTES) != hipSuccess) { fprintf(stderr, "kernel_launch: hipFuncSetAttribute failed\n"); grid = -1; return; }
        (void)hipGetLastError();
        grid = cus;
    }
    if (grid < 0) return;
    (void)hipMemsetAsync((char*)d_ws + WS_CTL, 0, CTL_ZERO_BYTES, stream);
    Args a{};
    for (int i = 0; i < 24; ++i) a.in[i] = d_in[i];
    a.out = (float*)d_out; a.ws = (unsigned char*)d_ws;
#if MK_ONE_LAUNCH
    a.ph_lo = 0; a.ph_hi = NPHASE;
    hipLaunchKernelGGL(mk_fwd, dim3(grid), dim3(512), LDS_BYTES, stream, a);
#else
    for (int ph = 0; ph < NPHASE; ++ph) { a.ph_lo = ph; a.ph_hi = ph + 1; hipLaunchKernelGGL(mk_fwd, dim3(grid), dim3(512), LDS_BYTES, stream, a); }
#endif
}
```

```cpp
#include <hip/hip_runtime.h>
#include <cstdio>
#include <cstdint>

constexpr int T = 8192, DM = 2048, PLE = 256;
constexpr int HGH = 8, HGD = 128, HGW = 1024, HGC = 64, HGNC = T / HGC;
constexpr int MH = 8, MNOPE = 128, MROPE = 64, MV = 128, MQL = 512, MKVL = 512, MQK = 192;
constexpr int PH = 8, PNK = 128, PQD = 256, PK = 16;
constexpr int INW = 9280, INW_PAD = 9472;
constexpr float EPS = 1e-6f;

namespace pg8 {
#define PG8_LAS __attribute__((address_space(3)))
typedef unsigned short bf16_t;
typedef short bf16x8 __attribute__((ext_vector_type(8)));
typedef float f32x4 __attribute__((ext_vector_type(4)));
typedef unsigned u32x4 __attribute__((ext_vector_type(4)));
constexpr int BM = 256, BK = 64, HALF = 128, HTB = HALF * BK * 2  , STAGE_BYTES = 8 * HTB, NXCD = 8, WGM = 8;

__host__ __device__ __forceinline__ int lds_byte(int r, int c) { const int st = (r >> 4) * 2 + (c >> 5), rr = r & 15, cc = c & 31, ob = rr * 64 + cc * 2; return st * 1024 + (ob ^ (((ob >> 9) & 1) << 5)); }
__host__ __device__ __forceinline__ void stage_rc(int b, int& R, int& C) { const int st = b / 1024, sb = b % 1024, swz = sb ^ (((sb >> 9) & 1) << 5); R = (st >> 1) * 16 + swz / 64; C = (st & 1) * 32 + (swz % 64) / 2; }
__host__ __device__ __forceinline__ int perm32(int rho) { const int n = rho >> 4, i = rho & 15; return 8 * (i >> 2) + 4 * n + (i & 3); }

struct Unit { int pm, pn; };
struct Gemm { const bf16_t* A; const bf16_t* Bt; int M, N, K; };

struct StaticOrder {
    int nM, nN, nwg, G, c;
    __host__ __device__ void init(int M, int N, int G_, int c_) { nM = M / BM; nN = N / BM; nwg = nM * nN; G = G_; c = c_; }
    __host__ __device__ bool next(int i, Unit& u) const {
        const long L = (long)i * G + c; if (L >= nwg) return false;
        int wgid = (int)L; { const int q = nwg / NXCD, r = nwg % NXCD, xcd = wgid % NXCD, off = wgid / NXCD; wgid = (xcd < r ? xcd * (q + 1) : r * (q + 1) + (xcd - r) * q) + off; }
        const int nig = WGM * nN, gid = wgid / nig, fm = gid * WGM, gsz = (nM - fm) < WGM ? (nM - fm) : WGM;
        u.pm = fm + ((wgid % nig) % gsz); u.pn = (wgid % nig) / gsz; return true;
    }
    __device__ __forceinline__ void a_ready(const Unit&) const {}
    __device__ __forceinline__ void done(const Unit&) const {}
};


typedef float f32x2 __attribute__((ext_vector_type(2)));
typedef __bf16 bf16x2_t __attribute__((ext_vector_type(2)));
__device__ __forceinline__ unsigned cvt_pk_bf16(float lo, float hi) { const f32x2 v = {lo, hi}; const bf16x2_t b = __builtin_convertvector(v, bf16x2_t); return __builtin_bit_cast(unsigned, b); }
__device__ __forceinline__ u32x4 pack8(const f32x4 a, const f32x4 b) { u32x4 w; w.x = cvt_pk_bf16(a[0], a[1]); w.y = cvt_pk_bf16(a[2], a[3]); w.z = cvt_pk_bf16(b[0], b[1]); w.w = cvt_pk_bf16(b[2], b[3]); return w; }
__device__ __forceinline__ void unpack8(const u32x4 w, f32x4& a, f32x4& b) {
    a[0] = __uint_as_float(w.x << 16); a[1] = __uint_as_float(w.x & 0xffff0000u); a[2] = __uint_as_float(w.y << 16); a[3] = __uint_as_float(w.y & 0xffff0000u);
    b[0] = __uint_as_float(w.z << 16); b[1] = __uint_as_float(w.z & 0xffff0000u); b[2] = __uint_as_float(w.w << 16); b[3] = __uint_as_float(w.w & 0xffff0000u); }
__device__ __forceinline__ float sigm(float v) { return __builtin_amdgcn_rcpf(1.0f + __expf(-v)); }
__device__ __forceinline__ f32x4 sigm4(const f32x4 v) { return (f32x4){sigm(v[0]), sigm(v[1]), sigm(v[2]), sigm(v[3])}; }
__device__ __forceinline__ float sumsq4(const f32x4 v) { return (v[0] * v[0] + v[1] * v[1]) + (v[2] * v[2] + v[3] * v[3]); }

#define EPI_ROWS_BEGIN _Pragma("unroll") for (int ai = 0; ai < 2; ++ai) _Pragma("unroll") for (int m = 0; m < 4; ++m) { const int row = u.pm * BM + ai * HALF + wr * 64 + m * 16 + fr;
#define EPI_COLS_BEGIN _Pragma("unroll") for (int bj = 0; bj < 2; ++bj) { const int col = u.pn * BM + bj * HALF + wc * 32 + 8 * fq; const f32x4 v0 = acc[ai][bj][m][0], v1 = acc[ai][bj][m][1];
#define EPI_COLS_END }
#define EPI_ROWS_END }
typedef const f32x4 (&AccRef)[2][2][4][2];

struct EpiProj {
    static constexpr bool PERM = true, AFTER_DRAIN = false;
    bf16_t *HQ, *HV, *HOG, *MQG, *MKVG, *GA, *GB, *KB; float *F, *SSQQ, *SSQKV; const float *lb, *qn, *kvn; const f32x2* CS;
    __device__ __forceinline__ void operator()(AccRef acc, const Unit& u, int wr, int wc, int fr, int fq) const {
        const int seg = u.pn;
        EPI_ROWS_BEGIN
            float ss = 0.f;
            EPI_COLS_BEGIN
                if (seg < 4) { *(u32x4*)(HQ + (size_t)row * 1024 + col) = pack8(v0, v1); }
                else if (seg < 8) { const int c = col - 1024; const f32x4 l0 = *(const f32x4*)(lb + c), l1 = *(const f32x4*)(lb + c + 4);
                    const f32x4 f0 = l0 + (1.0f - l0) * sigm4(v0), f1 = l1 + (1.0f - l1) * sigm4(v1);
                    *(f32x4*)(F + (size_t)row * 1024 + c) = f0; *(f32x4*)(F + (size_t)row * 1024 + c + 4) = f1; }
                else if (seg < 12) { *(u32x4*)(HV + (size_t)row * 1024 + (col - 2048)) = pack8(v0, v1); }
                else if (seg < 16) { *(u32x4*)(HOG + (size_t)row * 1024 + (col - 3072)) = pack8(v0 * sigm4(v0), v1 * sigm4(v1)); }
                else if (seg < 18) { const int c = col - 4096; ss += sumsq4(v0) + sumsq4(v1);
                    *(u32x4*)(MQG + (size_t)row * 512 + c) = pack8(v0 * *(const f32x4*)(qn + c), v1 * *(const f32x4*)(qn + c + 4)); }
                else if (seg < 20) { const int c = col - 4608; ss += sumsq4(v0) + sumsq4(v1);
                    *(u32x4*)(MKVG + (size_t)row * 512 + c) = pack8(v0 * *(const f32x4*)(kvn + c), v1 * *(const f32x4*)(kvn + c + 4)); }
                else if (seg < 28) { *(u32x4*)(GA + (size_t)row * 2048 + (col - 5120)) = pack8(sigm4(v0), sigm4(v1)); }
                else if (seg < 36) { *(u32x4*)(GB + (size_t)row * 2048 + (col - 7168)) = pack8(sigm4(v0), sigm4(v1)); }
                else { const int c = col - 9216;
                    if (c < 64) { const f32x2* cs = CS + (size_t)row * 32 + (c >> 1); const f32x2 c0 = cs[0], c1 = cs[1], c2 = cs[2], c3 = cs[3];
                        f32x4 o0, o1; o0[0] = v0[0] * c0.x - v0[1] * c0.y; o0[1] = v0[1] * c0.x + v0[0] * c0.y; o0[2] = v0[2] * c1.x - v0[3] * c1.y; o0[3] = v0[3] * c1.x + v0[2] * c1.y;
                        o1[0] = v1[0] * c2.x - v1[1] * c2.y; o1[1] = v1[1] * c2.x + v1[0] * c2.y; o1[2] = v1[2] * c3.x - v1[3] * c3.y; o1[3] = v1[3] * c3.x + v1[2] * c3.y;
                        const u32x4 w = pack8(o0, o1);
#pragma unroll
                        for (int h = 0; h < MH; ++h) *(u32x4*)(KB + ((size_t)h * T + row) * MQK + MNOPE + c) = w; } }
            EPI_COLS_END
            if (seg >= 16 && seg < 20) { ss += __shfl_xor(ss, 16); ss += __shfl_xor(ss, 32);
                if (fq == 0) { float* S = seg < 18 ? SSQQ : SSQKV; S[(size_t)row * 8 + (seg & 1) * 4 + wc] = ss; } }
        EPI_ROWS_END
    }
};
constexpr float QSCALE = 0.07216878364870323f * 1.4426950408889634f;
struct EpiQ {
    static constexpr bool PERM = true, AFTER_DRAIN = false;
    bf16_t* Q; const float* SSQQ; const f32x2* CS;
    __device__ __forceinline__ void operator()(AccRef acc, const Unit& u, int wr, int wc, int fr, int fq) const {
        EPI_ROWS_BEGIN
            const f32x4 s0 = *(const f32x4*)(SSQQ + (size_t)row * 8), s1 = *(const f32x4*)(SSQQ + (size_t)row * 8 + 4);
            const float rs = __builtin_amdgcn_rsqf(((s0[0] + s0[1]) + (s0[2] + s0[3]) + (s1[0] + s1[1]) + (s1[2] + s1[3])) * (1.0f / MQL) + EPS) * QSCALE;
            EPI_COLS_BEGIN
                const int head = col / MQK, d = col - head * MQK; f32x4 a = v0 * rs, b = v1 * rs;
                if (d >= MNOPE) { const f32x2* cs = CS + (size_t)row * 32 + ((d - MNOPE) >> 1); const f32x2 c0 = cs[0], c1 = cs[1], c2 = cs[2], c3 = cs[3];
                    f32x4 o0, o1; o0[0] = a[0] * c0.x - a[1] * c0.y; o0[1] = a[1] * c0.x + a[0] * c0.y; o0[2] = a[2] * c1.x - a[3] * c1.y; o0[3] = a[3] * c1.x + a[2] * c1.y;
                    o1[0] = b[0] * c2.x - b[1] * c2.y; o1[1] = b[1] * c2.x + b[0] * c2.y; o1[2] = b[2] * c3.x - b[3] * c3.y; o1[3] = b[3] * c3.x + b[2] * c3.y; a = o0; b = o1; }
                *(u32x4*)(Q + ((size_t)head * T + row) * MQK + d) = pack8(a, b);
            EPI_COLS_END
        EPI_ROWS_END
    }
};
struct EpiKV {
    static constexpr bool PERM = true, AFTER_DRAIN = false;
    bf16_t *K, *V; const float* SSQKV;
    __device__ __forceinline__ void operator()(AccRef acc, const Unit& u, int wr, int wc, int fr, int fq) const {
        EPI_ROWS_BEGIN
            const f32x4 s0 = *(const f32x4*)(SSQKV + (size_t)row * 8), s1 = *(const f32x4*)(SSQKV + (size_t)row * 8 + 4);
            const float rs = __builtin_amdgcn_rsqf(((s0[0] + s0[1]) + (s0[2] + s0[3]) + (s1[0] + s1[1]) + (s1[2] + s1[3])) * (1.0f / MKVL) + EPS);
            EPI_COLS_BEGIN
                const int head = col >> 8, d = col & 255; const u32x4 w = pack8(v0 * rs, v1 * rs);
                if (d < MNOPE) *(u32x4*)(K + ((size_t)head * T + row) * MQK + d) = w; else *(u32x4*)(V + ((size_t)head * T + row) * MV + (d - MNOPE)) = w;
            EPI_COLS_END
        EPI_ROWS_END
    }
};
struct EpiPlain {
    static constexpr bool PERM = true, AFTER_DRAIN = false;
    bf16_t* O; int ldc;
    __device__ __forceinline__ void operator()(AccRef acc, const Unit& u, int wr, int wc, int fr, int fq) const {
        EPI_ROWS_BEGIN EPI_COLS_BEGIN *(u32x4*)(O + (size_t)row * ldc + col) = pack8(v0, v1); EPI_COLS_END EPI_ROWS_END
    }
};
struct EpiYb {
    static constexpr bool PERM = true, AFTER_DRAIN = false;
    const bf16_t* GB; bf16_t* YB;
    __device__ __forceinline__ void operator()(AccRef acc, const Unit& u, int wr, int wc, int fr, int fq) const {
        EPI_ROWS_BEGIN EPI_COLS_BEGIN f32x4 g0, g1; unpack8(*(const u32x4*)(GB + (size_t)row * DM + col), g0, g1); *(u32x4*)(YB + (size_t)row * DM + col) = pack8(v0 * g0, v1 * g1); EPI_COLS_END EPI_ROWS_END
    }
};
struct EpiY {
    static constexpr bool PERM = true, AFTER_DRAIN = false;
    const bf16_t *GA, *YB; bf16_t* Y;
    __device__ __forceinline__ void operator()(AccRef acc, const Unit& u, int wr, int wc, int fr, int fq) const {
        EPI_ROWS_BEGIN EPI_COLS_BEGIN f32x4 g0, g1, y0, y1; unpack8(*(const u32x4*)(GA + (size_t)row * DM + col), g0, g1); unpack8(*(const u32x4*)(YB + (size_t)row * DM + col), y0, y1);
            *(u32x4*)(Y + (size_t)row * DM + col) = pack8(v0 * g0 + y0, v1 * g1 + y1); EPI_COLS_END EPI_ROWS_END
    }
};
struct EpiX1 {
    static constexpr bool PERM = true, AFTER_DRAIN = false;
    const float *X, *gain; float *OUT, *SSQ; bf16_t* XG;
    __device__ __forceinline__ void operator()(AccRef acc, const Unit& u, int wr, int wc, int fr, int fq) const {
        EPI_ROWS_BEGIN
            float ss = 0.f;
            EPI_COLS_BEGIN
                const size_t o = (size_t)row * DM + col; const f32x4 a = *(const f32x4*)(X + o) + v0, b = *(const f32x4*)(X + o + 4) + v1;
                *(f32x4*)(OUT + o) = a; *(f32x4*)(OUT + o + 4) = b; ss += sumsq4(a) + sumsq4(b);
                *(u32x4*)(XG + o) = pack8(a * *(const f32x4*)(gain + col), b * *(const f32x4*)(gain + col + 4));
            EPI_COLS_END
            ss += __shfl_xor(ss, 16); ss += __shfl_xor(ss, 32);
            if (fq == 0) SSQ[(size_t)row * 32 + u.pn * 4 + wc] = ss;
        EPI_ROWS_END
    }
};
struct EpiPle {
    static constexpr bool PERM = true, AFTER_DRAIN = false;
    const bf16_t* PE; const float *SSQ2, *X2; float *OUT, *SSQ;
    __device__ __forceinline__ void operator()(AccRef acc, const Unit& u, int wr, int wc, int fr, int fq) const {
        EPI_ROWS_BEGIN
            const f32x4 q0 = *(const f32x4*)(SSQ2 + (size_t)row * 8), q1 = *(const f32x4*)(SSQ2 + (size_t)row * 8 + 4);
            const float rs = __builtin_amdgcn_rsqf((((q0[0] + q0[1]) + (q0[2] + q0[3])) + ((q1[0] + q1[1]) + (q1[2] + q1[3]))) * (1.0f / DM) + EPS); float ss = 0.f;
            EPI_COLS_BEGIN
                const size_t o = (size_t)row * DM + col; f32x4 p0, p1; unpack8(*(const u32x4*)(PE + o), p0, p1);
                const f32x4 a = *(const f32x4*)(X2 + o) + sigm4(v0 * rs) * p0, b = *(const f32x4*)(X2 + o + 4) + sigm4(v1 * rs) * p1;
                *(f32x4*)(OUT + o) = a; *(f32x4*)(OUT + o + 4) = b; ss += sumsq4(a) + sumsq4(b);
            EPI_COLS_END
            ss += __shfl_xor(ss, 16); ss += __shfl_xor(ss, 32);
            if (fq == 0) SSQ[(size_t)row * 32 + u.pn * 4 + wc] = ss;
        EPI_ROWS_END
    }
};

template <class Epi, class Sched, bool ALIGN_EPI = false, bool SP2 = false>
__device__ __forceinline__ void gemm_phase(PG8_LAS unsigned char* lds, const Gemm g, const Sched& S, const Epi& E) {
    const int tid = threadIdx.x, wid = __builtin_amdgcn_readfirstlane(tid >> 6), lane = tid & 63, wr = wid >> 2, wc = wid & 3, fr = lane & 15, fq = lane >> 4;
    const int K = g.K, nt = K / BK;
    unsigned voffA[2], voffB[2];
#pragma unroll
    for (int i = 0; i < 2; ++i) { int R, C; stage_rc(tid * 16 + i * 8192, R, C); const int Rb = Epi::PERM ? ((R & ~31) + perm32(R & 31)) : R;
        voffA[i] = (unsigned)(R * K + C) * 2u; voffB[i] = (unsigned)(Rb * K + C) * 2u; }
    const size_t kstep = (size_t)(BK * 2);
    const size_t hstep = (size_t)HALF * K * 2;
    const size_t tstep = 2 * hstep;
    const unsigned ldsw = (unsigned)wid * 1024u;
    const int aoff = lds_byte(wr * 64 + fr, fq * 8), boff = lds_byte(wc * 32 + fr, fq * 8);
#define PG8_SA(b, h) (((b) * 2 + (h)) * HTB)
#define PG8_SB(b, h) ((4 + (b) * 2 + (h)) * HTB)
#define PG8_STAGE(bufoff, gbase, voff) do { _Pragma("unroll") for (int _i = 0; _i < 2; ++_i) \
        __builtin_amdgcn_global_load_lds((const unsigned*)((const char*)(gbase) + (voff)[_i]), (PG8_LAS unsigned*)(lds + (bufoff) + ldsw + _i * 8192), 16, 0, 0); } while (0)
#define PG8_LDA(dst, b, h) do { _Pragma("unroll") for (int m = 0; m < 4; ++m) _Pragma("unroll") for (int k = 0; k < 2; ++k) dst[m][k] = *(const PG8_LAS bf16x8*)(lds + PG8_SA(b, h) + aoff + m * 2048 + k * 1024); } while (0)
#define PG8_LDB(dst, b, h) do { _Pragma("unroll") for (int n = 0; n < 2; ++n) _Pragma("unroll") for (int k = 0; k < 2; ++k) dst[n][k] = *(const PG8_LAS bf16x8*)(lds + PG8_SB(b, h) + boff + n * 2048 + k * 1024); } while (0)
#define PG8_MMA(ai, bj, At, Bt) do { __builtin_amdgcn_s_setprio(1); _Pragma("unroll") for (int m = 0; m < 4; ++m) _Pragma("unroll") for (int n = 0; n < 2; ++n) _Pragma("unroll") for (int k = 0; k < 2; ++k) \
        acc[ai][bj][m][n] = __builtin_amdgcn_mfma_f32_16x16x32_bf16(Bt[n][k], At[m][k], acc[ai][bj][m][n], 0, 0, 0); __builtin_amdgcn_s_setprio(0); } while (0)
#define PG8_WAIT_V(n) asm volatile("s_waitcnt vmcnt(" #n ")" ::: "memory")
#define PG8_WAIT_L(n) asm volatile("s_waitcnt lgkmcnt(" #n ")" ::: "memory")
#define PG8_BAR __builtin_amdgcn_s_barrier()
#define PG8_SCHED __builtin_amdgcn_sched_barrier(0)
    Unit cur, nxt; int ui = 0;
    if (!S.next(0, cur)) return;
    f32x4 acc[2][2][4][2];
#pragma unroll
    for (int a = 0; a < 2; ++a)
#pragma unroll
        for (int b = 0; b < 2; ++b)
#pragma unroll
            for (int m = 0; m < 4; ++m)
#pragma unroll
                for (int n = 0; n < 2; ++n) acc[a][b][m][n] = (f32x4){0.f, 0.f, 0.f, 0.f};
    bf16x8 At[4][2], B0[2][2], B1[2][2];
    const char* cA = (const char*)g.A + (size_t)cur.pm * tstep; const char* cB = (const char*)g.Bt + (size_t)cur.pn * tstep;
    S.a_ready(cur);
    if constexpr (SP2) {
        PG8_STAGE(PG8_SB(0, 0), cB, voffB); PG8_STAGE(PG8_SB(0, 1), cB + hstep, voffB); PG8_STAGE(PG8_SA(0, 0), cA, voffA); PG8_STAGE(PG8_SA(0, 1), cA + hstep, voffA);
        if (wr == 1) PG8_BAR;
        PG8_WAIT_V(2); PG8_BAR;
        PG8_STAGE(PG8_SB(1, 0), cB + kstep, voffB); PG8_STAGE(PG8_SA(1, 0), cA + kstep, voffA); PG8_STAGE(PG8_SB(1, 1), cB + hstep + kstep, voffB);
        PG8_WAIT_V(6); PG8_BAR;
    } else {
        PG8_STAGE(PG8_SB(0, 0), cB, voffB); PG8_STAGE(PG8_SA(0, 0), cA, voffA); PG8_STAGE(PG8_SB(0, 1), cB + hstep, voffB); PG8_STAGE(PG8_SA(0, 1), cA + hstep, voffA);
        if (wr == 1) PG8_BAR;
        PG8_WAIT_V(4); PG8_BAR;
        PG8_STAGE(PG8_SB(1, 0), cB + kstep, voffB); PG8_STAGE(PG8_SA(1, 0), cA + kstep, voffA); PG8_STAGE(PG8_SB(1, 1), cB + hstep + kstep, voffB);
        PG8_WAIT_V(6); PG8_BAR;
    }
    for (;;) {
        const bool has_next = S.next(ui + 1, nxt);
        const char* nA = has_next ? (const char*)g.A + (size_t)nxt.pm * tstep : cA; const char* nB = has_next ? (const char*)g.Bt + (size_t)nxt.pn * tstep : cB;
        for (int t = 0; t < nt; t += 2) {
            const bool last = (t == nt - 2);
            const char* a1 = cA + (size_t)(t + 1) * kstep;
            const char* a2 = last ? nA : cA + (size_t)(t + 2) * kstep; const char* b2 = last ? nB : cB + (size_t)(t + 2) * kstep;
            const char* a3 = a2 + kstep; const char* b3 = b2 + kstep;
            if (last && has_next) S.a_ready(nxt);
            if constexpr (SP2) {
            PG8_LDB(B0, 0, 0); PG8_LDB(B1, 0, 1); PG8_SCHED; PG8_LDA(At, 0, 0); PG8_STAGE(PG8_SA(1, 1), a1 + hstep, voffA);
            PG8_WAIT_V(8); PG8_WAIT_L(0); PG8_BAR; PG8_MMA(0, 0, At, B0); PG8_MMA(0, 1, At, B1); PG8_BAR; PG8_SCHED;
            PG8_LDA(At, 0, 1); PG8_STAGE(PG8_SB(0, 0), b2, voffB); PG8_STAGE(PG8_SB(0, 1), b2 + hstep, voffB); PG8_STAGE(PG8_SA(0, 0), a2, voffA);
            PG8_WAIT_V(8); PG8_WAIT_L(0); PG8_BAR; PG8_MMA(1, 0, At, B0); PG8_MMA(1, 1, At, B1); PG8_BAR; PG8_SCHED;
            PG8_LDB(B0, 1, 0); PG8_LDB(B1, 1, 1); PG8_SCHED; PG8_LDA(At, 1, 0); PG8_STAGE(PG8_SA(0, 1), a2 + hstep, voffA);
            PG8_WAIT_V(8); PG8_WAIT_L(0); PG8_BAR; PG8_MMA(0, 0, At, B0); PG8_MMA(0, 1, At, B1); PG8_BAR; PG8_SCHED;
            PG8_LDA(At, 1, 1); PG8_STAGE(PG8_SB(1, 0), b3, voffB); PG8_STAGE(PG8_SB(1, 1), b3 + hstep, voffB); PG8_STAGE(PG8_SA(1, 0), a3, voffA);
            PG8_WAIT_V(8); PG8_WAIT_L(0); PG8_BAR; PG8_MMA(1, 0, At, B0); PG8_MMA(1, 1, At, B1); PG8_BAR; PG8_SCHED;
            } else {
            PG8_LDB(B0, 0, 0); PG8_SCHED; PG8_LDA(At, 0, 0); PG8_STAGE(PG8_SA(1, 1), a1 + hstep, voffA);
            PG8_WAIT_L(8); PG8_BAR; PG8_WAIT_L(0); PG8_MMA(0, 0, At, B0); PG8_BAR; PG8_SCHED;
            PG8_LDB(B1, 0, 1); PG8_STAGE(PG8_SB(0, 0), b2, voffB);
            PG8_BAR; PG8_WAIT_L(0); PG8_MMA(0, 1, At, B1); PG8_BAR;
            PG8_LDA(At, 0, 1); PG8_STAGE(PG8_SA(0, 0), a2, voffA);
            PG8_BAR; PG8_WAIT_L(0); PG8_MMA(1, 0, At, B0); PG8_BAR; PG8_SCHED;
            PG8_STAGE(PG8_SB(0, 1), b2 + hstep, voffB);
            PG8_WAIT_V(6); PG8_BAR; PG8_MMA(1, 1, At, B1); PG8_BAR;
            PG8_LDB(B0, 1, 0); PG8_SCHED; PG8_LDA(At, 1, 0); PG8_STAGE(PG8_SA(0, 1), a2 + hstep, voffA);
            PG8_WAIT_L(8); PG8_BAR; PG8_WAIT_L(0); PG8_MMA(0, 0, At, B0); PG8_BAR; PG8_SCHED;
            PG8_LDB(B1, 1, 1); PG8_STAGE(PG8_SB(1, 0), b3, voffB);
            PG8_BAR; PG8_WAIT_L(0); PG8_MMA(0, 1, At, B1); PG8_BAR;
            PG8_LDA(At, 1, 1); PG8_STAGE(PG8_SA(1, 0), a3, voffA);
            PG8_BAR; PG8_WAIT_L(0); PG8_MMA(1, 0, At, B0); PG8_BAR; PG8_SCHED;
            PG8_STAGE(PG8_SB(1, 1), b3 + hstep, voffB);
            PG8_WAIT_V(6); PG8_BAR; PG8_MMA(1, 1, At, B1); PG8_BAR;
            }
        }
        if constexpr (ALIGN_EPI) { if (wr == 0) PG8_BAR; }
        if constexpr (!Epi::AFTER_DRAIN) { E(acc, cur, wr, wc, fr, fq); S.done(cur); }
        if (!has_next) break;
#pragma unroll
        for (int a = 0; a < 2; ++a)
#pragma unroll
            for (int b = 0; b < 2; ++b)
#pragma unroll
                for (int m = 0; m < 4; ++m)
#pragma unroll
                    for (int n = 0; n < 2; ++n) acc[a][b][m][n] = (f32x4){0.f, 0.f, 0.f, 0.f};
        cur = nxt; cA = nA; cB = nB; ++ui;
        if constexpr (ALIGN_EPI) { if (wr == 1) PG8_BAR; }
    }
    PG8_WAIT_V(0);
    if constexpr (!ALIGN_EPI) { if (wr == 0) PG8_BAR; }
    PG8_BAR;
    if constexpr (Epi::AFTER_DRAIN) { E.fused(acc, cur, wr, wc, fr, fq, lds, wid, lane); S.done(cur); }
#undef PG8_SA
#undef PG8_SB
#undef PG8_STAGE
#undef PG8_LDA
#undef PG8_LDB
#undef PG8_MMA
#undef PG8_WAIT_V
#undef PG8_WAIT_L
#undef PG8_BAR
#undef PG8_SCHED
}
}

#define LAS __attribute__((address_space(3)))
typedef unsigned short bf16_t;
typedef short bf16x8 __attribute__((ext_vector_type(8)));
typedef short s16x4 __attribute__((ext_vector_type(4)));
typedef float f32x2 __attribute__((ext_vector_type(2)));
typedef float f32x4 __attribute__((ext_vector_type(4)));
typedef float f32x16 __attribute__((ext_vector_type(16)));
typedef unsigned u32x2 __attribute__((ext_vector_type(2)));
typedef unsigned u32x4 __attribute__((ext_vector_type(4)));
using pg8::cvt_pk_bf16; using pg8::pack8; using pg8::unpack8; using pg8::sumsq4; using pg8::sigm;
#define LDS_WAIT() asm volatile("s_waitcnt lgkmcnt(0)" ::: "memory")
__device__ __forceinline__ float bf2f(unsigned short b) { return __uint_as_float((unsigned)b << 16); }
__device__ __forceinline__ unsigned short f2bf(float f) { return (unsigned short)(cvt_pk_bf16(f, 0.f) & 0xffffu); }
__device__ __forceinline__ float wave_sum(float v) {
#pragma unroll
    for (int o = 1; o < 64; o <<= 1) v += __shfl_xor(v, o);
    return v;
}

constexpr size_t MiB = 1u << 20;
constexpr size_t WS_CTL = 0, CTL_ZERO_BYTES = 64 * 1024;
constexpr size_t WS_LB = 1 * MiB;
constexpr size_t WS_K1B = WS_LB + 64 * 1024;
constexpr size_t WS_K2B = WS_K1B + 64 * 1024;
constexpr size_t WS_SSQQ = 2 * MiB;
constexpr size_t WS_SSQKV = WS_SSQQ + 256 * 1024;
constexpr size_t WS_SSQ2 = WS_SSQKV + 256 * 1024;
constexpr size_t WS_SSQ1 = 3 * MiB;
constexpr size_t WS_SSQ3 = 4 * MiB;
constexpr size_t WS_DECAY = 5 * MiB;
constexpr size_t WS_CS = 6 * MiB;
constexpr size_t WS_EIDX = 8 * MiB;
constexpr size_t WS_GATE = 12 * MiB;
constexpr size_t WS_WUQT = 16 * MiB, WS_WUKVT = 18 * MiB, WS_WAT = 20 * MiB, WS_WBT = 24 * MiB, WS_WOT = 28 * MiB, WS_WQT = 36 * MiB, WS_WPGT = 44 * MiB, WS_WPET = 52 * MiB, WS_PBF = 53 * MiB;
constexpr size_t WS_WINT = 58 * MiB;
constexpr size_t WS_SPT = 58 * MiB;
constexpr size_t WS_ACTA = 96 * MiB;
constexpr size_t WS_GA = 128 * MiB, WS_GB = 160 * MiB;
constexpr size_t WS_QP = WS_GA, WS_PE = WS_GB;
constexpr size_t WS_HQ = 192 * MiB, WS_F = 208 * MiB, WS_HV = 240 * MiB, WS_HOG = 256 * MiB, WS_Q = 272 * MiB, WS_K = 296 * MiB, WS_V = 320 * MiB;
constexpr size_t WS_U8 = 192 * MiB, WS_V8 = 224 * MiB;
constexpr size_t WS_SU = 1 * MiB + 256 * 1024, WS_SV = WS_SU + 64 * 1024;
constexpr size_t WS_MQG = 336 * MiB, WS_MKVG = 344 * MiB, WS_OB = 336 * MiB;
constexpr size_t WS_DST = 352 * MiB;
constexpr size_t WS_OA = 416 * MiB, WS_YB = 432 * MiB, WS_Y = 464 * MiB, WS_END = 496 * MiB;
constexpr size_t WS_ZP = 256 * MiB;
constexpr size_t WS_PA = 288 * MiB;
constexpr size_t WS_RS1 = WS_SU + 128 * 1024;
constexpr size_t WS_X2 = 432 * MiB;

#define XB_TMO      128
#define XB_XCNT(j)  (256  + 64 * (j))
#define XB_XSUB(j)  (1280 + 64 * (j))
#define XB_XGEN(j)  (2304 + 64 * (j))
#define XB_TOP      3328
#define XB_TOPGEN   3392
#define XCD_BAR_WORDS 3456
#define XB_SPIN_CAP (1u << 18)

__device__ __forceinline__ unsigned xb_ld(unsigned* p)              { return __hip_atomic_load(p, __ATOMIC_RELAXED, __HIP_MEMORY_SCOPE_AGENT); }
__device__ __forceinline__ unsigned xb_add(unsigned* p, unsigned v) { return __hip_atomic_fetch_add(p, v, __ATOMIC_RELAXED, __HIP_MEMORY_SCOPE_AGENT); }
__device__ __forceinline__ unsigned xb_xcc_id() { return (unsigned)__builtin_amdgcn_s_getreg((3 << 11) | 20) & 0xFu; }
#define XB_SPIN(cond, bar) do { unsigned _sp = 0; while (cond) { __builtin_amdgcn_s_sleep(1); \
    if ((++_sp & 255u) == 0u) { if (xb_ld(&(bar)[XB_TMO])) break; if (_sp > XB_SPIN_CAP) { atomicAdd(&(bar)[XB_TMO], 1u); break; } } } } while (0)

struct XcdBarrier {
    unsigned* bar; unsigned x;
    volatile LAS unsigned* st;
};

__device__ __forceinline__ XcdBarrier xcd_barrier_post(unsigned* bar, volatile LAS unsigned* st) {
    XcdBarrier b; b.bar = bar; b.x = xb_xcc_id(); b.st = st;
    if (threadIdx.x == 0) (void)xb_add(&bar[XB_XCNT(b.x)], 1u);
    return b;
}
__device__ __forceinline__ void xcd_barrier_complete(unsigned* bar, unsigned x, unsigned& nloc, unsigned& nx) {
    const unsigned G = gridDim.x * gridDim.y * gridDim.z;
    unsigned sum, cnt, mine, sp = 0u;
    for (;;) {
        sum = 0u; cnt = 0u; mine = 0u;
#pragma unroll
        for (unsigned j = 0; j < 16; ++j) { const unsigned c = xb_ld(&bar[XB_XCNT(j)]); sum += c; cnt += (c > 0u) ? 1u : 0u; mine = (j == x) ? c : mine; }
        if (sum == G) break;
        __builtin_amdgcn_s_sleep(1);
        if ((++sp & 255u) == 0u) { if (xb_ld(&bar[XB_TMO])) break; if (sp > XB_SPIN_CAP) { atomicAdd(&bar[XB_TMO], 1u); break; } }
    }
    nloc = mine > 0u ? mine : 1u; nx = cnt > 0u ? cnt : 1u;
}

__device__ __forceinline__ void xcd_barrier(const XcdBarrier& b) {
    asm volatile("s_waitcnt vmcnt(0)" ::: "memory");
    __syncthreads();
    if (threadIdx.x == 0) {
        unsigned* bar = b.bar;
        __builtin_amdgcn_s_waitcnt(0);
        unsigned nloc = b.st[0], nx = b.st[1];
        if (nloc == 0u) { xcd_barrier_complete(bar, b.x, nloc, nx); b.st[0] = nloc; b.st[1] = nx; }
        const unsigned old = xb_add(&bar[XB_XSUB(b.x)], 1u);
        const unsigned gen = old / nloc;
        if (old + 1u == (gen + 1u) * nloc) {
            __builtin_amdgcn_fence(__ATOMIC_RELEASE, "agent");
            asm volatile("s_waitcnt vmcnt(0)" ::: "memory");
            const unsigned og = xb_add(&bar[XB_TOP], 1u);
            const unsigned tg = og / nx;
            if (og + 1u == (tg + 1u) * nx) xb_add(&bar[XB_TOPGEN], 1u);
            else XB_SPIN(xb_ld(&bar[XB_TOPGEN]) == tg, bar);
            __builtin_amdgcn_fence(__ATOMIC_ACQUIRE, "agent");
            xb_add(&bar[XB_XGEN(b.x)], 1u);
            asm volatile("s_waitcnt vmcnt(0)" ::: "memory");
        } else {
            XB_SPIN(xb_ld(&bar[XB_XGEN(b.x)]) == gen, bar);
            __builtin_amdgcn_fence(__ATOMIC_ACQUIRE, "agent");
            asm volatile("s_waitcnt vmcnt(0)" ::: "memory");
        }
    }
    __syncthreads();
}

struct Ctx { LAS unsigned char* lds; int tid, lane, wave, G, bid; float* out; unsigned char* ws; };
__device__ __forceinline__ const void* karg_ptr(int i) { return ((const void* const __attribute__((address_space(4)))*)__builtin_amdgcn_kernarg_segment_ptr())[i]; }
#define IP(i) ((const float*)karg_ptr(i))
#define WSP(type, off) ((type*)(C.ws + (off)))

__device__ __forceinline__ int ilv64(int i) { return i < 32 ? 2 * i : 2 * (i - 32) + 1; }
template <int MAP> __device__ __forceinline__ int colmap(int n) {
    if (MAP == 1) { if (n < 5120) return n; if (n < 5184) return 9216 + ilv64(n - 5120); return n - 64; }
    if (MAP == 2) { const int h = n / MQK, d = n - h * MQK; return d < MNOPE ? n : h * MQK + MNOPE + ilv64(d - MNOPE); }
    return n;
}
template <int MAP> __device__ __forceinline__ void p0_transpose_item(const float* W, int K, int N, bf16_t* WT, LAS float* scr, int item, int lane) {
    const int nblk = N / 32, kb = item / nblk, nb = item % nblk, k0 = 64 * kb, n0 = 32 * nb;
#pragma unroll 8
    for (int i = 0; i < 32; ++i) { const int kk = 2 * i + (lane >> 5); scr[kk * 33 + (lane & 31)] = W[(size_t)(k0 + kk) * N + n0 + (lane & 31)]; }
    LDS_WAIT(); asm volatile("" ::: "memory");
    const int c = lane & 7;
#pragma unroll
    for (int j = 0; j < 4; ++j) { const int n = (lane >> 3) + 8 * j; const LAS float* s = scr + (8 * c) * 33 + n;
        u32x4 o; o.x = cvt_pk_bf16(s[0 * 33], s[1 * 33]); o.y = cvt_pk_bf16(s[2 * 33], s[3 * 33]); o.z = cvt_pk_bf16(s[4 * 33], s[5 * 33]); o.w = cvt_pk_bf16(s[6 * 33], s[7 * 33]);
        *(u32x4*)(WT + (size_t)colmap<MAP>(n0 + n) * K + k0 + 8 * c) = o; }
    LDS_WAIT(); asm volatile("" ::: "memory");
}
__device__ __forceinline__ void rms_row_to_bf16(const float* xrow, const float* gain, bf16_t* orow, int lane) {
    const f32x4* xr = (const f32x4*)xrow + lane; const f32x4* gr = (const f32x4*)gain + lane;
    f32x4 v[8]; float s = 0.f;
#pragma unroll
    for (int j = 0; j < 8; ++j) { v[j] = xr[64 * j]; s += sumsq4(v[j]); }
    const float rs = __builtin_amdgcn_rsqf(wave_sum(s) * (1.0f / DM) + EPS);
    u32x2* o8 = (u32x2*)orow + lane;
#pragma unroll
    for (int j = 0; j < 8; ++j) { const f32x4 y = v[j] * rs * gr[64 * j]; u32x2 w; w.x = cvt_pk_bf16(y[0], y[1]); w.y = cvt_pk_bf16(y[2], y[3]); o8[64 * j] = w; }
}
__device__ __forceinline__ void cvt_copy(const float* src, bf16_t* dst, size_t n, size_t gtid, size_t nthr) {
    for (size_t i = gtid; i < n / 8; i += nthr) { const f32x4 a = ((const f32x4*)src)[2 * i], b = ((const f32x4*)src)[2 * i + 1]; ((u32x4*)dst)[i] = pack8(a, b); }
}

__device__ __forceinline__ void phase_prep(const Ctx& C) {
    LAS float* scr = (LAS float*)(C.lds + C.wave * 16384);
    const int gw = C.bid * 8 + C.wave, NGW = C.G * 8;
    constexpr int I_IN = (DM / 64) * (INW / 32), I_UQ = (MQL / 64) * (MH * MQK / 32), I_UKV = (MKVL / 64) * (2048 / 32), I_A = (HGW / 64) * (DM / 32), I_O = (DM / 64) * (DM / 32), I_PE = (PLE / 64) * (DM / 32);
    constexpr int NITEMS = I_IN + I_UQ + I_UKV + 2 * I_A + 3 * I_O + I_PE;
    for (int it = gw; it < NITEMS; it += NGW) {
        int r = it;
        if (r < I_IN) { p0_transpose_item<1>(IP(4), DM, INW, WSP(bf16_t, WS_WINT), scr, r, C.lane); continue; } r -= I_IN;
        if (r < I_UQ) { p0_transpose_item<2>(IP(9), MQL, MH * MQK, WSP(bf16_t, WS_WUQT), scr, r, C.lane); continue; } r -= I_UQ;
        if (r < I_UKV) { p0_transpose_item<0>(IP(10), MKVL, 2048, WSP(bf16_t, WS_WUKVT), scr, r, C.lane); continue; } r -= I_UKV;
        if (r < I_A) { p0_transpose_item<0>(IP(11), HGW, DM, WSP(bf16_t, WS_WAT), scr, r, C.lane); continue; } r -= I_A;
        if (r < I_A) { p0_transpose_item<0>(IP(12), HGW, DM, WSP(bf16_t, WS_WBT), scr, r, C.lane); continue; } r -= I_A;
        if (r < I_O) { p0_transpose_item<0>(IP(13), DM, DM, WSP(bf16_t, WS_WOT), scr, r, C.lane); continue; } r -= I_O;
        if (r < I_O) { p0_transpose_item<0>(IP(15), DM, DM, WSP(bf16_t, WS_WQT), scr, r, C.lane); continue; } r -= I_O;
        if (r < I_O) { p0_transpose_item<0>(IP(21), DM, DM, WSP(bf16_t, WS_WPGT), scr, r, C.lane); continue; } r -= I_O;
        p0_transpose_item<0>(IP(22), PLE, DM, WSP(bf16_t, WS_WPET), scr, r, C.lane);
    }
    for (int m = gw; m < T; m += NGW) rms_row_to_bf16(IP(0) + (size_t)m * DM, IP(3), WSP(bf16_t, WS_ACTA) + (size_t)m * DM, C.lane);
    const size_t gtid = (size_t)C.bid * 512 + C.tid, nthr = (size_t)C.G * 512;
    { u32x4* z = (u32x4*)(WSP(bf16_t, WS_WINT) + (size_t)INW * DM); for (size_t i = gtid; i < (size_t)(INW_PAD - INW) * DM / 8; i += nthr) z[i] = (u32x4){0u, 0u, 0u, 0u}; }
    cvt_copy(IP(1), WSP(bf16_t, WS_PBF), (size_t)T * PLE, gtid, nthr);
    cvt_copy(IP(16), WSP(bf16_t, WS_K1B), (size_t)PNK * 128, gtid, nthr);
    cvt_copy(IP(17), WSP(bf16_t, WS_K2B), (size_t)PNK * 128, gtid, nthr);
    for (size_t i = gtid; i < HGW; i += nthr) WSP(float, WS_LB)[i] = 1.0f / (1.0f + __expf(IP(5)[HGW + i] - IP(5)[i]));
    for (size_t e = gtid; e < (size_t)T * 32; e += nthr) { const int t = (int)(e >> 5), i = (int)(e & 31);
        double fr = 1.0; for (int k = 0; k < i; ++k) fr *= 0.74989420933245582;
        const float ang = (float)((const int*)karg_ptr(2))[t] * (float)fr; const double rev = (double)ang * 0.15915494309189535; const float fx = (float)(rev - floor(rev));
        WSP(f32x2, WS_CS)[e] = (f32x2){__builtin_amdgcn_cosf(fx), __builtin_amdgcn_sinf(fx)}; }
}

__device__ __forceinline__ void hgrn_cumsum(const Ctx& C, int h, int n, float (&fv)[16], float (&bb)[16], float& b_ref, float& b_last, LAS float* TOT) {
    const int d = C.tid & 127, rg = C.tid >> 7; const float* F = WSP(float, WS_F) + ((size_t)(n * HGC + rg * 16)) * HGW + h * HGD + d;
    float run = 0.f;
#pragma unroll
    for (int i = 0; i < 16; ++i) { fv[i] = F[(size_t)i * HGW]; run += __logf(fv[i]); bb[i] = run; }
    TOT[rg * 128 + d] = run; LDS_WAIT(); __syncthreads();
    const float t0 = TOT[d], t1 = TOT[128 + d], t2 = TOT[256 + d], t3 = TOT[384 + d];
    const float off = rg == 0 ? 0.f : rg == 1 ? t0 : rg == 2 ? t0 + t1 : (t0 + t1) + t2;
    b_ref = t0 + t1; b_last = ((t0 + t1) + t2) + t3;
#pragma unroll
    for (int i = 0; i < 16; ++i) bb[i] += off;
}
constexpr int HG_KDT = 0, HG_VT = 18432, HG_TOT = 36864;
__device__ __forceinline__ void hgrn_a_unit(const Ctx& C, int h, int n) {
    LAS bf16_t* KDT = (LAS bf16_t*)(C.lds + HG_KDT); LAS bf16_t* VT = (LAS bf16_t*)(C.lds + HG_VT); LAS float* TOT = (LAS float*)(C.lds + HG_TOT);
    const int d = C.tid & 127, rg = C.tid >> 7;
    float fv[16], bb[16], b_ref, b_last; hgrn_cumsum(C, h, n, fv, bb, b_ref, b_last, TOT);
    const bf16_t* HVp = WSP(bf16_t, WS_HV) + ((size_t)(n * HGC + rg * 16)) * HGW + h * HGD + d;
#pragma unroll
    for (int g = 0; g < 2; ++g) { float kd[8], vv[8];
#pragma unroll
        for (int i = 0; i < 8; ++i) { const int r = g * 8 + i; kd[i] = (1.0f - fv[r]) * __expf(b_last - bb[r]); vv[i] = bf2f(HVp[(size_t)r * HGW]); }
        u32x4 wk, wv; wk.x = cvt_pk_bf16(kd[0], kd[1]); wk.y = cvt_pk_bf16(kd[2], kd[3]); wk.z = cvt_pk_bf16(kd[4], kd[5]); wk.w = cvt_pk_bf16(kd[6], kd[7]);
        wv.x = cvt_pk_bf16(vv[0], vv[1]); wv.y = cvt_pk_bf16(vv[2], vv[3]); wv.z = cvt_pk_bf16(vv[4], vv[5]); wv.w = cvt_pk_bf16(vv[6], vv[7]);
        *(LAS u32x4*)(KDT + d * 72 + rg * 16 + g * 8) = wk; *(LAS u32x4*)(VT + d * 72 + rg * 16 + g * 8) = wv; }
    if (rg == 0) WSP(float, WS_DECAY)[((size_t)h * HGNC + n) * HGD + d] = __expf(b_last);
    LDS_WAIT(); __syncthreads();
    const int fr = C.lane & 15, fq = C.lane >> 4, w = C.wave;
    bf16x8 bfr[2];
#pragma unroll
    for (int ks = 0; ks < 2; ++ks) bfr[ks] = *(const LAS bf16x8*)(VT + (16 * w + fr) * 72 + 8 * fq + 32 * ks);
    float* DST = WSP(float, WS_DST) + (((size_t)h * HGNC + n) * HGD + 16 * w + fr) * HGD;
#pragma unroll
    for (int mt = 0; mt < 8; ++mt) { f32x4 acc = {0.f, 0.f, 0.f, 0.f};
#pragma unroll
        for (int ks = 0; ks < 2; ++ks) { const bf16x8 a = *(const LAS bf16x8*)(KDT + (16 * mt + fr) * 72 + 8 * fq + 32 * ks); acc = __builtin_amdgcn_mfma_f32_16x16x32_bf16(a, bfr[ks], acc, 0, 0, 0); }
        *(f32x4*)(DST + 16 * mt + 4 * fq) = acc; }
    LDS_WAIT(); __syncthreads();
}
__device__ __forceinline__ void hgrn_scan(const Ctx& C) {
    const float* DST = WSP(float, WS_DST); const float* DEC = WSP(float, WS_DECAY); bf16_t* SPT = WSP(bf16_t, WS_SPT);
    for (int e = C.bid * 512 + C.tid; e < HGH * HGD * HGD; e += C.G * 512) {
        const int h = e >> 14, dv = (e >> 7) & 127, dk = e & 127; float S = 0.f;
        const size_t base = ((size_t)h * HGNC * HGD + dv) * HGD + dk; const size_t dbase = (size_t)h * HGNC * HGD + dk;
#pragma unroll 8
        for (int n = 0; n < HGNC; ++n) { SPT[base + (size_t)n * HGD * HGD] = f2bf(S); S = DEC[dbase + (size_t)n * HGD] * S + DST[base + (size_t)n * HGD * HGD]; }
    }
}
constexpr int HC_QIN = 0, HC_KIN = 17408, HC_QE = 34816, HC_VT = 52224, HC_AQ = 70656, HC_TOT = 79872, HC_OL = 81920;
__device__ __forceinline__ void hgrn_c_unit(const Ctx& C, int h, int n) {
    LAS bf16_t* QIN = (LAS bf16_t*)(C.lds + HC_QIN); LAS bf16_t* KIN = (LAS bf16_t*)(C.lds + HC_KIN); LAS bf16_t* QE = (LAS bf16_t*)(C.lds + HC_QE);
    LAS bf16_t* VT = (LAS bf16_t*)(C.lds + HC_VT); LAS bf16_t* AQ = (LAS bf16_t*)(C.lds + HC_AQ); LAS float* TOT = (LAS float*)(C.lds + HC_TOT); LAS float* OL = (LAS float*)(C.lds + HC_OL);
    const int d = C.tid & 127, rg = C.tid >> 7;
    float fv[16], bb[16], b_ref, b_last; hgrn_cumsum(C, h, n, fv, bb, b_ref, b_last, TOT);
    const size_t gro = ((size_t)(n * HGC + rg * 16)) * HGW + h * HGD + d; const bf16_t* HVp = WSP(bf16_t, WS_HV) + gro; const bf16_t* HQp = WSP(bf16_t, WS_HQ) + gro;
#pragma unroll
    for (int g = 0; g < 2; ++g) { float vv[8];
#pragma unroll
        for (int i = 0; i < 8; ++i) { const int r = g * 8 + i, c = rg * 16 + r; const float q = bf2f(HQp[(size_t)r * HGW]), k = 1.0f - fv[r];
            QIN[c * 136 + d] = f2bf(q * __expf(bb[r] - b_ref)); KIN[c * 136 + d] = f2bf(k * __expf(b_ref - bb[r])); QE[c * 136 + d] = f2bf(q * __expf(bb[r])); vv[i] = bf2f(HVp[(size_t)r * HGW]); }
        u32x4 wv; wv.x = cvt_pk_bf16(vv[0], vv[1]); wv.y = cvt_pk_bf16(vv[2], vv[3]); wv.z = cvt_pk_bf16(vv[4], vv[5]); wv.w = cvt_pk_bf16(vv[6], vv[7]);
        *(LAS u32x4*)(VT + d * 72 + rg * 16 + g * 8) = wv; }
    LDS_WAIT(); __syncthreads();
    const int fr = C.lane & 15, fq = C.lane >> 4, w = C.wave;
    { const int mt = w >> 1;
#pragma unroll
      for (int j = 0; j < 2; ++j) { const int nt = 2 * (w & 1) + j; f32x4 acc = {0.f, 0.f, 0.f, 0.f};
#pragma unroll
        for (int ks = 0; ks < 4; ++ks) { const bf16x8 a = *(const LAS bf16x8*)(QIN + (16 * mt + fr) * 136 + 8 * fq + 32 * ks), b = *(const LAS bf16x8*)(KIN + (16 * nt + fr) * 136 + 8 * fq + 32 * ks);
            acc = __builtin_amdgcn_mfma_f32_16x16x32_bf16(a, b, acc, 0, 0, 0); }
        const int s = 16 * nt + fr;
#pragma unroll
        for (int i = 0; i < 4; ++i) { const int c = 16 * mt + 4 * fq + i; AQ[c * 72 + s] = f2bf(s <= c ? acc[i] : 0.f); } } }
    LDS_WAIT(); __syncthreads();
    { bf16x8 bv[2], bs[4]; const bf16_t* SP = WSP(bf16_t, WS_SPT) + (((size_t)h * HGNC + n) * HGD + 16 * w + fr) * HGD;
#pragma unroll
      for (int ks = 0; ks < 2; ++ks) bv[ks] = *(const LAS bf16x8*)(VT + (16 * w + fr) * 72 + 8 * fq + 32 * ks);
#pragma unroll
      for (int ks = 0; ks < 4; ++ks) bs[ks] = *(const bf16x8*)(SP + 8 * fq + 32 * ks);
#pragma unroll
      for (int mt = 0; mt < 4; ++mt) { f32x4 acc = {0.f, 0.f, 0.f, 0.f};
#pragma unroll
        for (int ks = 0; ks < 2; ++ks) { const bf16x8 a = *(const LAS bf16x8*)(AQ + (16 * mt + fr) * 72 + 8 * fq + 32 * ks); acc = __builtin_amdgcn_mfma_f32_16x16x32_bf16(a, bv[ks], acc, 0, 0, 0); }
#pragma unroll
        for (int ks = 0; ks < 4; ++ks) { const bf16x8 a = *(const LAS bf16x8*)(QE + (16 * mt + fr) * 136 + 8 * fq + 32 * ks); acc = __builtin_amdgcn_mfma_f32_16x16x32_bf16(a, bs[ks], acc, 0, 0, 0); }
#pragma unroll
        for (int i = 0; i < 4; ++i) OL[(16 * mt + 4 * fq + i) * 132 + 16 * w + fr] = acc[i]; } }
    LDS_WAIT(); __syncthreads();
    { const int c = C.tid >> 3, j = C.tid & 7; f32x4 o[4]; float ss = 0.f;
#pragma unroll
      for (int i = 0; i < 4; ++i) { o[i] = *(const LAS f32x4*)(OL + c * 132 + 16 * j + 4 * i); ss += sumsq4(o[i]); }
      ss += __shfl_xor(ss, 1); ss += __shfl_xor(ss, 2); ss += __shfl_xor(ss, 4);
      const float rs = __builtin_amdgcn_rsqf(ss * (1.0f / HGD) + EPS); const size_t go = (size_t)(n * HGC + c) * HGW + h * HGD + 16 * j;
      const float* gn = IP(6) + h * HGD + 16 * j; const bf16_t* HOG = WSP(bf16_t, WS_HOG) + go; bf16_t* OA = WSP(bf16_t, WS_OA) + go;
#pragma unroll
      for (int i = 0; i < 2; ++i) { f32x4 s0, s1; unpack8(*(const u32x4*)(HOG + 8 * i), s0, s1);
          *(u32x4*)(OA + 8 * i) = pack8(o[2 * i] * rs * *(const f32x4*)(gn + 8 * i) * s0, o[2 * i + 1] * rs * *(const f32x4*)(gn + 8 * i + 4) * s1); } }
    LDS_WAIT(); __syncthreads();
}

constexpr int AT_K = 0, AT_KSTR = 400, AT_V = 25600, AT_MRG = 0, AT_MRG_STRIDE = 16384 + 256;
typedef short v4i16_t __attribute__((ext_vector_type(4)));
__device__ __forceinline__ s16x4 vtr(const LAS unsigned char* p) { return __builtin_bit_cast(s16x4, __builtin_amdgcn_ds_read_tr16_b64_v4i16((LAS v4i16_t*)p)); }
__device__ __forceinline__ int crow(int r, int hi) { return (r & 3) + 8 * (r >> 2) + 4 * hi; }
__device__ __forceinline__ void attn_unit(const Ctx& C, int h, int qb) {
    const int lane = C.lane, ql = lane & 31, hi = lane >> 5, kg = C.wave >> 2, qw = C.wave & 3, tid = C.tid;
    const int q0 = qb * 128, ntiles = 2 * (qb + 1), qpos = q0 + 32 * qw + ql;
    const bf16_t* Qp = WSP(bf16_t, WS_Q) + ((size_t)h * T + qpos) * MQK + 8 * hi; const bf16_t* Kp = WSP(bf16_t, WS_K) + (size_t)h * T * MQK; const bf16_t* Vp = WSP(bf16_t, WS_V) + (size_t)h * T * MV;
    bf16x8 qf[12];
#pragma unroll
    for (int ks = 0; ks < 12; ++ks) qf[ks] = *(const bf16x8*)(Qp + 16 * ks);
    float m_run = -1e30f, l_run = 0.f; f32x16 oT[4];
#pragma unroll
    for (int nb = 0; nb < 4; ++nb) oT[nb] = (f32x16){0.f, 0.f, 0.f, 0.f, 0.f, 0.f, 0.f, 0.f, 0.f, 0.f, 0.f, 0.f, 0.f, 0.f, 0.f, 0.f};
    const LAS unsigned char* kfrag = C.lds + AT_K + (32 * kg + ql) * AT_KSTR + 16 * hi;
    const LAS unsigned char* vfrag = C.lds + AT_V + (16 * kg) * 512 + (4 * hi + ((lane & 15) >> 2)) * 64 + ((lane >> 4) & 1) * 32 + (lane & 3) * 8;
    for (int j = 0; j < ntiles; ++j) {
        const int k0 = 64 * j;
        __syncthreads();
#pragma unroll
        for (int i = 0; i < 3; ++i) { const int cid = tid + 512 * i, r = cid / 24, cc = cid - r * 24; *(LAS u32x4*)(C.lds + AT_K + r * AT_KSTR + cc * 16) = *(const u32x4*)(Kp + (size_t)(k0 + r) * MQK + cc * 8); }
#pragma unroll
        for (int i = 0; i < 2; ++i) { const int cid = tid + 512 * i, r = cid >> 4, cc = cid & 15; *(LAS u32x4*)(C.lds + AT_V + ((r >> 3) * 4 + (cc >> 2)) * 512 + (r & 7) * 64 + (cc & 3) * 16) = *(const u32x4*)(Vp + (size_t)(k0 + r) * MV + cc * 8); }
        LDS_WAIT(); __syncthreads();
        const int kbase = k0 + 32 * kg;
        if (kbase <= q0 + 32 * qw + 31) {
            f32x16 st = (f32x16){0.f, 0.f, 0.f, 0.f, 0.f, 0.f, 0.f, 0.f, 0.f, 0.f, 0.f, 0.f, 0.f, 0.f, 0.f, 0.f};
#pragma unroll
            for (int ks = 0; ks < 12; ++ks) { const bf16x8 a = *(const LAS bf16x8*)(kfrag + 32 * ks); st = __builtin_amdgcn_mfma_f32_32x32x16_bf16(a, qf[ks], st, 0, 0, 0); }
            if (kbase + 31 > q0 + 32 * qw) {
#pragma unroll
                for (int r = 0; r < 16; ++r) if (kbase + crow(r, hi) > qpos) st[r] = -__builtin_inff();
            }
            float mx = st[0];
#pragma unroll
            for (int r = 1; r < 16; ++r) mx = fmaxf(mx, st[r]);
            mx = fmaxf(mx, __shfl_xor(mx, 32));
            const float m_new = fmaxf(m_run, mx), alpha = __builtin_amdgcn_exp2f(m_run - m_new); m_run = m_new;
            float ps = 0.f;
#pragma unroll
            for (int r = 0; r < 16; ++r) { st[r] = __builtin_amdgcn_exp2f(st[r] - m_new); ps += st[r]; }
            ps += __shfl_xor(ps, 32); l_run = l_run * alpha + ps;
#pragma unroll
            for (int nb = 0; nb < 4; ++nb) oT[nb] *= alpha;
            bf16x8 pf[2];
#pragma unroll
            for (int s2 = 0; s2 < 2; ++s2) { u32x4 w; w.x = cvt_pk_bf16(st[8 * s2 + 0], st[8 * s2 + 1]); w.y = cvt_pk_bf16(st[8 * s2 + 2], st[8 * s2 + 3]); w.z = cvt_pk_bf16(st[8 * s2 + 4], st[8 * s2 + 5]); w.w = cvt_pk_bf16(st[8 * s2 + 6], st[8 * s2 + 7]); pf[s2] = __builtin_bit_cast(bf16x8, w); }
#pragma unroll
            for (int nb = 0; nb < 4; ++nb)
#pragma unroll
                for (int s2 = 0; s2 < 2; ++s2) { const s16x4 lo = vtr(vfrag + (8 * s2) * 512 + nb * 512), hh = vtr(vfrag + (8 * s2 + 4) * 512 + nb * 512);
                    const bf16x8 vf = (bf16x8){lo[0], lo[1], lo[2], lo[3], hh[0], hh[1], hh[2], hh[3]};
                    oT[nb] = __builtin_amdgcn_mfma_f32_32x32x16_bf16(vf, pf[s2], oT[nb], 0, 0, 0); }
        }
    }
    __syncthreads();
    LAS float* MG = (LAS float*)(C.lds + AT_MRG + qw * AT_MRG_STRIDE);
    if (kg == 1) { if (hi == 0) { MG[2 * ql] = m_run; MG[2 * ql + 1] = l_run; }
#pragma unroll
        for (int nb = 0; nb < 4; ++nb)
#pragma unroll
            for (int r = 0; r < 16; ++r) MG[64 + (nb * 16 + r) * 64 + lane] = oT[nb][r]; }
    LDS_WAIT(); __syncthreads();
    if (kg == 0) { const float m2 = MG[2 * ql], l2 = MG[2 * ql + 1], mm = fmaxf(m_run, m2), a1 = __builtin_amdgcn_exp2f(m_run - mm), a2 = __builtin_amdgcn_exp2f(m2 - mm);
        const float inv = 1.0f / (a1 * l_run + a2 * l2); const float c1 = a1 * inv, c2 = a2 * inv;
        bf16_t* O = WSP(bf16_t, WS_OB) + (size_t)qpos * HGW + h * MV + 4 * hi;
#pragma unroll
        for (int nb = 0; nb < 4; ++nb)
#pragma unroll
            for (int g = 0; g < 4; ++g) { float o[4];
#pragma unroll
                for (int i = 0; i < 4; ++i) { const int r = 4 * g + i; o[i] = c1 * oT[nb][r] + c2 * MG[64 + (nb * 16 + r) * 64 + lane]; }
                u32x2 w; w.x = cvt_pk_bf16(o[0], o[1]); w.y = cvt_pk_bf16(o[2], o[3]); *(u32x2*)(O + 32 * nb + 8 * g) = w; } }
    LDS_WAIT();
}

constexpr int TK_K1 = 0, TK_K2 = 34816, TK_KSTR = 272, TK_IDX = 69632;
__device__ __forceinline__ int f2ord(float f) { const int i = __float_as_int(f); return i >= 0 ? i : (i ^ 0x7fffffff); }
__device__ __forceinline__ float ord2f(int k) { return __int_as_float(k >= 0 ? k : (k ^ 0x7fffffff)); }
#define TK_INS(L, x) do { int _x = (x); _Pragma("unroll") for (int _i = 0; _i < 16; ++_i) { const int _t = max(L[_i], _x); _x = min(L[_i], _x); L[_i] = _t; } } while (0)
__device__ __forceinline__ void topk_stage_keys(const Ctx& C) {
#pragma unroll
    for (int i = 0; i < 8; ++i) { const int cid = C.tid + 512 * i, tb = cid >> 11, r = (cid >> 4) & 127, cc = cid & 15;
        *(LAS u32x4*)(C.lds + tb * TK_K2 + r * TK_KSTR + cc * 16) = *(const u32x4*)(WSP(bf16_t, tb ? WS_K2B : WS_K1B) + r * 128 + cc * 8); }
    LDS_WAIT(); __syncthreads();
}
__device__ __forceinline__ void topk_wave(const Ctx& C, int tb, int head) {
    const int lane = C.lane, tl = lane & 31, hi = lane >> 5, t = tb * 32 + tl;
    int v12[2][16];
#pragma unroll
    for (int half = 0; half < 2; ++half) {
        f32x16 acc[4];
#pragma unroll
        for (int kt = 0; kt < 4; ++kt) acc[kt] = (f32x16){0.f, 0.f, 0.f, 0.f, 0.f, 0.f, 0.f, 0.f, 0.f, 0.f, 0.f, 0.f, 0.f, 0.f, 0.f, 0.f};
        const bf16_t* qp = WSP(bf16_t, WS_QP) + (size_t)t * DM + head * PQD + half * 128 + 8 * hi; const LAS unsigned char* kp = C.lds + half * TK_K2 + tl * TK_KSTR + 16 * hi;
#pragma unroll
        for (int ks = 0; ks < 8; ++ks) { const bf16x8 bq = *(const bf16x8*)(qp + 16 * ks);
#pragma unroll
            for (int kt = 0; kt < 4; ++kt) { const bf16x8 ak = *(const LAS bf16x8*)(kp + kt * 32 * TK_KSTR + 32 * ks); acc[kt] = __builtin_amdgcn_mfma_f32_32x32x16_bf16(ak, bq, acc[kt], 0, 0, 0); } }
        int L[16];
#pragma unroll
        for (int i = 0; i < 16; ++i) L[i] = (int)0x80000000;
#pragma unroll
        for (int kt = 0; kt < 4; ++kt)
#pragma unroll
            for (int r = 0; r < 16; ++r) { const int key = 32 * kt + (r & 3) + 8 * (r >> 2) + 4 * hi; TK_INS(L, (f2ord(acc[kt][r]) & ~127) | (127 - key)); }
        int P[16];
#pragma unroll
        for (int i = 0; i < 16; ++i) P[i] = __shfl_xor(L[i], 32);
#pragma unroll
        for (int i = 0; i < 16; ++i) TK_INS(L, P[i]);
#pragma unroll
        for (int i = 0; i < 16; ++i) v12[half][i] = L[i];
    }
    LAS int* IDX = (LAS int*)(C.lds + TK_IDX + 4096 * C.wave) + tl * 32;
#pragma unroll
    for (int g = 0; g < 4; ++g) { u32x4 w;
#pragma unroll
        for (int i = 0; i < 4; ++i) w[i] = (unsigned)(127 - ((hi ? v12[1][4 * g + i] : v12[0][4 * g + i]) & 127));
        *(LAS u32x4*)(IDX + 16 * hi + 4 * g) = w; }
    float f1[16], f2[16];
#pragma unroll
    for (int i = 0; i < 16; ++i) { f1[i] = ord2f(v12[0][i] & ~127); f2[i] = ord2f(v12[1][i] & ~127); }
    int CL[16];
#pragma unroll
    for (int i = 0; i < 16; ++i) CL[i] = (int)0x80000000;
#pragma unroll
    for (int ca = 0; ca < 16; ++ca)
#pragma unroll
        for (int cb = 0; cb < 16; ++cb) if ((ca + 1) * (cb + 1) <= 16) TK_INS(CL, (f2ord(f1[ca] + f2[cb]) & ~255) | (255 - (ca * 16 + cb)));
    float rs;
    { const f32x4* sp = (const f32x4*)(WSP(float, WS_SSQ1) + (size_t)t * 32 + 16 * hi); const f32x4 s0 = sp[0], s1 = sp[1], s2 = sp[2], s3 = sp[3];
      float ss = ((s0[0] + s0[1]) + (s0[2] + s0[3])) + ((s1[0] + s1[1]) + (s1[2] + s1[3])) + ((s2[0] + s2[1]) + (s2[2] + s2[3])) + ((s3[0] + s3[1]) + (s3[2] + s3[3]));
      ss += __shfl_xor(ss, 32); rs = __builtin_amdgcn_rsqf(ss * (1.0f / DM) + EPS); if (head == 0 && hi == 0) WSP(float, WS_RS1)[t] = rs; }
    float ev[16], sm = 0.f; const float mx = ord2f(CL[0] & ~255);
#pragma unroll
    for (int i = 0; i < 16; ++i) { ev[i] = __expf((ord2f(CL[i] & ~255) - mx) * rs); sm += ev[i]; }
    const float inv = 1.0f / sm;
    LDS_WAIT();
    int eo[8]; float go[8];
#pragma unroll
    for (int i = 0; i < 8; ++i) { const int ck = hi ? CL[8 + i] : CL[i]; const int ab = 255 - (ck & 255); eo[i] = IDX[ab >> 4] * PNK + IDX[16 + (ab & 15)]; go[i] = (hi ? ev[8 + i] : ev[i]) * inv; }
    int* ep = WSP(int, WS_EIDX) + (size_t)t * 128 + head * 16 + 8 * hi; float* gp = WSP(float, WS_GATE) + (size_t)t * 128 + head * 16 + 8 * hi;
    *(u32x4*)ep = (u32x4){(unsigned)eo[0], (unsigned)eo[1], (unsigned)eo[2], (unsigned)eo[3]}; *(u32x4*)(ep + 4) = (u32x4){(unsigned)eo[4], (unsigned)eo[5], (unsigned)eo[6], (unsigned)eo[7]};
    *(f32x4*)gp = (f32x4){go[0], go[1], go[2], go[3]}; *(f32x4*)(gp + 4) = (f32x4){go[4], go[5], go[6], go[7]};
    LDS_WAIT();
}

__device__ __forceinline__ void fp8_row(const float* src, unsigned char* dst, float* scale, int row, int lane) {
    const float* xr = src + (size_t)row * DM + 16 * lane; f32x4 v[8]; float am = 0.f;
#pragma unroll
    for (int j = 0; j < 2; ++j)
#pragma unroll
        for (int i = 0; i < 4; ++i) { v[4 * j + i] = *(const f32x4*)(xr + 1024 * j + 4 * i); am = fmaxf(am, fmaxf(fmaxf(fabsf(v[4 * j + i][0]), fabsf(v[4 * j + i][1])), fmaxf(fabsf(v[4 * j + i][2]), fabsf(v[4 * j + i][3])))); }
#pragma unroll
    for (int o = 1; o < 64; o <<= 1) am = fmaxf(am, __shfl_xor(am, o));
    const float sc = am > 0.f ? am * (1.0f / 240.0f) : 1.0f, inv = am > 0.f ? 240.0f / am : 1.0f;
    if (lane == 0) scale[row] = sc;
#pragma unroll
    for (int j = 0; j < 2; ++j) { u32x4 w;
#pragma unroll
        for (int i = 0; i < 4; ++i) { const f32x4 y = v[4 * j + i] * inv; int p = 0; p = __builtin_amdgcn_cvt_pk_fp8_f32(y[0], y[1], p, false); p = __builtin_amdgcn_cvt_pk_fp8_f32(y[2], y[3], p, true); w[i] = (unsigned)p; }
        *(u32x4*)(dst + (size_t)row * DM + 1024 * j + 16 * lane) = w; }
}
__device__ __forceinline__ float gelu_erf(float z) { return 0.5f * z * (1.0f + erff(z * 0.70710678118654752f)); }
__device__ __forceinline__ void cvt16(const u32x4 w, f32x2 (&o)[8]) {
#pragma unroll
    for (int i = 0; i < 4; ++i) { o[2 * i] = __builtin_amdgcn_cvt_pk_f32_fp8((int)w[i], false); o[2 * i + 1] = __builtin_amdgcn_cvt_pk_f32_fp8((int)w[i], true); }
}
__device__ __forceinline__ void peer_z_wave(const Ctx& C, int s, int t0, int tstep) {
    if (t0 >= T) return;
    const int lane = C.lane, g = lane >> 4, c = lane & 15, col0 = 256 * s + 16 * c;
    const unsigned char* U = WSP(unsigned char, WS_U8); const int* EI = WSP(int, WS_EIDX) + lane; const float* RS = WSP(float, WS_RS1); const float* gnp = IP(14) + col0;
    u32x4 uwA[8], uwB[8]; f32x4 xv[4]; f32x2 h[8]; int eC0, eC1, eN0 = 0, eN1 = 0;
#define PZ_ROWS(UW, EB_, Q_) do { _Pragma("unroll") for (int i = 0; i < 8; ++i) { const int e = __shfl((EB_), 32 * ((Q_) & 1) + 4 * i + g); UW[i] = *(const u32x4*)(U + ((unsigned)e * (unsigned)DM + (unsigned)col0)); } } while (0)
#define PZ_X(T_) do { _Pragma("unroll") for (int i = 0; i < 4; ++i) xv[i] = *(const f32x4*)(C.out + (size_t)(T_) * DM + col0 + 4 * i); } while (0)
#define PZ_DOTS(UW, ZK, Q_) do { _Pragma("unroll") for (int i = 0; i < 8; ++i) { f32x2 uf[8]; cvt16(UW[i], uf); f32x2 a = uf[0] * h[0]; \
            _Pragma("unroll") for (int k = 1; k < 8; ++k) a += uf[k] * h[k]; \
            float d = a.x + a.y; d += __shfl_xor(d, 1); d += __shfl_xor(d, 2); d += __shfl_xor(d, 4); d += __shfl_xor(d, 8); ZK = (c == i + 8 * ((Q_) & 1)) ? d : ZK; } } while (0)
    eC0 = EI[(size_t)t0 * 128]; eC1 = EI[(size_t)t0 * 128 + 64];
    PZ_ROWS(uwA, eC0, 0); PZ_X(t0);
    for (int t = t0; t < T; t += tstep) {
        const int tn = t + tstep; const bool more = tn < T;
        if (more) { eN0 = EI[(size_t)tn * 128]; eN1 = EI[(size_t)tn * 128 + 64]; }
        PZ_ROWS(uwB, eC0, 1);
        { const float rs = RS[t];
#pragma unroll
          for (int i = 0; i < 4; ++i) { const f32x4 y = xv[i] * rs * *(const f32x4*)(gnp + 4 * i); h[2 * i] = (f32x2){y[0], y[1]}; h[2 * i + 1] = (f32x2){y[2], y[3]}; } }
        float zk0 = 0.f, zk1 = 0.f;
        PZ_DOTS(uwA, zk0, 0);
        PZ_ROWS(uwA, eC1, 0);
        PZ_DOTS(uwB, zk0, 1);
        PZ_ROWS(uwB, eC1, 1);
        PZ_DOTS(uwA, zk1, 0);
        if (more) { PZ_ROWS(uwA, eN0, 0); PZ_X(tn); }
        PZ_DOTS(uwB, zk1, 1);
        float* zp = WSP(float, WS_ZP) + ((size_t)t * 8 + s) * 128; zp[4 * c + g] = zk0; zp[64 + 4 * c + g] = zk1;
        eC0 = eN0; eC1 = eN1;
    }
#undef PZ_ROWS
#undef PZ_X
#undef PZ_DOTS
}
__device__ __forceinline__ void peer_act(const Ctx& C) {
    const float* zp = WSP(float, WS_ZP); const int* EI = WSP(int, WS_EIDX); const float* GT = WSP(float, WS_GATE); float* A = WSP(float, WS_PA);
    for (int i = C.bid * 512 + C.tid; i < T * 128; i += C.G * 512) { const int t = i >> 7, e = i & 127; float z = 0.f;
#pragma unroll
        for (int q = 0; q < 8; ++q) z += zp[((size_t)t * 8 + q) * 128 + e];
        const int ex = EI[i]; A[i] = gelu_erf(z * WSP(float, WS_SU)[ex]) * GT[i] * WSP(float, WS_SV)[ex]; }
}
__device__ __forceinline__ void peer_out_wave(const Ctx& C, int s, int t0, int tstep) {
    if (t0 >= T) return;
    const int lane = C.lane, g = lane >> 4, c = lane & 15, col0 = 256 * s + 16 * c;
    const unsigned char* V = WSP(unsigned char, WS_V8); const int* EI = WSP(int, WS_EIDX) + lane; const float* PA = WSP(float, WS_PA) + lane;
    const f32x4 gp = *(const f32x4*)(IP(20) + col0 + 4 * g);
    u32x4 vwA[8], vwB[8]; int eC0, eC1, eN0 = 0, eN1 = 0; float aC0, aC1, aN0 = 0.f, aN1 = 0.f;
#define PO_ROWS(VW, EB_, Q_) do { _Pragma("unroll") for (int i = 0; i < 8; ++i) { const int e = __shfl((EB_), 32 * ((Q_) & 1) + 4 * i + g); VW[i] = *(const u32x4*)(V + ((unsigned)e * (unsigned)DM + (unsigned)col0)); } } while (0)
#define PO_ACC(VW, AB_, Q_) do { _Pragma("unroll") for (int i = 0; i < 8; ++i) { const float av = __shfl((AB_), 32 * ((Q_) & 1) + 4 * i + g); f32x2 vf[8]; cvt16(VW[i], vf); \
            _Pragma("unroll") for (int k = 0; k < 8; ++k) acc[k] += vf[k] * av; } } while (0)
    eC0 = EI[(size_t)t0 * 128]; eC1 = EI[(size_t)t0 * 128 + 64]; aC0 = PA[(size_t)t0 * 128]; aC1 = PA[(size_t)t0 * 128 + 64];
    PO_ROWS(vwA, eC0, 0);
    for (int t = t0; t < T; t += tstep) {
        const int tn = t + tstep; const bool more = tn < T;
        if (more) { eN0 = EI[(size_t)tn * 128]; eN1 = EI[(size_t)tn * 128 + 64]; aN0 = PA[(size_t)tn * 128]; aN1 = PA[(size_t)tn * 128 + 64]; }
        PO_ROWS(vwB, eC0, 1);
        const size_t o = (size_t)t * DM + col0 + 4 * g; const f32x4 x1 = *(const f32x4*)(C.out + o);
        f32x2 acc[8];
#pragma unroll
        for (int k = 0; k < 8; ++k) acc[k] = (f32x2){0.f, 0.f};
        PO_ACC(vwA, aC0, 0);
        PO_ROWS(vwA, eC1, 0);
        PO_ACC(vwB, aC0, 1);
        PO_ROWS(vwB, eC1, 1);
        PO_ACC(vwA, aC1, 0);
        if (more) PO_ROWS(vwA, eN0, 0);
        PO_ACC(vwB, aC1, 1);
#pragma unroll
        for (int k = 0; k < 8; ++k) { acc[k].x += __shfl_xor(acc[k].x, 16); acc[k].y += __shfl_xor(acc[k].y, 16); acc[k].x += __shfl_xor(acc[k].x, 32); acc[k].y += __shfl_xor(acc[k].y, 32); }
        const f32x2 p0 = g == 0 ? acc[0] : g == 1 ? acc[2] : g == 2 ? acc[4] : acc[6], p1 = g == 0 ? acc[1] : g == 1 ? acc[3] : g == 2 ? acc[5] : acc[7];
        const f32x4 x2 = x1 + (f32x4){p0.x, p0.y, p1.x, p1.y};
        *(f32x4*)(WSP(float, WS_X2) + o) = x2;
        const f32x4 y = x2 * gp; u32x2 w; w.x = cvt_pk_bf16(y[0], y[1]); w.y = cvt_pk_bf16(y[2], y[3]); *(u32x2*)(WSP(bf16_t, WS_ACTA) + o) = w;
        const float s2 = wave_sum(sumsq4(x2)); if (lane == 0) WSP(float, WS_SSQ2)[(size_t)t * 8 + s] = s2;
        eC0 = eN0; eC1 = eN1; aC0 = aN0; aC1 = aN1;
    }
#undef PO_ROWS
#undef PO_ACC
}
__device__ __forceinline__ void final_row(const Ctx& C, int t) {
    const int lane = C.lane; float pz = lane < 32 ? WSP(float, WS_SSQ3)[(size_t)t * 32 + lane] : 0.f;
    const float rs = __builtin_amdgcn_rsqf(wave_sum(pz) * (1.0f / DM) + EPS);
    f32x4* xr = (f32x4*)(C.out + (size_t)t * DM) + lane; const f32x4* gr = (const f32x4*)IP(23) + lane;
#pragma unroll
    for (int j = 0; j < 8; ++j) xr[64 * j] = xr[64 * j] * rs * gr[64 * j];
}

constexpr int NPHASE = 12;
#ifndef MK_ONE_LAUNCH
#define MK_ONE_LAUNCH 1
#endif
constexpr int LDS_BYTES = 147456;
constexpr int MISC_OFF = 131072 + 320;
struct Args { const void* in[24]; float* out; unsigned char* ws; int ph_lo, ph_hi; };
#define GEMM_ALIGN true
#define GEMM_SP2 true

__global__ void __launch_bounds__(512, 2) mk_fwd(Args args) {
    extern __shared__ __attribute__((aligned(16))) unsigned char lds_raw[];
    Ctx C;
    C.lds = (LAS unsigned char*)lds_raw; C.tid = threadIdx.x; C.lane = C.tid & 63; C.wave = __builtin_amdgcn_readfirstlane(C.tid >> 6); C.G = gridDim.x; C.bid = blockIdx.x;
    C.out = (float*)karg_ptr(24); C.ws = (unsigned char*)karg_ptr(25);
    volatile LAS unsigned* MISC = (volatile LAS unsigned*)(C.lds + MISC_OFF);
    if (C.tid < 32) MISC[C.tid] = 0u;
    __syncthreads();
    const int lo = ((const int __attribute__((address_space(4)))*)__builtin_amdgcn_kernarg_segment_ptr())[52], hi = ((const int __attribute__((address_space(4)))*)__builtin_amdgcn_kernarg_segment_ptr())[53];
    const bool multi = (hi - lo) > 1;
    XcdBarrier bar; bar.bar = (unsigned*)(C.ws + WS_CTL) + 1024; bar.x = 0; bar.st = nullptr;
    if (multi) bar = xcd_barrier_post((unsigned*)(C.ws + WS_CTL) + 1024, MISC + 8);
    LAS unsigned char* L = C.lds;
    const int gw = C.bid * 8 + C.wave, NGW = C.G * 8;

    if (lo <= 0 && 0 < hi) {
 phase_prep(C);
    }
    if (lo <= 0 && 1 < hi) xcd_barrier(bar);
    if (lo <= 1 && 1 < hi) {
        pg8::Gemm g{WSP(bf16_t, WS_ACTA), WSP(bf16_t, WS_WINT), T, INW_PAD, DM}; pg8::StaticOrder S; S.init(T, INW_PAD, C.G, C.bid);
        pg8::EpiProj E{WSP(bf16_t, WS_HQ), WSP(bf16_t, WS_HV), WSP(bf16_t, WS_HOG), WSP(bf16_t, WS_MQG), WSP(bf16_t, WS_MKVG), WSP(bf16_t, WS_GA), WSP(bf16_t, WS_GB), WSP(bf16_t, WS_K),
                       WSP(float, WS_F), WSP(float, WS_SSQQ), WSP(float, WS_SSQKV), WSP(float, WS_LB), IP(7), IP(8), WSP(pg8::f32x2, WS_CS)};
        pg8::gemm_phase<pg8::EpiProj, pg8::StaticOrder, GEMM_ALIGN, GEMM_SP2>(L, g, S, E);

    }
    if (lo <= 1 && 2 < hi) xcd_barrier(bar);
    if (lo <= 2 && 2 < hi) {
        { pg8::Gemm g{WSP(bf16_t, WS_MQG), WSP(bf16_t, WS_WUQT), T, MH * MQK, MQL}; pg8::StaticOrder S; S.init(T, MH * MQK, C.G, C.bid);
          pg8::EpiQ E{WSP(bf16_t, WS_Q), WSP(float, WS_SSQQ), WSP(pg8::f32x2, WS_CS)};
          pg8::gemm_phase<pg8::EpiQ, pg8::StaticOrder, GEMM_ALIGN, GEMM_SP2>(L, g, S, E); }
        { pg8::Gemm g{WSP(bf16_t, WS_MKVG), WSP(bf16_t, WS_WUKVT), T, 2048, MKVL}; pg8::StaticOrder S; S.init(T, 2048, C.G, C.bid);
          pg8::EpiKV E{WSP(bf16_t, WS_K), WSP(bf16_t, WS_V), WSP(float, WS_SSQKV)};
          pg8::gemm_phase<pg8::EpiKV, pg8::StaticOrder, GEMM_ALIGN, GEMM_SP2>(L, g, S, E); }
        __syncthreads();
        for (int u = C.bid; u < HGH * HGNC; u += C.G) hgrn_a_unit(C, u >> 7, u & 127);

    }
    if (lo <= 2 && 3 < hi) xcd_barrier(bar);
    if (lo <= 3 && 3 < hi) {
        hgrn_scan(C);
        for (int pr = C.bid; pr < 256; pr += C.G) { const int h = pr >> 5, s = pr & 31; attn_unit(C, h, 63 - s); attn_unit(C, h, s); }

    }
    if (lo <= 3 && 4 < hi) xcd_barrier(bar);
    if (lo <= 4 && 4 < hi) {
        __syncthreads();
        for (int u = C.bid; u < HGH * HGNC; u += C.G) hgrn_c_unit(C, u >> 7, u & 127);
        __syncthreads();
        pg8::Gemm g{WSP(bf16_t, WS_OB), WSP(bf16_t, WS_WBT), T, DM, HGW}; pg8::StaticOrder S; S.init(T, DM, C.G, C.bid);
        pg8::EpiYb E{WSP(bf16_t, WS_GB), WSP(bf16_t, WS_YB)};
        pg8::gemm_phase<pg8::EpiYb, pg8::StaticOrder, GEMM_ALIGN, GEMM_SP2>(L, g, S, E);

    }
    if (lo <= 4 && 5 < hi) xcd_barrier(bar);
    if (lo <= 5 && 5 < hi) {
        for (int r = gw; r < 2 * PNK * PNK; r += NGW) { if (r < PNK * PNK) fp8_row(IP(18), WSP(unsigned char, WS_U8), WSP(float, WS_SU), r, C.lane); else fp8_row(IP(19), WSP(unsigned char, WS_V8), WSP(float, WS_SV), r - PNK * PNK, C.lane); }
        pg8::Gemm g{WSP(bf16_t, WS_OA), WSP(bf16_t, WS_WAT), T, DM, HGW}; pg8::StaticOrder S; S.init(T, DM, C.G, C.bid);
        pg8::EpiY E{WSP(bf16_t, WS_GA), WSP(bf16_t, WS_YB), WSP(bf16_t, WS_Y)};
        pg8::gemm_phase<pg8::EpiY, pg8::StaticOrder, GEMM_ALIGN, GEMM_SP2>(L, g, S, E);

    }
    if (lo <= 5 && 6 < hi) xcd_barrier(bar);
    if (lo <= 6 && 6 < hi) {
        pg8::Gemm g{WSP(bf16_t, WS_Y), WSP(bf16_t, WS_WOT), T, DM, DM}; pg8::StaticOrder S; S.init(T, DM, C.G, C.bid);
        pg8::EpiX1 E{IP(0), IP(14), C.out, WSP(float, WS_SSQ1), WSP(bf16_t, WS_ACTA)};
        pg8::gemm_phase<pg8::EpiX1, pg8::StaticOrder, GEMM_ALIGN, GEMM_SP2>(L, g, S, E);

    }
    if (lo <= 6 && 7 < hi) xcd_barrier(bar);
    if (lo <= 7 && 7 < hi) {
        { pg8::Gemm g{WSP(bf16_t, WS_ACTA), WSP(bf16_t, WS_WQT), T, DM, DM}; pg8::StaticOrder S; S.init(T, DM, C.G, C.bid);
          pg8::EpiPlain E{WSP(bf16_t, WS_QP), DM};
          pg8::gemm_phase<pg8::EpiPlain, pg8::StaticOrder, GEMM_ALIGN, GEMM_SP2>(L, g, S, E); }
        { pg8::Gemm g{WSP(bf16_t, WS_PBF), WSP(bf16_t, WS_WPET), T, DM, PLE}; pg8::StaticOrder S; S.init(T, DM, C.G, C.bid);
          pg8::EpiPlain E{WSP(bf16_t, WS_PE), DM};
          pg8::gemm_phase<pg8::EpiPlain, pg8::StaticOrder, GEMM_ALIGN, GEMM_SP2>(L, g, S, E); }

    }
    if (lo <= 7 && 8 < hi) xcd_barrier(bar);
    if (lo <= 8 && 8 < hi) {
        __syncthreads();
        topk_stage_keys(C);
        for (int wu = gw; wu < (T / 32) * PH; wu += NGW) topk_wave(C, wu >> 3, wu & 7);
        __syncthreads();

    }
    if (lo <= 8 && 9 < hi) xcd_barrier(bar);
    if (lo <= 9 && 9 < hi) {
        { const int sl = C.bid & 7, wsl = (C.bid >> 3) * 8 + C.wave, nws = (C.G >> 3) * 8;
          if (C.bid < (C.G & ~7)) peer_z_wave(C, sl, wsl, nws);
          xcd_barrier(bar);
          peer_act(C);
          xcd_barrier(bar);
          if (C.bid < (C.G & ~7)) peer_out_wave(C, sl, wsl, nws); }

    }
    if (lo <= 9 && 10 < hi) xcd_barrier(bar);
    if (lo <= 10 && 10 < hi) {
        pg8::Gemm g{WSP(bf16_t, WS_ACTA), WSP(bf16_t, WS_WPGT), T, DM, DM}; pg8::StaticOrder S; S.init(T, DM, C.G, C.bid);
        pg8::EpiPle E{WSP(bf16_t, WS_PE), WSP(float, WS_SSQ2), WSP(float, WS_X2), C.out, WSP(float, WS_SSQ3)};
        pg8::gemm_phase<pg8::EpiPle, pg8::StaticOrder, GEMM_ALIGN, GEMM_SP2>(L, g, S, E);

    }
    if (lo <= 10 && 11 < hi) xcd_barrier(bar);
    if (lo <= 11 && 11 < hi) {
 for (int t = gw; t < T; t += NGW) final_row(C, t);
    }
    if (lo <= 11 && 12 < hi) xcd_barrier(bar);
}

extern "C" void kernel_launch(void* const* d_in, const int* in_sizes, int n_in, void* d_out, int out_size, void* d_ws, size_t ws_size, hipStream_t stream) {
    static int grid = 0;
    if (grid == 0) {
        if (n_in != 24 || out_size != T * DM || ws_size < WS_END) { fprintf(stderr, "kernel_launch: unexpected shapes: n_in %d out %d ws %zu (need %zu)\n", n_in, out_size, ws_size, (size_t)WS_END); grid = -1; return; }
        int dev = 0, cus = 0;
        if (hipGetDevice(&dev) != hipSuccess || hipDeviceGetAttribute(&cus, hipDeviceAttributeMultiprocessorCount, dev) != hipSuccess) { grid = -1; return; }
        if (hipFuncSetAttribute((const void*)mk_fwd, hipFuncAttributeMaxDynamicSharedMemorySize, LDS_BYTES) != hipSuccess) { fprintf(stderr, "kernel_launch: hipFuncSetAttribute failed\n"); grid = -1; return; }
        (void)hipGetLastError();
        grid = cus;
    }
    if (grid < 0) return;
    (void)hipMemsetAsync((char*)d_ws + WS_CTL, 0, CTL_ZERO_BYTES, stream);
    Args a{};
    for (int i = 0; i < 24; ++i) a.in[i] = d_in[i];
    a.out = (float*)d_out; a.ws = (unsigned char*)d_ws;
#if MK_ONE_LAUNCH
    a.ph_lo = 0; a.ph_hi = NPHASE;
    hipLaunchKernelGGL(mk_fwd, dim3(grid), dim3(512), LDS_BYTES, stream, a);
#else
    for (int ph = 0; ph < NPHASE; ++ph) { a.ph_lo = ph; a.ph_hi = ph + 1; hipLaunchKernelGGL(mk_fwd, dim3(grid), dim3(512), LDS_BYTES, stream, a); }
#endif
}
```

```cpp
#include <hip/hip_runtime.h>
#include <cstdio>
#include <cstdint>

constexpr int T = 8192, DM = 2048, PLE = 256;
constexpr int HGH = 8, HGD = 128, HGW = 1024, HGC = 64, HGNC = T / HGC;
constexpr int MH = 8, MNOPE = 128, MROPE = 64, MV = 128, MQL = 512, MKVL = 512, MQK = 192;
constexpr int PH = 8, PNK = 128, PQD = 256, PK = 16;
constexpr int INW = 9280, INW_PAD = 9472;
constexpr float EPS = 1e-6f;

namespace pg8 {
#define PG8_LAS __attribute__((address_space(3)))
typedef unsigned short bf16_t;
typedef short bf16x8 __attribute__((ext_vector_type(8)));
typedef float f32x4 __attribute__((ext_vector_type(4)));
typedef unsigned u32x4 __attribute__((ext_vector_type(4)));
constexpr int BM = 256, BK = 64, HALF = 128, HTB = HALF * BK * 2  , STAGE_BYTES = 8 * HTB, NXCD = 8, WGM = 8;

__host__ __device__ __forceinline__ int lds_byte(int r, int c) { const int st = (r >> 4) * 2 + (c >> 5), rr = r & 15, cc = c & 31, ob = rr * 64 + cc * 2; return st * 1024 + (ob ^ (((ob >> 9) & 1) << 5)); }
__host__ __device__ __forceinline__ void stage_rc(int b, int& R, int& C) { const int st = b / 1024, sb = b % 1024, swz = sb ^ (((sb >> 9) & 1) << 5); R = (st >> 1) * 16 + swz / 64; C = (st & 1) * 32 + (swz % 64) / 2; }
__host__ __device__ __forceinline__ int perm32(int rho) { const int n = rho >> 4, i = rho & 15; return 8 * (i >> 2) + 4 * n + (i & 3); }

struct Unit { int pm, pn; };
struct Gemm { const bf16_t* A; const bf16_t* Bt; int M, N, K; };

struct StaticOrder {
    int nM, nN, nwg, G, c;
    __host__ __device__ void init(int M, int N, int G_, int c_) { nM = M / BM; nN = N / BM; nwg = nM * nN; G = G_; c = c_; }
    __host__ __device__ bool next(int i, Unit& u) const {
        const long L = (long)i * G + c; if (L >= nwg) return false;
        int wgid = (int)L; { const int q = nwg / NXCD, r = nwg % NXCD, xcd = wgid % NXCD, off = wgid / NXCD; wgid = (xcd < r ? xcd * (q + 1) : r * (q + 1) + (xcd - r) * q) + off; }
        const int nig = WGM * nN, gid = wgid / nig, fm = gid * WGM, gsz = (nM - fm) < WGM ? (nM - fm) : WGM;
        u.pm = fm + ((wgid % nig) % gsz); u.pn = (wgid % nig) / gsz; return true;
    }
    __device__ __forceinline__ void a_ready(const Unit&) const {}
    __device__ __forceinline__ void done(const Unit&) const {}
};


typedef float f32x2 __attribute__((ext_vector_type(2)));
typedef __bf16 bf16x2_t __attribute__((ext_vector_type(2)));
__device__ __forceinline__ unsigned cvt_pk_bf16(float lo, float hi) { const f32x2 v = {lo, hi}; const bf16x2_t b = __builtin_convertvector(v, bf16x2_t); return __builtin_bit_cast(unsigned, b); }
__device__ __forceinline__ u32x4 pack8(const f32x4 a, const f32x4 b) { u32x4 w; w.x = cvt_pk_bf16(a[0], a[1]); w.y = cvt_pk_bf16(a[2], a[3]); w.z = cvt_pk_bf16(b[0], b[1]); w.w = cvt_pk_bf16(b[2], b[3]); return w; }
__device__ __forceinline__ void unpack8(const u32x4 w, f32x4& a, f32x4& b) {
    a[0] = __uint_as_float(w.x << 16); a[1] = __uint_as_float(w.x & 0xffff0000u); a[2] = __uint_as_float(w.y << 16); a[3] = __uint_as_float(w.y & 0xffff0000u);
    b[0] = __uint_as_float(w.z << 16); b[1] = __uint_as_float(w.z & 0xffff0000u); b[2] = __uint_as_float(w.w << 16); b[3] = __uint_as_float(w.w & 0xffff0000u); }
__device__ __forceinline__ float sigm(float v) { return __builtin_amdgcn_rcpf(1.0f + __expf(-v)); }
__device__ __forceinline__ f32x4 sigm4(const f32x4 v) { return (f32x4){sigm(v[0]), sigm(v[1]), sigm(v[2]), sigm(v[3])}; }
__device__ __forceinline__ float sumsq4(const f32x4 v) { return (v[0] * v[0] + v[1] * v[1]) + (v[2] * v[2] + v[3] * v[3]); }

#define EPI_ROWS_BEGIN _Pragma("unroll") for (int ai = 0; ai < 2; ++ai) _Pragma("unroll") for (int m = 0; m < 4; ++m) { const int row = u.pm * BM + ai * HALF + wr * 64 + m * 16 + fr;
#define EPI_COLS_BEGIN _Pragma("unroll") for (int bj = 0; bj < 2; ++bj) { const int col = u.pn * BM + bj * HALF + wc * 32 + 8 * fq; const f32x4 v0 = acc[ai][bj][m][0], v1 = acc[ai][bj][m][1];
#define EPI_COLS_END }
#define EPI_ROWS_END }
typedef const f32x4 (&AccRef)[2][2][4][2];

struct EpiProj {
    static constexpr bool PERM = true, AFTER_DRAIN = false;
    bf16_t *HQ, *HV, *HOG, *MQG, *MKVG, *GA, *GB, *KB; float *F, *SSQQ, *SSQKV; const float *lb, *qn, *kvn; const f32x2* CS;
    __device__ __forceinline__ void operator()(AccRef acc, const Unit& u, int wr, int wc, int fr, int fq) const {
        const int seg = u.pn;
        EPI_ROWS_BEGIN
            float ss = 0.f;
            EPI_COLS_BEGIN
                if (seg < 4) { *(u32x4*)(HQ + (size_t)row * 1024 + col) = pack8(v0, v1); }
                else if (seg < 8) { const int c = col - 1024; const f32x4 l0 = *(const f32x4*)(lb + c), l1 = *(const f32x4*)(lb + c + 4);
                    const f32x4 f0 = l0 + (1.0f - l0) * sigm4(v0), f1 = l1 + (1.0f - l1) * sigm4(v1);
                    *(f32x4*)(F + (size_t)row * 1024 + c) = f0; *(f32x4*)(F + (size_t)row * 1024 + c + 4) = f1; }
                else if (seg < 12) { *(u32x4*)(HV + (size_t)row * 1024 + (col - 2048)) = pack8(v0, v1); }
                else if (seg < 16) { *(u32x4*)(HOG + (size_t)row * 1024 + (col - 3072)) = pack8(v0 * sigm4(v0), v1 * sigm4(v1)); }
                else if (seg < 18) { const int c = col - 4096; ss += sumsq4(v0) + sumsq4(v1);
                    *(u32x4*)(MQG + (size_t)row * 512 + c) = pack8(v0 * *(const f32x4*)(qn + c), v1 * *(const f32x4*)(qn + c + 4)); }
                else if (seg < 20) { const int c = col - 4608; ss += sumsq4(v0) + sumsq4(v1);
                    *(u32x4*)(MKVG + (size_t)row * 512 + c) = pack8(v0 * *(const f32x4*)(kvn + c), v1 * *(const f32x4*)(kvn + c + 4)); }
                else if (seg < 28) { *(u32x4*)(GA + (size_t)row * 2048 + (col - 5120)) = pack8(sigm4(v0), sigm4(v1)); }
                else if (seg < 36) { *(u32x4*)(GB + (size_t)row * 2048 + (col - 7168)) = pack8(sigm4(v0), sigm4(v1)); }
                else { const int c = col - 9216;
                    if (c < 64) { const f32x2* cs = CS + (size_t)row * 32 + (c >> 1); const f32x2 c0 = cs[0], c1 = cs[1], c2 = cs[2], c3 = cs[3];
                        f32x4 o0, o1; o0[0] = v0[0] * c0.x - v0[1] * c0.y; o0[1] = v0[1] * c0.x + v0[0] * c0.y; o0[2] = v0[2] * c1.x - v0[3] * c1.y; o0[3] = v0[3] * c1.x + v0[2] * c1.y;
                        o1[0] = v1[0] * c2.x - v1[1] * c2.y; o1[1] = v1[1] * c2.x + v1[0] * c2.y; o1[2] = v1[2] * c3.x - v1[3] * c3.y; o1[3] = v1[3] * c3.x + v1[2] * c3.y;
                        const u32x4 w = pack8(o0, o1);
#pragma unroll
                        for (int h = 0; h < MH; ++h) *(u32x4*)(KB + ((size_t)h * T + row) * MQK + MNOPE + c) = w; } }
            EPI_COLS_END
            if (seg >= 16 && seg < 20) { ss += __shfl_xor(ss, 16); ss += __shfl_xor(ss, 32);
                if (fq == 0) { float* S = seg < 18 ? SSQQ : SSQKV; S[(size_t)row * 8 + (seg & 1) * 4 + wc] = ss; } }
        EPI_ROWS_END
    }
};
constexpr float QSCALE = 0.07216878364870323f * 1.4426950408889634f;
struct EpiQ {
    static constexpr bool PERM = true, AFTER_DRAIN = false;
    bf16_t* Q; const float* SSQQ; const f32x2* CS;
    __device__ __forceinline__ void operator()(AccRef acc, const Unit& u, int wr, int wc, int fr, int fq) const {
        EPI_ROWS_BEGIN
            const f32x4 s0 = *(const f32x4*)(SSQQ + (size_t)row * 8), s1 = *(const f32x4*)(SSQQ + (size_t)row * 8 + 4);
            const float rs = __builtin_amdgcn_rsqf(((s0[0] + s0[1]) + (s0[2] + s0[3]) + (s1[0] + s1[1]) + (s1[2] + s1[3])) * (1.0f / MQL) + EPS) * QSCALE;
            EPI_COLS_BEGIN
                const int head = col / MQK, d = col - head * MQK; f32x4 a = v0 * rs, b = v1 * rs;
                if (d >= MNOPE) { const f32x2* cs = CS + (size_t)row * 32 + ((d - MNOPE) >> 1); const f32x2 c0 = cs[0], c1 = cs[1], c2 = cs[2], c3 = cs[3];
                    f32x4 o0, o1; o0[0] = a[0] * c0.x - a[1] * c0.y; o0[1] = a[1] * c0.x + a[0] * c0.y; o0[2] = a[2] * c1.x - a[3] * c1.y; o0[3] = a[3] * c1.x + a[2] * c1.y;
                    o1[0] = b[0] * c2.x - b[1] * c2.y; o1[1] = b[1] * c2.x + b[0] * c2.y; o1[2] = b[2] * c3.x - b[3] * c3.y; o1[3] = b[3] * c3.x + b[2] * c3.y; a = o0; b = o1; }
                *(u32x4*)(Q + ((size_t)head * T + row) * MQK + d) = pack8(a, b);
            EPI_COLS_END
        EPI_ROWS_END
    }
};
struct EpiKV {
    static constexpr bool PERM = true, AFTER_DRAIN = false;
    bf16_t *K, *V; const float* SSQKV;
    __device__ __forceinline__ void operator()(AccRef acc, const Unit& u, int wr, int wc, int fr, int fq) const {
        EPI_ROWS_BEGIN
            const f32x4 s0 = *(const f32x4*)(SSQKV + (size_t)row * 8), s1 = *(const f32x4*)(SSQKV + (size_t)row * 8 + 4);
            const float rs = __builtin_amdgcn_rsqf(((s0[0] + s0[1]) + (s0[2] + s0[3]) + (s1[0] + s1[1]) + (s1[2] + s1[3])) * (1.0f / MKVL) + EPS);
            EPI_COLS_BEGIN
                const int head = col >> 8, d = col & 255; const u32x4 w = pack8(v0 * rs, v1 * rs);
                if (d < MNOPE) *(u32x4*)(K + ((size_t)head * T + row) * MQK + d) = w; else *(u32x4*)(V + ((size_t)head * T + row) * MV + (d - MNOPE)) = w;
            EPI_COLS_END
        EPI_ROWS_END
    }
};
struct EpiPlain {
    static constexpr bool PERM = true, AFTER_DRAIN = false;
    bf16_t* O; int ldc;
    __device__ __forceinline__ void operator()(AccRef acc, const Unit& u, int wr, int wc, int fr, int fq) const {
        EPI_ROWS_BEGIN EPI_COLS_BEGIN *(u32x4*)(O + (size_t)row * ldc + col) = pack8(v0, v1); EPI_COLS_END EPI_ROWS_END
    }
};
struct EpiYb {
    static constexpr bool PERM = true, AFTER_DRAIN = false;
    const bf16_t* GB; bf16_t* YB;
    __device__ __forceinline__ void operator()(AccRef acc, const Unit& u, int wr, int wc, int fr, int fq) const {
        EPI_ROWS_BEGIN EPI_COLS_BEGIN f32x4 g0, g1; unpack8(*(const u32x4*)(GB + (size_t)row * DM + col), g0, g1); *(u32x4*)(YB + (size_t)row * DM + col) = pack8(v0 * g0, v1 * g1); EPI_COLS_END EPI_ROWS_END
    }
};
struct EpiY {
    static constexpr bool PERM = true, AFTER_DRAIN = false;
    const bf16_t *GA, *YB; bf16_t* Y;
    __device__ __forceinline__ void operator()(AccRef acc, const Unit& u, int wr, int wc, int fr, int fq) const {
        EPI_ROWS_BEGIN EPI_COLS_BEGIN f32x4 g0, g1, y0, y1; unpack8(*(const u32x4*)(GA + (size_t)row * DM + col), g0, g1); unpack8(*(const u32x4*)(YB + (size_t)row * DM + col), y0, y1);
            *(u32x4*)(Y + (size_t)row * DM + col) = pack8(v0 * g0 + y0, v1 * g1 + y1); EPI_COLS_END EPI_ROWS_END
    }
};
struct EpiX1 {
    static constexpr bool PERM = true, AFTER_DRAIN = false;
    const float *X, *gain; float *OUT, *SSQ; bf16_t* XG;
    __device__ __forceinline__ void operator()(AccRef acc, const Unit& u, int wr, int wc, int fr, int fq) const {
        EPI_ROWS_BEGIN
            float ss = 0.f;
            EPI_COLS_BEGIN
                const size_t o = (size_t)row * DM + col; const f32x4 a = *(const f32x4*)(X + o) + v0, b = *(const f32x4*)(X + o + 4) + v1;
                *(f32x4*)(OUT + o) = a; *(f32x4*)(OUT + o + 4) = b; ss += sumsq4(a) + sumsq4(b);
                *(u32x4*)(XG + o) = pack8(a * *(const f32x4*)(gain + col), b * *(const f32x4*)(gain + col + 4));
            EPI_COLS_END
            ss += __shfl_xor(ss, 16); ss += __shfl_xor(ss, 32);
            if (fq == 0) SSQ[(size_t)row * 32 + u.pn * 4 + wc] = ss;
        EPI_ROWS_END
    }
};
struct EpiPle {
    static constexpr bool PERM = true, AFTER_DRAIN = false;
    const bf16_t* PE; const float *SSQ2, *X2; float *OUT, *SSQ;
    __device__ __forceinline__ void operator()(AccRef acc, const Unit& u, int wr, int wc, int fr, int fq) const {
        EPI_ROWS_BEGIN
            const f32x4 q0 = *(const f32x4*)(SSQ2 + (size_t)row * 8), q1 = *(const f32x4*)(SSQ2 + (size_t)row * 8 + 4);
            const float rs = __builtin_amdgcn_rsqf((((q0[0] + q0[1]) + (q0[2] + q0[3])) + ((q1[0] + q1[1]) + (q1[2] + q1[3]))) * (1.0f / DM) + EPS); float ss = 0.f;
            EPI_COLS_BEGIN
                const size_t o = (size_t)row * DM + col; f32x4 p0, p1; unpack8(*(const u32x4*)(PE + o), p0, p1);
                const f32x4 a = *(const f32x4*)(X2 + o) + sigm4(v0 * rs) * p0, b = *(const f32x4*)(X2 + o + 4) + sigm4(v1 * rs) * p1;
                *(f32x4*)(OUT + o) = a; *(f32x4*)(OUT + o + 4) = b; ss += sumsq4(a) + sumsq4(b);
            EPI_COLS_END
            ss += __shfl_xor(ss, 16); ss += __shfl_xor(ss, 32);
            if (fq == 0) SSQ[(size_t)row * 32 + u.pn * 4 + wc] = ss;
        EPI_ROWS_END
    }
};

template <class Epi, class Sched, bool ALIGN_EPI = false, bool SP2 = false>
__device__ __forceinline__ void gemm_phase(PG8_LAS unsigned char* lds, const Gemm g, const Sched& S, const Epi& E) {
    const int tid = threadIdx.x, wid = __builtin_amdgcn_readfirstlane(tid >> 6), lane = tid & 63, wr = wid >> 2, wc = wid & 3, fr = lane & 15, fq = lane >> 4;
    const int K = g.K, nt = K / BK;
    unsigned voffA[2], voffB[2];
#pragma unroll
    for (int i = 0; i < 2; ++i) { int R, C; stage_rc(tid * 16 + i * 8192, R, C); const int Rb = Epi::PERM ? ((R & ~31) + perm32(R & 31)) : R;
        voffA[i] = (unsigned)(R * K + C) * 2u; voffB[i] = (unsigned)(Rb * K + C) * 2u; }
    const size_t kstep = (size_t)(BK * 2);
    const size_t hstep = (size_t)HALF * K * 2;
    const size_t tstep = 2 * hstep;
    const unsigned ldsw = (unsigned)wid * 1024u;
    const int aoff = lds_byte(wr * 64 + fr, fq * 8), boff = lds_byte(wc * 32 + fr, fq * 8);
#define PG8_SA(b, h) (((b) * 2 + (h)) * HTB)
#define PG8_SB(b, h) ((4 + (b) * 2 + (h)) * HTB)
#define PG8_STAGE(bufoff, gbase, voff) do { _Pragma("unroll") for (int _i = 0; _i < 2; ++_i) \
        __builtin_amdgcn_global_load_lds((const unsigned*)((const char*)(gbase) + (voff)[_i]), (PG8_LAS unsigned*)(lds + (bufoff) + ldsw + _i * 8192), 16, 0, 0); } while (0)
#define PG8_LDA(dst, b, h) do { _Pragma("unroll") for (int m = 0; m < 4; ++m) _Pragma("unroll") for (int k = 0; k < 2; ++k) dst[m][k] = *(const PG8_LAS bf16x8*)(lds + PG8_SA(b, h) + aoff + m * 2048 + k * 1024); } while (0)
#define PG8_LDB(dst, b, h) do { _Pragma("unroll") for (int n = 0; n < 2; ++n) _Pragma("unroll") for (int k = 0; k < 2; ++k) dst[n][k] = *(const PG8_LAS bf16x8*)(lds + PG8_SB(b, h) + boff + n * 2048 + k * 1024); } while (0)
#define PG8_MMA(ai, bj, At, Bt) do { __builtin_amdgcn_s_setprio(1); _Pragma("unroll") for (int m = 0; m < 4; ++m) _Pragma("unroll") for (int n = 0; n < 2; ++n) _Pragma("unroll") for (int k = 0; k < 2; ++k) \
        acc[ai][bj][m][n] = __builtin_amdgcn_mfma_f32_16x16x32_bf16(Bt[n][k], At[m][k], acc[ai][bj][m][n], 0, 0, 0); __builtin_amdgcn_s_setprio(0); } while (0)
#define PG8_WAIT_V(n) asm volatile("s_waitcnt vmcnt(" #n ")" ::: "memory")
#define PG8_WAIT_L(n) asm volatile("s_waitcnt lgkmcnt(" #n ")" ::: "memory")
#define PG8_BAR __builtin_amdgcn_s_barrier()
#define PG8_SCHED __builtin_amdgcn_sched_barrier(0)
    Unit cur, nxt; int ui = 0;
    if (!S.next(0, cur)) return;
    f32x4 acc[2][2][4][2];
#pragma unroll
    for (int a = 0; a < 2; ++a)
#pragma unroll
        for (int b = 0; b < 2; ++b)
#pragma unroll
            for (int m = 0; m < 4; ++m)
#pragma unroll
                for (int n = 0; n < 2; ++n) acc[a][b][m][n] = (f32x4){0.f, 0.f, 0.f, 0.f};
    bf16x8 At[4][2], B0[2][2], B1[2][2];
    const char* cA = (const char*)g.A + (size_t)cur.pm * tstep; const char* cB = (const char*)g.Bt + (size_t)cur.pn * tstep;
    S.a_ready(cur);
    if constexpr (SP2) {
        PG8_STAGE(PG8_SB(0, 0), cB, voffB); PG8_STAGE(PG8_SB(0, 1), cB + hstep, voffB); PG8_STAGE(PG8_SA(0, 0), cA, voffA); PG8_STAGE(PG8_SA(0, 1), cA + hstep, voffA);
        if (wr == 1) PG8_BAR;
        PG8_WAIT_V(2); PG8_BAR;
        PG8_STAGE(PG8_SB(1, 0), cB + kstep, voffB); PG8_STAGE(PG8_SA(1, 0), cA + kstep, voffA); PG8_STAGE(PG8_SB(1, 1), cB + hstep + kstep, voffB);
        PG8_WAIT_V(6); PG8_BAR;
    } else {
        PG8_STAGE(PG8_SB(0, 0), cB, voffB); PG8_STAGE(PG8_SA(0, 0), cA, voffA); PG8_STAGE(PG8_SB(0, 1), cB + hstep, voffB); PG8_STAGE(PG8_SA(0, 1), cA + hstep, voffA);
        if (wr == 1) PG8_BAR;
        PG8_WAIT_V(4); PG8_BAR;
        PG8_STAGE(PG8_SB(1, 0), cB + kstep, voffB); PG8_STAGE(PG8_SA(1, 0), cA + kstep, voffA); PG8_STAGE(PG8_SB(1, 1), cB + hstep + kstep, voffB);
        PG8_WAIT_V(6); PG8_BAR;
    }
    for (;;) {
        const bool has_next = S.next(ui + 1, nxt);
        const char* nA = has_next ? (const char*)g.A + (size_t)nxt.pm * tstep : cA; const char* nB = has_next ? (const char*)g.Bt + (size_t)nxt.pn * tstep : cB;
        for (int t = 0; t < nt; t += 2) {
            const bool last = (t == nt - 2);
            const char* a1 = cA + (size_t)(t + 1) * kstep;
            const char* a2 = last ? nA : cA + (size_t)(t + 2) * kstep; const char* b2 = last ? nB : cB + (size_t)(t + 2) * kstep;
            const char* a3 = a2 + kstep; const char* b3 = b2 + kstep;
            if (last && has_next) S.a_ready(nxt);
            if constexpr (SP2) {
            PG8_LDB(B0, 0, 0); PG8_LDB(B1, 0, 1); PG8_SCHED; PG8_LDA(At, 0, 0); PG8_STAGE(PG8_SA(1, 1), a1 + hstep, voffA);
            PG8_WAIT_V(8); PG8_WAIT_L(0); PG8_BAR; PG8_MMA(0, 0, At, B0); PG8_MMA(0, 1, At, B1); PG8_BAR; PG8_SCHED;
            PG8_LDA(At, 0, 1); PG8_STAGE(PG8_SB(0, 0), b2, voffB); PG8_STAGE(PG8_SB(0, 1), b2 + hstep, voffB); PG8_STAGE(PG8_SA(0, 0), a2, voffA);
            PG8_WAIT_V(8); PG8_WAIT_L(0); PG8_BAR; PG8_MMA(1, 0, At, B0); PG8_MMA(1, 1, At, B1); PG8_BAR; PG8_SCHED;
            PG8_LDB(B0, 1, 0); PG8_LDB(B1, 1, 1); PG8_SCHED; PG8_LDA(At, 1, 0); PG8_STAGE(PG8_SA(0, 1), a2 + hstep, voffA);
            PG8_WAIT_V(8); PG8_WAIT_L(0); PG8_BAR; PG8_MMA(0, 0, At, B0); PG8_MMA(0, 1, At, B1); PG8_BAR; PG8_SCHED;
            PG8_LDA(At, 1, 1); PG8_STAGE(PG8_SB(1, 0), b3, voffB); PG8_STAGE(PG8_SB(1, 1), b3 + hstep, voffB); PG8_STAGE(PG8_SA(1, 0), a3, voffA);
            PG8_WAIT_V(8); PG8_WAIT_L(0); PG8_BAR; PG8_MMA(1, 0, At, B0); PG8_MMA(1, 1, At, B1); PG8_BAR; PG8_SCHED;
            } else {
            PG8_LDB(B0, 0, 0); PG8_SCHED; PG8_LDA(At, 0, 0); PG8_STAGE(PG8_SA(1, 1), a1 + hstep, voffA);
            PG8_WAIT_L(8); PG8_BAR; PG8_WAIT_L(0); PG8_MMA(0, 0, At, B0); PG8_BAR; PG8_SCHED;
            PG8_LDB(B1, 0, 1); PG8_STAGE(PG8_SB(0, 0), b2, voffB);
            PG8_BAR; PG8_WAIT_L(0); PG8_MMA(0, 1, At, B1); PG8_BAR;
            PG8_LDA(At, 0, 1); PG8_STAGE(PG8_SA(0, 0), a2, voffA);
            PG8_BAR; PG8_WAIT_L(0); PG8_MMA(1, 0, At, B0); PG8_BAR; PG8_SCHED;
            PG8_STAGE(PG8_SB(0, 1), b2 + hstep, voffB);
            PG8_WAIT_V(6); PG8_BAR; PG8_MMA(1, 1, At, B1); PG8_BAR;
            PG8_LDB(B0, 1, 0); PG8_SCHED; PG8_LDA(At, 1, 0); PG8_STAGE(PG8_SA(0, 1), a2 + hstep, voffA);
            PG8_WAIT_L(8); PG8_BAR; PG8_WAIT_L(0); PG8_MMA(0, 0, At, B0); PG8_BAR; PG8_SCHED;
            PG8_LDB(B1, 1, 1); PG8_STAGE(PG8_SB(1, 0), b3, voffB);
            PG8_BAR; PG8_WAIT_L(0); PG8_MMA(0, 1, At, B1); PG8_BAR;
            PG8_LDA(At, 1, 1); PG8_STAGE(PG8_SA(1, 0), a3, voffA);
            PG8_BAR; PG8_WAIT_L(0); PG8_MMA(1, 0, At, B0); PG8_BAR; PG8_SCHED;
            PG8_STAGE(PG8_SB(1, 1), b3 + hstep, voffB);
            PG8_WAIT_V(6); PG8_BAR; PG8_MMA(1, 1, At, B1); PG8_BAR;
            }
        }
        if constexpr (ALIGN_EPI) { if (wr == 0) PG8_BAR; }
        if constexpr (!Epi::AFTER_DRAIN) { E(acc, cur, wr, wc, fr, fq); S.done(cur); }
        if (!has_next) break;
#pragma unroll
        for (int a = 0; a < 2; ++a)
#pragma unroll
            for (int b = 0; b < 2; ++b)
#pragma unroll
                for (int m = 0; m < 4; ++m)
#pragma unroll
                    for (int n = 0; n < 2; ++n) acc[a][b][m][n] = (f32x4){0.f, 0.f, 0.f, 0.f};
        cur = nxt; cA = nA; cB = nB; ++ui;
        if constexpr (ALIGN_EPI) { if (wr == 1) PG8_BAR; }
    }
    PG8_WAIT_V(0);
    if constexpr (!ALIGN_EPI) { if (wr == 0) PG8_BAR; }
    PG8_BAR;
    if constexpr (Epi::AFTER_DRAIN) { E.fused(acc, cur, wr, wc, fr, fq, lds, wid, lane); S.done(cur); }
#undef PG8_SA
#undef PG8_SB
#undef PG8_STAGE
#undef PG8_LDA
#undef PG8_LDB
#undef PG8_MMA
#undef PG8_WAIT_V
#undef PG8_WAIT_L
#undef PG8_BAR
#undef PG8_SCHED
}
}

#define LAS __attribute__((address_space(3)))
typedef unsigned short bf16_t;
typedef short bf16x8 __attribute__((ext_vector_type(8)));
typedef short s16x4 __attribute__((ext_vector_type(4)));
typedef float f32x2 __attribute__((ext_vector_type(2)));
typedef float f32x4 __attribute__((ext_vector_type(4)));
typedef float f32x16 __attribute__((ext_vector_type(16)));
typedef unsigned u32x2 __attribute__((ext_vector_type(2)));
typedef unsigned u32x4 __attribute__((ext_vector_type(4)));
using pg8::cvt_pk_bf16; using pg8::pack8; using pg8::unpack8; using pg8::sumsq4; using pg8::sigm;
#define LDS_WAIT() asm volatile("s_waitcnt lgkmcnt(0)" ::: "memory")
__device__ __forceinline__ float bf2f(unsigned short b) { return __uint_as_float((unsigned)b << 16); }
__device__ __forceinline__ unsigned short f2bf(float f) { return (unsigned short)(cvt_pk_bf16(f, 0.f) & 0xffffu); }
__device__ __forceinline__ float wave_sum(float v) {
#pragma unroll
    for (int o = 1; o < 64; o <<= 1) v += __shfl_xor(v, o);
    return v;
}

constexpr size_t MiB = 1u << 20;
constexpr size_t WS_CTL = 0, CTL_ZERO_BYTES = 64 * 1024;
constexpr size_t WS_LB = 1 * MiB;
constexpr size_t WS_K1B = WS_LB + 64 * 1024;
constexpr size_t WS_K2B = WS_K1B + 64 * 1024;
constexpr size_t WS_SSQQ = 2 * MiB;
constexpr size_t WS_SSQKV = WS_SSQQ + 256 * 1024;
constexpr size_t WS_SSQ2 = WS_SSQKV + 256 * 1024;
constexpr size_t WS_SSQ1 = 3 * MiB;
constexpr size_t WS_SSQ3 = 4 * MiB;
constexpr size_t WS_DECAY = 5 * MiB;
constexpr size_t WS_CS = 6 * MiB;
constexpr size_t WS_EIDX = 8 * MiB;
constexpr size_t WS_GATE = 12 * MiB;
constexpr size_t WS_WUQT = 16 * MiB, WS_WUKVT = 18 * MiB, WS_WAT = 20 * MiB, WS_WBT = 24 * MiB, WS_WOT = 28 * MiB, WS_WQT = 36 * MiB, WS_WPGT = 44 * MiB, WS_WPET = 52 * MiB, WS_PBF = 53 * MiB;
constexpr size_t WS_WINT = 58 * MiB;
constexpr size_t WS_SPT = 58 * MiB;
constexpr size_t WS_ACTA = 96 * MiB;
constexpr size_t WS_GA = 128 * MiB, WS_GB = 160 * MiB;
constexpr size_t WS_QP = WS_GA, WS_PE = WS_GB;
constexpr size_t WS_HQ = 192 * MiB, WS_F = 208 * MiB, WS_HV = 240 * MiB, WS_HOG = 256 * MiB, WS_Q = 272 * MiB, WS_K = 296 * MiB, WS_V = 320 * MiB;
constexpr size_t WS_U8 = 192 * MiB, WS_V8 = 224 * MiB;
constexpr size_t WS_SU = 1 * MiB + 256 * 1024, WS_SV = WS_SU + 64 * 1024;
constexpr size_t WS_MQG = 336 * MiB, WS_MKVG = 344 * MiB, WS_OB = 336 * MiB;
constexpr size_t WS_DST = 352 * MiB;
constexpr size_t WS_OA = 416 * MiB, WS_YB = 432 * MiB, WS_Y = 464 * MiB, WS_END = 496 * MiB;
constexpr size_t WS_ZP = 256 * MiB;
constexpr size_t WS_PA = 288 * MiB;
constexpr size_t WS_RS1 = WS_SU + 128 * 1024;
constexpr size_t WS_X2 = 432 * MiB;

#define XB_TMO      128
#define XB_XCNT(j)  (256  + 64 * (j))
#define XB_XSUB(j)  (1280 + 64 * (j))
#define XB_XGEN(j)  (2304 + 64 * (j))
#define XB_TOP      3328
#define XB_TOPGEN   3392
#define XCD_BAR_WORDS 3456
#define XB_SPIN_CAP (1u << 18)

__device__ __forceinline__ unsigned xb_ld(unsigned* p)              { return __hip_atomic_load(p, __ATOMIC_RELAXED, __HIP_MEMORY_SCOPE_AGENT); }
__device__ __forceinline__ unsigned xb_add(unsigned* p, unsigned v) { return __hip_atomic_fetch_add(p, v, __ATOMIC_RELAXED, __HIP_MEMORY_SCOPE_AGENT); }
__device__ __forceinline__ unsigned xb_xcc_id() { return (unsigned)__builtin_amdgcn_s_getreg((3 << 11) | 20) & 0xFu; }
#define XB_SPIN(cond, bar) do { unsigned _sp = 0; while (cond) { __builtin_amdgcn_s_sleep(1); \
    if ((++_sp & 255u) == 0u) { if (xb_ld(&(bar)[XB_TMO])) break; if (_sp > XB_SPIN_CAP) { atomicAdd(&(bar)[XB_TMO], 1u); break; } } } } while (0)

struct XcdBarrier {
    unsigned* bar; unsigned x;
    volatile LAS unsigned* st;
};

__device__ __forceinline__ XcdBarrier xcd_barrier_post(unsigned* bar, volatile LAS unsigned* st) {
    XcdBarrier b; b.bar = bar; b.x = xb_xcc_id(); b.st = st;
    if (threadIdx.x == 0) (void)xb_add(&bar[XB_XCNT(b.x)], 1u);
    return b;
}
__device__ __forceinline__ void xcd_barrier_complete(unsigned* bar, unsigned x, unsigned& nloc, unsigned& nx) {
    const unsigned G = gridDim.x * gridDim.y * gridDim.z;
    unsigned sum, cnt, mine, sp = 0u;
    for (;;) {
        sum = 0u; cnt = 0u; mine = 0u;
#pragma unroll
        for (unsigned j = 0; j < 16; ++j) { const unsigned c = xb_ld(&bar[XB_XCNT(j)]); sum += c; cnt += (c > 0u) ? 1u : 0u; mine = (j == x) ? c : mine; }
        if (sum == G) break;
        __builtin_amdgcn_s_sleep(1);
        if ((++sp & 255u) == 0u) { if (xb_ld(&bar[XB_TMO])) break; if (sp > XB_SPIN_CAP) { atomicAdd(&bar[XB_TMO], 1u); break; } }
    }
    nloc = mine > 0u ? mine : 1u; nx = cnt > 0u ? cnt : 1u;
}

__device__ __forceinline__ void xcd_barrier(const XcdBarrier& b) {
    asm volatile("s_waitcnt vmcnt(0)" ::: "memory");
    __syncthreads();
    if (threadIdx.x == 0) {
        unsigned* bar = b.bar;
        __builtin_amdgcn_s_waitcnt(0);
        unsigned nloc = b.st[0], nx = b.st[1];
        if (nloc == 0u) { xcd_barrier_complete(bar, b.x, nloc, nx); b.st[0] = nloc; b.st[1] = nx; }
        const unsigned old = xb_add(&bar[XB_XSUB(b.x)], 1u);
        const unsigned gen = old / nloc;
        if (old + 1u == (gen + 1u) * nloc) {
            __builtin_amdgcn_fence(__ATOMIC_RELEASE, "agent");
            asm volatile("s_waitcnt vmcnt(0)" ::: "memory");
            const unsigned og = xb_add(&bar[XB_TOP], 1u);
            const unsigned tg = og / nx;
            if (og + 1u == (tg + 1u) * nx) xb_add(&bar[XB_TOPGEN], 1u);
            else XB_SPIN(xb_ld(&bar[XB_TOPGEN]) == tg, bar);
            __builtin_amdgcn_fence(__ATOMIC_ACQUIRE, "agent");
            xb_add(&bar[XB_XGEN(b.x)], 1u);
            asm volatile("s_waitcnt vmcnt(0)" ::: "memory");
        } else {
            XB_SPIN(xb_ld(&bar[XB_XGEN(b.x)]) == gen, bar);
            __builtin_amdgcn_fence(__ATOMIC_ACQUIRE, "agent");
            asm volatile("s_waitcnt vmcnt(0)" ::: "memory");
        }
    }
    __syncthreads();
}

struct Ctx { LAS unsigned char* lds; int tid, lane, wave, G, bid; float* out; unsigned char* ws; };
__device__ __forceinline__ const void* karg_ptr(int i) { return ((const void* const __attribute__((address_space(4)))*)__builtin_amdgcn_kernarg_segment_ptr())[i]; }
#define IP(i) ((const float*)karg_ptr(i))
#define WSP(type, off) ((type*)(C.ws + (off)))

__device__ __forceinline__ int ilv64(int i) { return i < 32 ? 2 * i : 2 * (i - 32) + 1; }
template <int MAP> __device__ __forceinline__ int colmap(int n) {
    if (MAP == 1) { if (n < 5120) return n; if (n < 5184) return 9216 + ilv64(n - 5120); return n - 64; }
    if (MAP == 2) { const int h = n / MQK, d = n - h * MQK; return d < MNOPE ? n : h * MQK + MNOPE + ilv64(d - MNOPE); }
    return n;
}
template <int MAP> __device__ __forceinline__ void p0_transpose_item(const float* W, int K, int N, bf16_t* WT, LAS float* scr, int item, int lane) {
    const int nblk = N / 32, kb = item / nblk, nb = item % nblk, k0 = 64 * kb, n0 = 32 * nb;
#pragma unroll 8
    for (int i = 0; i < 32; ++i) { const int kk = 2 * i + (lane >> 5); scr[kk * 33 + (lane & 31)] = W[(size_t)(k0 + kk) * N + n0 + (lane & 31)]; }
    LDS_WAIT(); asm volatile("" ::: "memory");
    const int c = lane & 7;
#pragma unroll
    for (int j = 0; j < 4; ++j) { const int n = (lane >> 3) + 8 * j; const LAS float* s = scr + (8 * c) * 33 + n;
        u32x4 o; o.x = cvt_pk_bf16(s[0 * 33], s[1 * 33]); o.y = cvt_pk_bf16(s[2 * 33], s[3 * 33]); o.z = cvt_pk_bf16(s[4 * 33], s[5 * 33]); o.w = cvt_pk_bf16(s[6 * 33], s[7 * 33]);
        *(u32x4*)(WT + (size_t)colmap<MAP>(n0 + n) * K + k0 + 8 * c) = o; }
    LDS_WAIT(); asm volatile("" ::: "memory");
}
__device__ __forceinline__ void rms_row_to_bf16(const float* xrow, const float* gain, bf16_t* orow, int lane) {
    const f32x4* xr = (const f32x4*)xrow + lane; const f32x4* gr = (const f32x4*)gain + lane;
    f32x4 v[8]; float s = 0.f;
#pragma unroll
    for (int j = 0; j < 8; ++j) { v[j] = xr[64 * j]; s += sumsq4(v[j]); }
    const float rs = __builtin_amdgcn_rsqf(wave_sum(s) * (1.0f / DM) + EPS);
    u32x2* o8 = (u32x2*)orow + lane;
#pragma unroll
    for (int j = 0; j < 8; ++j) { const f32x4 y = v[j] * rs * gr[64 * j]; u32x2 w; w.x = cvt_pk_bf16(y[0], y[1]); w.y = cvt_pk_bf16(y[2], y[3]); o8[64 * j] = w; }
}
__device__ __forceinline__ void cvt_copy(const float* src, bf16_t* dst, size_t n, size_t gtid, size_t nthr) {
    for (size_t i = gtid; i < n / 8; i += nthr) { const f32x4 a = ((const f32x4*)src)[2 * i], b = ((const f32x4*)src)[2 * i + 1]; ((u32x4*)dst)[i] = pack8(a, b); }
}

__device__ __forceinline__ void phase_prep(const Ctx& C) {
    LAS float* scr = (LAS float*)(C.lds + C.wave * 16384);
    const int gw = C.bid * 8 + C.wave, NGW = C.G * 8;
    constexpr int I_IN = (DM / 64) * (INW / 32), I_UQ = (MQL / 64) * (MH * MQK / 32), I_UKV = (MKVL / 64) * (2048 / 32), I_A = (HGW / 64) * (DM / 32), I_O = (DM / 64) * (DM / 32), I_PE = (PLE / 64) * (DM / 32);
    constexpr int NITEMS = I_IN + I_UQ + I_UKV + 2 * I_A + 3 * I_O + I_PE;
    for (int it = gw; it < NITEMS; it += NGW) {
        int r = it;
        if (r < I_IN) { p0_transpose_item<1>(IP(4), DM, INW, WSP(bf16_t, WS_WINT), scr, r, C.lane); continue; } r -= I_IN;
        if (r < I_UQ) { p0_transpose_item<2>(IP(9), MQL, MH * MQK, WSP(bf16_t, WS_WUQT), scr, r, C.lane); continue; } r -= I_UQ;
        if (r < I_UKV) { p0_transpose_item<0>(IP(10), MKVL, 2048, WSP(bf16_t, WS_WUKVT), scr, r, C.lane); continue; } r -= I_UKV;
        if (r < I_A) { p0_transpose_item<0>(IP(11), HGW, DM, WSP(bf16_t, WS_WAT), scr, r, C.lane); continue; } r -= I_A;
        if (r < I_A) { p0_transpose_item<0>(IP(12), HGW, DM, WSP(bf16_t, WS_WBT), scr, r, C.lane); continue; } r -= I_A;
        if (r < I_O) { p0_transpose_item<0>(IP(13), DM, DM, WSP(bf16_t, WS_WOT), scr, r, C.lane); continue; } r -= I_O;
        if (r < I_O) { p0_transpose_item<0>(IP(15), DM, DM, WSP(bf16_t, WS_WQT), scr, r, C.lane); continue; } r -= I_O;
        if (r < I_O) { p0_transpose_item<0>(IP(21), DM, DM, WSP(bf16_t, WS_WPGT), scr, r, C.lane); continue; } r -= I_O;
        p0_transpose_item<0>(IP(22), PLE, DM, WSP(bf16_t, WS_WPET), scr, r, C.lane);
    }
    for (int m = gw; m < T; m += NGW) rms_row_to_bf16(IP(0) + (size_t)m * DM, IP(3), WSP(bf16_t, WS_ACTA) + (size_t)m * DM, C.lane);
    const size_t gtid = (size_t)C.bid * 512 + C.tid, nthr = (size_t)C.G * 512;
    { u32x4* z = (u32x4*)(WSP(bf16_t, WS_WINT) + (size_t)INW * DM); for (size_t i = gtid; i < (size_t)(INW_PAD - INW) * DM / 8; i += nthr) z[i] = (u32x4){0u, 0u, 0u, 0u}; }
    cvt_copy(IP(1), WSP(bf16_t, WS_PBF), (size_t)T * PLE, gtid, nthr);
    cvt_copy(IP(16), WSP(bf16_t, WS_K1B), (size_t)PNK * 128, gtid, nthr);
    cvt_copy(IP(17), WSP(bf16_t, WS_K2B), (size_t)PNK * 128, gtid, nthr);
    for (size_t i = gtid; i < HGW; i += nthr) WSP(float, WS_LB)[i] = 1.0f / (1.0f + __expf(IP(5)[HGW + i] - IP(5)[i]));
    for (size_t e = gtid; e < (size_t)T * 32; e += nthr) { const int t = (int)(e >> 5), i = (int)(e & 31);
        double fr = 1.0; for (int k = 0; k < i; ++k) fr *= 0.74989420933245582;
        const float ang = (float)((const int*)karg_ptr(2))[t] * (float)fr; const double rev = (double)ang * 0.15915494309189535; const float fx = (float)(rev - floor(rev));
        WSP(f32x2, WS_CS)[e] = (f32x2){__builtin_amdgcn_cosf(fx), __builtin_amdgcn_sinf(fx)}; }
}

__device__ __forceinline__ void hgrn_cumsum(const Ctx& C, int h, int n, float (&fv)[16], float (&bb)[16], float& b_ref, float& b_last, LAS float* TOT) {
    const int d = C.tid & 127, rg = C.tid >> 7; const float* F = WSP(float, WS_F) + ((size_t)(n * HGC + rg * 16)) * HGW + h * HGD + d;
    float run = 0.f;
#pragma unroll
    for (int i = 0; i < 16; ++i) { fv[i] = F[(size_t)i * HGW]; run += __logf(fv[i]); bb[i] = run; }
    TOT[rg * 128 + d] = run; LDS_WAIT(); __syncthreads();
    const float t0 = TOT[d], t1 = TOT[128 + d], t2 = TOT[256 + d], t3 = TOT[384 + d];
    const float off = rg == 0 ? 0.f : rg == 1 ? t0 : rg == 2 ? t0 + t1 : (t0 + t1) + t2;
    b_ref = t0 + t1; b_last = ((t0 + t1) + t2) + t3;
#pragma unroll
    for (int i = 0; i < 16; ++i) bb[i] += off;
}
constexpr int HG_KDT = 0, HG_VT = 18432, HG_TOT = 36864;
__device__ __forceinline__ void hgrn_a_unit(const Ctx& C, int h, int n) {
    LAS bf16_t* KDT = (LAS bf16_t*)(C.lds + HG_KDT); LAS bf16_t* VT = (LAS bf16_t*)(C.lds + HG_VT); LAS float* TOT = (LAS float*)(C.lds + HG_TOT);
    const int d = C.tid & 127, rg = C.tid >> 7;
    float fv[16], bb[16], b_ref, b_last; hgrn_cumsum(C, h, n, fv, bb, b_ref, b_last, TOT);
    const bf16_t* HVp = WSP(bf16_t, WS_HV) + ((size_t)(n * HGC + rg * 16)) * HGW + h * HGD + d;
#pragma unroll
    for (int g = 0; g < 2; ++g) { float kd[8], vv[8];
#pragma unroll
        for (int i = 0; i < 8; ++i) { const int r = g * 8 + i; kd[i] = (1.0f - fv[r]) * __expf(b_last - bb[r]); vv[i] = bf2f(HVp[(size_t)r * HGW]); }
        u32x4 wk, wv; wk.x = cvt_pk_bf16(kd[0], kd[1]); wk.y = cvt_pk_bf16(kd[2], kd[3]); wk.z = cvt_pk_bf16(kd[4], kd[5]); wk.w = cvt_pk_bf16(kd[6], kd[7]);
        wv.x = cvt_pk_bf16(vv[0], vv[1]); wv.y = cvt_pk_bf16(vv[2], vv[3]); wv.z = cvt_pk_bf16(vv[4], vv[5]); wv.w = cvt_pk_bf16(vv[6], vv[7]);
        *(LAS u32x4*)(KDT + d * 72 + rg * 16 + g * 8) = wk; *(LAS u32x4*)(VT + d * 72 + rg * 16 + g * 8) = wv; }
    if (rg == 0) WSP(float, WS_DECAY)[((size_t)h * HGNC + n) * HGD + d] = __expf(b_last);
    LDS_WAIT(); __syncthreads();
    const int fr = C.lane & 15, fq = C.lane >> 4, w = C.wave;
    bf16x8 bfr[2];
#pragma unroll
    for (int ks = 0; ks < 2; ++ks) bfr[ks] = *(const LAS bf16x8*)(VT + (16 * w + fr) * 72 + 8 * fq + 32 * ks);
    float* DST = WSP(float, WS_DST) + (((size_t)h * HGNC + n) * HGD + 16 * w + fr) * HGD;
#pragma unroll
    for (int mt = 0; mt < 8; ++mt) { f32x4 acc = {0.f, 0.f, 0.f, 0.f};
#pragma unroll
        for (int ks = 0; ks < 2; ++ks) { const bf16x8 a = *(const LAS bf16x8*)(KDT + (16 * mt + fr) * 72 + 8 * fq + 32 * ks); acc = __builtin_amdgcn_mfma_f32_16x16x32_bf16(a, bfr[ks], acc, 0, 0, 0); }
        *(f32x4*)(DST + 16 * mt + 4 * fq) = acc; }
    LDS_WAIT(); __syncthreads();
}
__device__ __forceinline__ void hgrn_scan(const Ctx& C) {
    const float* DST = WSP(float, WS_DST); const float* DEC = WSP(float, WS_DECAY); bf16_t* SPT = WSP(bf16_t, WS_SPT);
    for (int e = C.bid * 512 + C.tid; e < HGH * HGD * HGD; e += C.G * 512) {
        const int h = e >> 14, dv = (e >> 7) & 127, dk = e & 127; float S = 0.f;
        const size_t base = ((size_t)h * HGNC * HGD + dv) * HGD + dk; const size_t dbase = (size_t)h * HGNC * HGD + dk;
#pragma unroll 16
        for (int n = 0; n < HGNC; ++n) { SPT[base + (size_t)n * HGD * HGD] = f2bf(S); S = DEC[dbase + (size_t)n * HGD] * S + DST[base + (size_t)n * HGD * HGD]; }
    }
}
constexpr int HC_QIN = 0, HC_KIN = 17408, HC_QE = 34816, HC_VT = 52224, HC_AQ = 70656, HC_TOT = 79872, HC_OL = 81920;
__device__ __forceinline__ void hgrn_c_unit(const Ctx& C, int h, int n) {
    LAS bf16_t* QIN = (LAS bf16_t*)(C.lds + HC_QIN); LAS bf16_t* KIN = (LAS bf16_t*)(C.lds + HC_KIN); LAS bf16_t* QE = (LAS bf16_t*)(C.lds + HC_QE);
    LAS bf16_t* VT = (LAS bf16_t*)(C.lds + HC_VT); LAS bf16_t* AQ = (LAS bf16_t*)(C.lds + HC_AQ); LAS float* TOT = (LAS float*)(C.lds + HC_TOT); LAS float* OL = (LAS float*)(C.lds + HC_OL);
    const int d = C.tid & 127, rg = C.tid >> 7;
    float fv[16], bb[16], b_ref, b_last; hgrn_cumsum(C, h, n, fv, bb, b_ref, b_last, TOT);
    const size_t gro = ((size_t)(n * HGC + rg * 16)) * HGW + h * HGD + d; const bf16_t* HVp = WSP(bf16_t, WS_HV) + gro; const bf16_t* HQp = WSP(bf16_t, WS_HQ) + gro;
#pragma unroll
    for (int g = 0; g < 2; ++g) { float vv[8];
#pragma unroll
        for (int i = 0; i < 8; ++i) { const int r = g * 8 + i, c = rg * 16 + r; const float q = bf2f(HQp[(size_t)r * HGW]), k = 1.0f - fv[r];
            QIN[c * 136 + d] = f2bf(q * __expf(bb[r] - b_ref)); KIN[c * 136 + d] = f2bf(k * __expf(b_ref - bb[r])); QE[c * 136 + d] = f2bf(q * __expf(bb[r])); vv[i] = bf2f(HVp[(size_t)r * HGW]); }
        u32x4 wv; wv.x = cvt_pk_bf16(vv[0], vv[1]); wv.y = cvt_pk_bf16(vv[2], vv[3]); wv.z = cvt_pk_bf16(vv[4], vv[5]); wv.w = cvt_pk_bf16(vv[6], vv[7]);
        *(LAS u32x4*)(VT + d * 72 + rg * 16 + g * 8) = wv; }
    LDS_WAIT(); __syncthreads();
    const int fr = C.lane & 15, fq = C.lane >> 4, w = C.wave;
    { const int mt = w >> 1;
#pragma unroll
      for (int j = 0; j < 2; ++j) { const int nt = 2 * (w & 1) + j; f32x4 acc = {0.f, 0.f, 0.f, 0.f};
#pragma unroll
        for (int ks = 0; ks < 4; ++ks) { const bf16x8 a = *(const LAS bf16x8*)(QIN + (16 * mt + fr) * 136 + 8 * fq + 32 * ks), b = *(const LAS bf16x8*)(KIN + (16 * nt + fr) * 136 + 8 * fq + 32 * ks);
            acc = __builtin_amdgcn_mfma_f32_16x16x32_bf16(a, b, acc, 0, 0, 0); }
        const int s = 16 * nt + fr;
#pragma unroll
        for (int i = 0; i < 4; ++i) { const int c = 16 * mt + 4 * fq + i; AQ[c * 72 + s] = f2bf(s <= c ? acc[i] : 0.f); } } }
    LDS_WAIT(); __syncthreads();
    { bf16x8 bv[2], bs[4]; const bf16_t* SP = WSP(bf16_t, WS_SPT) + (((size_t)h * HGNC + n) * HGD + 16 * w + fr) * HGD;
#pragma unroll
      for (int ks = 0; ks < 2; ++ks) bv[ks] = *(const LAS bf16x8*)(VT + (16 * w + fr) * 72 + 8 * fq + 32 * ks);
#pragma unroll
      for (int ks = 0; ks < 4; ++ks) bs[ks] = *(const bf16x8*)(SP + 8 * fq + 32 * ks);
#pragma unroll
      for (int mt = 0; mt < 4; ++mt) { f32x4 acc = {0.f, 0.f, 0.f, 0.f};
#pragma unroll
        for (int ks = 0; ks < 2; ++ks) { const bf16x8 a = *(const LAS bf16x8*)(AQ + (16 * mt + fr) * 72 + 8 * fq + 32 * ks); acc = __builtin_amdgcn_mfma_f32_16x16x32_bf16(a, bv[ks], acc, 0, 0, 0); }
#pragma unroll
        for (int ks = 0; ks < 4; ++ks) { const bf16x8 a = *(const LAS bf16x8*)(QE + (16 * mt + fr) * 136 + 8 * fq + 32 * ks); acc = __builtin_amdgcn_mfma_f32_16x16x32_bf16(a, bs[ks], acc, 0, 0, 0); }
#pragma unroll
        for (int i = 0; i < 4; ++i) OL[(16 * mt + 4 * fq + i) * 132 + 16 * w + fr] = acc[i]; } }
    LDS_WAIT(); __syncthreads();
    { const int c = C.tid >> 3, j = C.tid & 7; f32x4 o[4]; float ss = 0.f;
#pragma unroll
      for (int i = 0; i < 4; ++i) { o[i] = *(const LAS f32x4*)(OL + c * 132 + 16 * j + 4 * i); ss += sumsq4(o[i]); }
      ss += __shfl_xor(ss, 1); ss += __shfl_xor(ss, 2); ss += __shfl_xor(ss, 4);
      const float rs = __builtin_amdgcn_rsqf(ss * (1.0f / HGD) + EPS); const size_t go = (size_t)(n * HGC + c) * HGW + h * HGD + 16 * j;
      const float* gn = IP(6) + h * HGD + 16 * j; const bf16_t* HOG = WSP(bf16_t, WS_HOG) + go; bf16_t* OA = WSP(bf16_t, WS_OA) + go;
#pragma unroll
      for (int i = 0; i < 2; ++i) { f32x4 s0, s1; unpack8(*(const u32x4*)(HOG + 8 * i), s0, s1);
          *(u32x4*)(OA + 8 * i) = pack8(o[2 * i] * rs * *(const f32x4*)(gn + 8 * i) * s0, o[2 * i + 1] * rs * *(const f32x4*)(gn + 8 * i + 4) * s1); } }
    LDS_WAIT(); __syncthreads();
}

constexpr int AT_K = 0, AT_KSTR = 400, AT_V = 25600, AT_MRG = 0, AT_MRG_STRIDE = 16384 + 256;
typedef short v4i16_t __attribute__((ext_vector_type(4)));
__device__ __forceinline__ s16x4 vtr(const LAS unsigned char* p) { return __builtin_bit_cast(s16x4, __builtin_amdgcn_ds_read_tr16_b64_v4i16((LAS v4i16_t*)p)); }
__device__ __forceinline__ int crow(int r, int hi) { return (r & 3) + 8 * (r >> 2) + 4 * hi; }
__device__ __forceinline__ void attn_unit(const Ctx& C, int h, int qb) {
    const int lane = C.lane, ql = lane & 31, hi = lane >> 5, kg = C.wave >> 2, qw = C.wave & 3, tid = C.tid;
    const int q0 = qb * 128, ntiles = 2 * (qb + 1), qpos = q0 + 32 * qw + ql;
    const bf16_t* Qp = WSP(bf16_t, WS_Q) + ((size_t)h * T + qpos) * MQK + 8 * hi; const bf16_t* Kp = WSP(bf16_t, WS_K) + (size_t)h * T * MQK; const bf16_t* Vp = WSP(bf16_t, WS_V) + (size_t)h * T * MV;
    bf16x8 qf[12];
#pragma unroll
    for (int ks = 0; ks < 12; ++ks) qf[ks] = *(const bf16x8*)(Qp + 16 * ks);
    float m_run = -1e30f, l_run = 0.f; f32x16 oT[4];
#pragma unroll
    for (int nb = 0; nb < 4; ++nb) oT[nb] = (f32x16){0.f, 0.f, 0.f, 0.f, 0.f, 0.f, 0.f, 0.f, 0.f, 0.f, 0.f, 0.f, 0.f, 0.f, 0.f, 0.f};
    const LAS unsigned char* kfrag = C.lds + AT_K + (32 * kg + ql) * AT_KSTR + 16 * hi;
    const LAS unsigned char* vfrag = C.lds + AT_V + (16 * kg) * 512 + (4 * hi + ((lane & 15) >> 2)) * 64 + ((lane >> 4) & 1) * 32 + (lane & 3) * 8;
    u32x4 kr[3], vr[2];
#define AT_FETCH(K0_) do { _Pragma("unroll") for (int i = 0; i < 3; ++i) { const int cid = tid + 512 * i, r = cid / 24, cc = cid - r * 24; kr[i] = *(const u32x4*)(Kp + (size_t)((K0_) + r) * MQK + cc * 8); } \
        _Pragma("unroll") for (int i = 0; i < 2; ++i) { const int cid = tid + 512 * i, r = cid >> 4, cc = cid & 15; vr[i] = *(const u32x4*)(Vp + (size_t)((K0_) + r) * MV + cc * 8); } } while (0)
    AT_FETCH(0);
    for (int j = 0; j < ntiles; ++j) {
        const int k0 = 64 * j;
        __syncthreads();
#pragma unroll
        for (int i = 0; i < 3; ++i) { const int cid = tid + 512 * i, r = cid / 24, cc = cid - r * 24; *(LAS u32x4*)(C.lds + AT_K + r * AT_KSTR + cc * 16) = kr[i]; }
#pragma unroll
        for (int i = 0; i < 2; ++i) { const int cid = tid + 512 * i, r = cid >> 4, cc = cid & 15; *(LAS u32x4*)(C.lds + AT_V + ((r >> 3) * 4 + (cc >> 2)) * 512 + (r & 7) * 64 + (cc & 3) * 16) = vr[i]; }
        LDS_WAIT(); __syncthreads();
        if (j + 1 < ntiles) AT_FETCH(k0 + 64);
        const int kbase = k0 + 32 * kg;
        if (kbase <= q0 + 32 * qw + 31) {
            f32x16 st = (f32x16){0.f, 0.f, 0.f, 0.f, 0.f, 0.f, 0.f, 0.f, 0.f, 0.f, 0.f, 0.f, 0.f, 0.f, 0.f, 0.f};
#pragma unroll
            for (int ks = 0; ks < 12; ++ks) { const bf16x8 a = *(const LAS bf16x8*)(kfrag + 32 * ks); st = __builtin_amdgcn_mfma_f32_32x32x16_bf16(a, qf[ks], st, 0, 0, 0); }
            if (kbase + 31 > q0 + 32 * qw) {
#pragma unroll
                for (int r = 0; r < 16; ++r) if (kbase + crow(r, hi) > qpos) st[r] = -__builtin_inff();
            }
            float mx = st[0];
#pragma unroll
            for (int r = 1; r < 16; ++r) mx = fmaxf(mx, st[r]);
            mx = fmaxf(mx, __shfl_xor(mx, 32));
            const float m_new = fmaxf(m_run, mx), alpha = __builtin_amdgcn_exp2f(m_run - m_new); m_run = m_new;
            float ps = 0.f;
#pragma unroll
            for (int r = 0; r < 16; ++r) { st[r] = __builtin_amdgcn_exp2f(st[r] - m_new); ps += st[r]; }
            ps += __shfl_xor(ps, 32); l_run = l_run * alpha + ps;
#pragma unroll
            for (int nb = 0; nb < 4; ++nb) oT[nb] *= alpha;
            bf16x8 pf[2];
#pragma unroll
            for (int s2 = 0; s2 < 2; ++s2) { u32x4 w; w.x = cvt_pk_bf16(st[8 * s2 + 0], st[8 * s2 + 1]); w.y = cvt_pk_bf16(st[8 * s2 + 2], st[8 * s2 + 3]); w.z = cvt_pk_bf16(st[8 * s2 + 4], st[8 * s2 + 5]); w.w = cvt_pk_bf16(st[8 * s2 + 6], st[8 * s2 + 7]); pf[s2] = __builtin_bit_cast(bf16x8, w); }
#pragma unroll
            for (int nb = 0; nb < 4; ++nb)
#pragma unroll
                for (int s2 = 0; s2 < 2; ++s2) { const s16x4 lo = vtr(vfrag + (8 * s2) * 512 + nb * 512), hh = vtr(vfrag + (8 * s2 + 4) * 512 + nb * 512);
                    const bf16x8 vf = (bf16x8){lo[0], lo[1], lo[2], lo[3], hh[0], hh[1], hh[2], hh[3]};
                    oT[nb] = __builtin_amdgcn_mfma_f32_32x32x16_bf16(vf, pf[s2], oT[nb], 0, 0, 0); }
        }
    }
#undef AT_FETCH
    __syncthreads();
    LAS float* MG = (LAS float*)(C.lds + AT_MRG + qw * AT_MRG_STRIDE);
    if (kg == 1) { if (hi == 0) { MG[2 * ql] = m_run; MG[2 * ql + 1] = l_run; }
#pragma unroll
        for (int nb = 0; nb < 4; ++nb)
#pragma unroll
            for (int r = 0; r < 16; ++r) MG[64 + (nb * 16 + r) * 64 + lane] = oT[nb][r]; }
    LDS_WAIT(); __syncthreads();
    if (kg == 0) { const float m2 = MG[2 * ql], l2 = MG[2 * ql + 1], mm = fmaxf(m_run, m2), a1 = __builtin_amdgcn_exp2f(m_run - mm), a2 = __builtin_amdgcn_exp2f(m2 - mm);
        const float inv = 1.0f / (a1 * l_run + a2 * l2); const float c1 = a1 * inv, c2 = a2 * inv;
        bf16_t* O = WSP(bf16_t, WS_OB) + (size_t)qpos * HGW + h * MV + 4 * hi;
#pragma unroll
        for (int nb = 0; nb < 4; ++nb)
#pragma unroll
            for (int g = 0; g < 4; ++g) { float o[4];
#pragma unroll
                for (int i = 0; i < 4; ++i) { const int r = 4 * g + i; o[i] = c1 * oT[nb][r] + c2 * MG[64 + (nb * 16 + r) * 64 + lane]; }
                u32x2 w; w.x = cvt_pk_bf16(o[0], o[1]); w.y = cvt_pk_bf16(o[2], o[3]); *(u32x2*)(O + 32 * nb + 8 * g) = w; } }
    LDS_WAIT();
}

constexpr int TK_K1 = 0, TK_K2 = 34816, TK_KSTR = 272, TK_IDX = 69632;
__device__ __forceinline__ int f2ord(float f) { const int i = __float_as_int(f); return i >= 0 ? i : (i ^ 0x7fffffff); }
__device__ __forceinline__ float ord2f(int k) { return __int_as_float(k >= 0 ? k : (k ^ 0x7fffffff)); }
#define TK_INS(L, x) do { int _x = (x); _Pragma("unroll") for (int _i = 0; _i < 16; ++_i) { const int _t = max(L[_i], _x); _x = min(L[_i], _x); L[_i] = _t; } } while (0)
__device__ __forceinline__ void topk_stage_keys(const Ctx& C) {
#pragma unroll
    for (int i = 0; i < 8; ++i) { const int cid = C.tid + 512 * i, tb = cid >> 11, r = (cid >> 4) & 127, cc = cid & 15;
        *(LAS u32x4*)(C.lds + tb * TK_K2 + r * TK_KSTR + cc * 16) = *(const u32x4*)(WSP(bf16_t, tb ? WS_K2B : WS_K1B) + r * 128 + cc * 8); }
    LDS_WAIT(); __syncthreads();
}
__device__ __forceinline__ void topk_wave(const Ctx& C, int tb, int head) {
    const int lane = C.lane, tl = lane & 31, hi = lane >> 5, t = tb * 32 + tl;
    int v12[2][16];
#pragma unroll
    for (int half = 0; half < 2; ++half) {
        f32x16 acc[4];
#pragma unroll
        for (int kt = 0; kt < 4; ++kt) acc[kt] = (f32x16){0.f, 0.f, 0.f, 0.f, 0.f, 0.f, 0.f, 0.f, 0.f, 0.f, 0.f, 0.f, 0.f, 0.f, 0.f, 0.f};
        const bf16_t* qp = WSP(bf16_t, WS_QP) + (size_t)t * DM + head * PQD + half * 128 + 8 * hi; const LAS unsigned char* kp = C.lds + half * TK_K2 + tl * TK_KSTR + 16 * hi;
#pragma unroll
        for (int ks = 0; ks < 8; ++ks) { const bf16x8 bq = *(const bf16x8*)(qp + 16 * ks);
#pragma unroll
            for (int kt = 0; kt < 4; ++kt) { const bf16x8 ak = *(const LAS bf16x8*)(kp + kt * 32 * TK_KSTR + 32 * ks); acc[kt] = __builtin_amdgcn_mfma_f32_32x32x16_bf16(ak, bq, acc[kt], 0, 0, 0); } }
        int L[16];
#pragma unroll
        for (int i = 0; i < 16; ++i) L[i] = (int)0x80000000;
#pragma unroll
        for (int kt = 0; kt < 4; ++kt)
#pragma unroll
            for (int r = 0; r < 16; ++r) { const int key = 32 * kt + (r & 3) + 8 * (r >> 2) + 4 * hi; TK_INS(L, (f2ord(acc[kt][r]) & ~127) | (127 - key)); }
        int P[16];
#pragma unroll
        for (int i = 0; i < 16; ++i) P[i] = __shfl_xor(L[i], 32);
#pragma unroll
        for (int i = 0; i < 16; ++i) TK_INS(L, P[i]);
#pragma unroll
        for (int i = 0; i < 16; ++i) v12[half][i] = L[i];
    }
    LAS int* IDX = (LAS int*)(C.lds + TK_IDX + 4096 * C.wave) + tl * 32;
#pragma unroll
    for (int g = 0; g < 4; ++g) { u32x4 w;
#pragma unroll
        for (int i = 0; i < 4; ++i) w[i] = (unsigned)(127 - ((hi ? v12[1][4 * g + i] : v12[0][4 * g + i]) & 127));
        *(LAS u32x4*)(IDX + 16 * hi + 4 * g) = w; }
    float f1[16], f2[16];
#pragma unroll
    for (int i = 0; i < 16; ++i) { f1[i] = ord2f(v12[0][i] & ~127); f2[i] = ord2f(v12[1][i] & ~127); }
    int CL[16];
#pragma unroll
    for (int i = 0; i < 16; ++i) CL[i] = (int)0x80000000;
#pragma unroll
    for (int ca = 0; ca < 16; ++ca)
#pragma unroll
        for (int cb = 0; cb < 16; ++cb) if ((ca + 1) * (cb + 1) <= 16) TK_INS(CL, (f2ord(f1[ca] + f2[cb]) & ~255) | (255 - (ca * 16 + cb)));
    float rs;
    { const f32x4* sp = (const f32x4*)(WSP(float, WS_SSQ1) + (size_t)t * 32 + 16 * hi); const f32x4 s0 = sp[0], s1 = sp[1], s2 = sp[2], s3 = sp[3];
      float ss = ((s0[0] + s0[1]) + (s0[2] + s0[3])) + ((s1[0] + s1[1]) + (s1[2] + s1[3])) + ((s2[0] + s2[1]) + (s2[2] + s2[3])) + ((s3[0] + s3[1]) + (s3[2] + s3[3]));
      ss += __shfl_xor(ss, 32); rs = __builtin_amdgcn_rsqf(ss * (1.0f / DM) + EPS); if (head == 0 && hi == 0) WSP(float, WS_RS1)[t] = rs; }
    float ev[16], sm = 0.f; const float mx = ord2f(CL[0] & ~255);
#pragma unroll
    for (int i = 0; i < 16; ++i) { ev[i] = __expf((ord2f(CL[i] & ~255) - mx) * rs); sm += ev[i]; }
    const float inv = 1.0f / sm;
    LDS_WAIT();
    int eo[8]; float go[8];
#pragma unroll
    for (int i = 0; i < 8; ++i) { const int ck = hi ? CL[8 + i] : CL[i]; const int ab = 255 - (ck & 255); eo[i] = IDX[ab >> 4] * PNK + IDX[16 + (ab & 15)]; go[i] = (hi ? ev[8 + i] : ev[i]) * inv; }
    int* ep = WSP(int, WS_EIDX) + (size_t)t * 128 + head * 16 + 8 * hi; float* gp = WSP(float, WS_GATE) + (size_t)t * 128 + head * 16 + 8 * hi;
    *(u32x4*)ep = (u32x4){(unsigned)eo[0], (unsigned)eo[1], (unsigned)eo[2], (unsigned)eo[3]}; *(u32x4*)(ep + 4) = (u32x4){(unsigned)eo[4], (unsigned)eo[5], (unsigned)eo[6], (unsigned)eo[7]};
    *(f32x4*)gp = (f32x4){go[0], go[1], go[2], go[3]}; *(f32x4*)(gp + 4) = (f32x4){go[4], go[5], go[6], go[7]};
    LDS_WAIT();
}

__device__ __forceinline__ void fp8_row(const float* src, unsigned char* dst, float* scale, int row, int lane) {
    const float* xr = src + (size_t)row * DM + 16 * lane; f32x4 v[8]; float am = 0.f;
#pragma unroll
    for (int j = 0; j < 2; ++j)
#pragma unroll
        for (int i = 0; i < 4; ++i) { v[4 * j + i] = *(const f32x4*)(xr + 1024 * j + 4 * i); am = fmaxf(am, fmaxf(fmaxf(fabsf(v[4 * j + i][0]), fabsf(v[4 * j + i][1])), fmaxf(fabsf(v[4 * j + i][2]), fabsf(v[4 * j + i][3])))); }
#pragma unroll
    for (int o = 1; o < 64; o <<= 1) am = fmaxf(am, __shfl_xor(am, o));
    const float sc = am > 0.f ? am * (1.0f / 240.0f) : 1.0f, inv = am > 0.f ? 240.0f / am : 1.0f;
    if (lane == 0) scale[row] = sc;
#pragma unroll
    for (int j = 0; j < 2; ++j) { u32x4 w;
#pragma unroll
        for (int i = 0; i < 4; ++i) { const f32x4 y = v[4 * j + i] * inv; int p = 0; p = __builtin_amdgcn_cvt_pk_fp8_f32(y[0], y[1], p, false); p = __builtin_amdgcn_cvt_pk_fp8_f32(y[2], y[3], p, true); w[i] = (unsigned)p; }
        *(u32x4*)(dst + (size_t)row * DM + 1024 * j + 16 * lane) = w; }
}
__device__ __forceinline__ float gelu_erf(float z) { return 0.5f * z * (1.0f + erff(z * 0.70710678118654752f)); }
__device__ __forceinline__ void cvt16(const u32x4 w, f32x2 (&o)[8]) {
#pragma unroll
    for (int i = 0; i < 4; ++i) { o[2 * i] = __builtin_amdgcn_cvt_pk_f32_fp8((int)w[i], false); o[2 * i + 1] = __builtin_amdgcn_cvt_pk_f32_fp8((int)w[i], true); }
}
__device__ __forceinline__ float row16_allsum(float d) {
    d += __builtin_bit_cast(float, __builtin_amdgcn_update_dpp(0, __builtin_bit_cast(int, d), 0x121, 0xf, 0xf, false));
    d += __builtin_bit_cast(float, __builtin_amdgcn_update_dpp(0, __builtin_bit_cast(int, d), 0x122, 0xf, 0xf, false));
    d += __builtin_bit_cast(float, __builtin_amdgcn_update_dpp(0, __builtin_bit_cast(int, d), 0x124, 0xf, 0xf, false));
    d += __builtin_bit_cast(float, __builtin_amdgcn_update_dpp(0, __builtin_bit_cast(int, d), 0x128, 0xf, 0xf, false));
    return d;
}
__device__ __forceinline__ void peer_z_wave(const Ctx& C, int s, int t0, int tstep) {
    if (t0 >= T) return;
    const int lane = C.lane, g = lane >> 4, c = lane & 15, col0 = 256 * s + 16 * c;
    const unsigned char* U = WSP(unsigned char, WS_U8); const int* EI = WSP(int, WS_EIDX) + lane; const float* RS = WSP(float, WS_RS1); const float* gnp = IP(14) + col0;
    u32x4 uwA[8], uwB[8]; f32x4 xv[4]; f32x2 h[8]; int eC0, eC1, eN0 = 0, eN1 = 0;
#define PZ_ROWS(UW, EB_, Q_) do { _Pragma("unroll") for (int i = 0; i < 8; ++i) { const int e = __shfl((EB_), 32 * ((Q_) & 1) + 4 * i + g); UW[i] = *(const u32x4*)(U + ((unsigned)e * (unsigned)DM + (unsigned)col0)); } } while (0)
#define PZ_X(T_) do { _Pragma("unroll") for (int i = 0; i < 4; ++i) xv[i] = *(const f32x4*)(C.out + (size_t)(T_) * DM + col0 + 4 * i); } while (0)
#define PZ_DOTS(UW, ZK, Q_) do { _Pragma("unroll") for (int i = 0; i < 8; ++i) { f32x2 uf[8]; cvt16(UW[i], uf); f32x2 a = uf[0] * h[0]; \
            _Pragma("unroll") for (int k = 1; k < 8; ++k) a += uf[k] * h[k]; \
            const float d = row16_allsum(a.x + a.y); ZK = (c == i + 8 * ((Q_) & 1)) ? d : ZK; } } while (0)
    eC0 = EI[(size_t)t0 * 128]; eC1 = EI[(size_t)t0 * 128 + 64];
    PZ_ROWS(uwA, eC0, 0); PZ_X(t0);
    for (int t = t0; t < T; t += tstep) {
        const int tn = t + tstep; const bool more = tn < T;
        if (more) { eN0 = EI[(size_t)tn * 128]; eN1 = EI[(size_t)tn * 128 + 64]; }
        PZ_ROWS(uwB, eC0, 1);
        { const float rs = RS[t];
#pragma unroll
          for (int i = 0; i < 4; ++i) { const f32x4 y = xv[i] * rs * *(const f32x4*)(gnp + 4 * i); h[2 * i] = (f32x2){y[0], y[1]}; h[2 * i + 1] = (f32x2){y[2], y[3]}; } }
        float zk0 = 0.f, zk1 = 0.f;
        PZ_DOTS(uwA, zk0, 0);
        PZ_ROWS(uwA, eC1, 0);
        PZ_DOTS(uwB, zk0, 1);
        PZ_ROWS(uwB, eC1, 1);
        PZ_DOTS(uwA, zk1, 0);
        if (more) { PZ_ROWS(uwA, eN0, 0); PZ_X(tn); }
        PZ_DOTS(uwB, zk1, 1);
        float* zp = WSP(float, WS_ZP) + ((size_t)t * 8 + s) * 128; zp[4 * c + g] = zk0; zp[64 + 4 * c + g] = zk1;
        eC0 = eN0; eC1 = eN1;
    }
#undef PZ_ROWS
#undef PZ_X
#undef PZ_DOTS
}
__device__ __forceinline__ void peer_act(const Ctx& C) {
    const float* zp = WSP(float, WS_ZP); const int* EI = WSP(int, WS_EIDX); const float* GT = WSP(float, WS_GATE); float* A = WSP(float, WS_PA);
    for (int i = C.bid * 512 + C.tid; i < T * 128; i += C.G * 512) { const int t = i >> 7, e = i & 127; float z = 0.f;
#pragma unroll
        for (int q = 0; q < 8; ++q) z += zp[((size_t)t * 8 + q) * 128 + e];
        const int ex = EI[i]; A[i] = gelu_erf(z * WSP(float, WS_SU)[ex]) * GT[i] * WSP(float, WS_SV)[ex]; }
}
__device__ __forceinline__ void peer_out_wave(const Ctx& C, int s, int t0, int tstep) {
    if (t0 >= T) return;
    const int lane = C.lane, g = lane >> 4, c = lane & 15, col0 = 256 * s + 16 * c;
    const unsigned char* V = WSP(unsigned char, WS_V8); const int* EI = WSP(int, WS_EIDX) + lane; const float* PA = WSP(float, WS_PA) + lane;
    const f32x4 gp = *(const f32x4*)(IP(20) + col0 + 4 * g);
    u32x4 vwA[8], vwB[8]; int eC0, eC1, eN0 = 0, eN1 = 0; float aC0, aC1, aN0 = 0.f, aN1 = 0.f;
#define PO_ROWS(VW, EB_, Q_) do { _Pragma("unroll") for (int i = 0; i < 8; ++i) { const int e = __shfl((EB_), 32 * ((Q_) & 1) + 4 * i + g); VW[i] = *(const u32x4*)(V + ((unsigned)e * (unsigned)DM + (unsigned)col0)); } } while (0)
#define PO_ACC(VW, AB_, Q_) do { _Pragma("unroll") for (int i = 0; i < 8; ++i) { const float av = __shfl((AB_), 32 * ((Q_) & 1) + 4 * i + g); f32x2 vf[8]; cvt16(VW[i], vf); \
            _Pragma("unroll") for (int k = 0; k < 8; ++k) acc[k] += vf[k] * av; } } while (0)
    eC0 = EI[(size_t)t0 * 128]; eC1 = EI[(size_t)t0 * 128 + 64]; aC0 = PA[(size_t)t0 * 128]; aC1 = PA[(size_t)t0 * 128 + 64];
    PO_ROWS(vwA, eC0, 0);
    for (int t = t0; t < T; t += tstep) {
        const int tn = t + tstep; const bool more = tn < T;
        if (more) { eN0 = EI[(size_t)tn * 128]; eN1 = EI[(size_t)tn * 128 + 64]; aN0 = PA[(size_t)tn * 128]; aN1 = PA[(size_t)tn * 128 + 64]; }
        PO_ROWS(vwB, eC0, 1);
        const size_t o = (size_t)t * DM + col0 + 4 * g; const f32x4 x1 = *(const f32x4*)(C.out + o);
        f32x2 acc[8];
#pragma unroll
        for (int k = 0; k < 8; ++k) acc[k] = (f32x2){0.f, 0.f};
        PO_ACC(vwA, aC0, 0);
        PO_ROWS(vwA, eC1, 0);
        PO_ACC(vwB, aC0, 1);
        PO_ROWS(vwB, eC1, 1);
        PO_ACC(vwA, aC1, 0);
        if (more) PO_ROWS(vwA, eN0, 0);
        PO_ACC(vwB, aC1, 1);
#pragma unroll
        for (int k = 0; k < 8; ++k) { acc[k].x += __shfl_xor(acc[k].x, 16); acc[k].y += __shfl_xor(acc[k].y, 16); acc[k].x += __shfl_xor(acc[k].x, 32); acc[k].y += __shfl_xor(acc[k].y, 32); }
        const f32x2 p0 = g == 0 ? acc[0] : g == 1 ? acc[2] : g == 2 ? acc[4] : acc[6], p1 = g == 0 ? acc[1] : g == 1 ? acc[3] : g == 2 ? acc[5] : acc[7];
        const f32x4 x2 = x1 + (f32x4){p0.x, p0.y, p1.x, p1.y};
        *(f32x4*)(WSP(float, WS_X2) + o) = x2;
        const f32x4 y = x2 * gp; u32x2 w; w.x = cvt_pk_bf16(y[0], y[1]); w.y = cvt_pk_bf16(y[2], y[3]); *(u32x2*)(WSP(bf16_t, WS_ACTA) + o) = w;
        const float s2 = wave_sum(sumsq4(x2)); if (lane == 0) WSP(float, WS_SSQ2)[(size_t)t * 8 + s] = s2;
        eC0 = eN0; eC1 = eN1; aC0 = aN0; aC1 = aN1;
    }
#undef PO_ROWS
#undef PO_ACC
}
__device__ __forceinline__ void final_row(const Ctx& C, int t) {
    const int lane = C.lane; float pz = lane < 32 ? WSP(float, WS_SSQ3)[(size_t)t * 32 + lane] : 0.f;
    const float rs = __builtin_amdgcn_rsqf(wave_sum(pz) * (1.0f / DM) + EPS);
    f32x4* xr = (f32x4*)(C.out + (size_t)t * DM) + lane; const f32x4* gr = (const f32x4*)IP(23) + lane;
#pragma unroll
    for (int j = 0; j < 8; ++j) xr[64 * j] = xr[64 * j] * rs * gr[64 * j];
}

constexpr int NPHASE = 12;
#ifndef MK_ONE_LAUNCH
#define MK_ONE_LAUNCH 1
#endif
constexpr int LDS_BYTES = 147456;
constexpr int MISC_OFF = 131072 + 320;
struct Args { const void* in[24]; float* out; unsigned char* ws; int ph_lo, ph_hi; };
#define GEMM_ALIGN true
#define GEMM_SP2 true

__global__ void __launch_bounds__(512, 2) mk_fwd(Args args) {
    extern __shared__ __attribute__((aligned(16))) unsigned char lds_raw[];
    Ctx C;
    C.lds = (LAS unsigned char*)lds_raw; C.tid = threadIdx.x; C.lane = C.tid & 63; C.wave = __builtin_amdgcn_readfirstlane(C.tid >> 6); C.G = gridDim.x; C.bid = blockIdx.x;
    C.out = (float*)karg_ptr(24); C.ws = (unsigned char*)karg_ptr(25);
    volatile LAS unsigned* MISC = (volatile LAS unsigned*)(C.lds + MISC_OFF);
    if (C.tid < 32) MISC[C.tid] = 0u;
    __syncthreads();
    const int lo = ((const int __attribute__((address_space(4)))*)__builtin_amdgcn_kernarg_segment_ptr())[52], hi = ((const int __attribute__((address_space(4)))*)__builtin_amdgcn_kernarg_segment_ptr())[53];
    const bool multi = (hi - lo) > 1;
    XcdBarrier bar; bar.bar = (unsigned*)(C.ws + WS_CTL) + 1024; bar.x = 0; bar.st = nullptr;
    if (multi) bar = xcd_barrier_post((unsigned*)(C.ws + WS_CTL) + 1024, MISC + 8);
    LAS unsigned char* L = C.lds;
    const int gw = C.bid * 8 + C.wave, NGW = C.G * 8;

    if (lo <= 0 && 0 < hi) {
 phase_prep(C);
    }
    if (lo <= 0 && 1 < hi) xcd_barrier(bar);
    if (lo <= 1 && 1 < hi) {
        pg8::Gemm g{WSP(bf16_t, WS_ACTA), WSP(bf16_t, WS_WINT), T, INW_PAD, DM}; pg8::StaticOrder S; S.init(T, INW_PAD, C.G, C.bid);
        pg8::EpiProj E{WSP(bf16_t, WS_HQ), WSP(bf16_t, WS_HV), WSP(bf16_t, WS_HOG), WSP(bf16_t, WS_MQG), WSP(bf16_t, WS_MKVG), WSP(bf16_t, WS_GA), WSP(bf16_t, WS_GB), WSP(bf16_t, WS_K),
                       WSP(float, WS_F), WSP(float, WS_SSQQ), WSP(float, WS_SSQKV), WSP(float, WS_LB), IP(7), IP(8), WSP(pg8::f32x2, WS_CS)};
        pg8::gemm_phase<pg8::EpiProj, pg8::StaticOrder, GEMM_ALIGN, GEMM_SP2>(L, g, S, E);

    }
    if (lo <= 1 && 2 < hi) xcd_barrier(bar);
    if (lo <= 2 && 2 < hi) {
        { pg8::Gemm g{WSP(bf16_t, WS_MQG), WSP(bf16_t, WS_WUQT), T, MH * MQK, MQL}; pg8::StaticOrder S; S.init(T, MH * MQK, C.G, C.bid);
          pg8::EpiQ E{WSP(bf16_t, WS_Q), WSP(float, WS_SSQQ), WSP(pg8::f32x2, WS_CS)};
          pg8::gemm_phase<pg8::EpiQ, pg8::StaticOrder, GEMM_ALIGN, GEMM_SP2>(L, g, S, E); }
        { pg8::Gemm g{WSP(bf16_t, WS_MKVG), WSP(bf16_t, WS_WUKVT), T, 2048, MKVL}; pg8::StaticOrder S; S.init(T, 2048, C.G, C.bid);
          pg8::EpiKV E{WSP(bf16_t, WS_K), WSP(bf16_t, WS_V), WSP(float, WS_SSQKV)};
          pg8::gemm_phase<pg8::EpiKV, pg8::StaticOrder, GEMM_ALIGN, GEMM_SP2>(L, g, S, E); }
        __syncthreads();
        for (int u = C.bid; u < HGH * HGNC; u += C.G) hgrn_a_unit(C, u >> 7, u & 127);

    }
    if (lo <= 2 && 3 < hi) xcd_barrier(bar);
    if (lo <= 3 && 3 < hi) {
        hgrn_scan(C);
        for (int pr = C.bid; pr < 256; pr += C.G) { const int h = pr >> 5, s = pr & 31; attn_unit(C, h, 63 - s); attn_unit(C, h, s); }

    }
    if (lo <= 3 && 4 < hi) xcd_barrier(bar);
    if (lo <= 4 && 4 < hi) {
        __syncthreads();
        for (int u = C.bid; u < HGH * HGNC; u += C.G) hgrn_c_unit(C, u >> 7, u & 127);
        __syncthreads();
        pg8::Gemm g{WSP(bf16_t, WS_OB), WSP(bf16_t, WS_WBT), T, DM, HGW}; pg8::StaticOrder S; S.init(T, DM, C.G, C.bid);
        pg8::EpiYb E{WSP(bf16_t, WS_GB), WSP(bf16_t, WS_YB)};
        pg8::gemm_phase<pg8::EpiYb, pg8::StaticOrder, GEMM_ALIGN, GEMM_SP2>(L, g, S, E);

    }
    if (lo <= 4 && 5 < hi) xcd_barrier(bar);
    if (lo <= 5 && 5 < hi) {
        for (int r = gw; r < 2 * PNK * PNK; r += NGW) { if (r < PNK * PNK) fp8_row(IP(18), WSP(unsigned char, WS_U8), WSP(float, WS_SU), r, C.lane); else fp8_row(IP(19), WSP(unsigned char, WS_V8), WSP(float, WS_SV), r - PNK * PNK, C.lane); }
        pg8::Gemm g{WSP(bf16_t, WS_OA), WSP(bf16_t, WS_WAT), T, DM, HGW}; pg8::StaticOrder S; S.init(T, DM, C.G, C.bid);
        pg8::EpiY E{WSP(bf16_t, WS_GA), WSP(bf16_t, WS_YB), WSP(bf16_t, WS_Y)};
        pg8::gemm_phase<pg8::EpiY, pg8::StaticOrder, GEMM_ALIGN, GEMM_SP2>(L, g, S, E);

    }
    if (lo <= 5 && 6 < hi) xcd_barrier(bar);
    if (lo <= 6 && 6 < hi) {
        pg8::Gemm g{WSP(bf16_t, WS_Y), WSP(bf16_t, WS_WOT), T, DM, DM}; pg8::StaticOrder S; S.init(T, DM, C.G, C.bid);
        pg8::EpiX1 E{IP(0), IP(14), C.out, WSP(float, WS_SSQ1), WSP(bf16_t, WS_ACTA)};
        pg8::gemm_phase<pg8::EpiX1, pg8::StaticOrder, GEMM_ALIGN, GEMM_SP2>(L, g, S, E);

    }
    if (lo <= 6 && 7 < hi) xcd_barrier(bar);
    if (lo <= 7 && 7 < hi) {
        { pg8::Gemm g{WSP(bf16_t, WS_ACTA), WSP(bf16_t, WS_WQT), T, DM, DM}; pg8::StaticOrder S; S.init(T, DM, C.G, C.bid);
          pg8::EpiPlain E{WSP(bf16_t, WS_QP), DM};
          pg8::gemm_phase<pg8::EpiPlain, pg8::StaticOrder, GEMM_ALIGN, GEMM_SP2>(L, g, S, E); }
        { pg8::Gemm g{WSP(bf16_t, WS_PBF), WSP(bf16_t, WS_WPET), T, DM, PLE}; pg8::StaticOrder S; S.init(T, DM, C.G, C.bid);
          pg8::EpiPlain E{WSP(bf16_t, WS_PE), DM};
          pg8::gemm_phase<pg8::EpiPlain, pg8::StaticOrder, GEMM_ALIGN, GEMM_SP2>(L, g, S, E); }

    }
    if (lo <= 7 && 8 < hi) xcd_barrier(bar);
    if (lo <= 8 && 8 < hi) {
        __syncthreads();
        topk_stage_keys(C);
        for (int wu = gw; wu < (T / 32) * PH; wu += NGW) topk_wave(C, wu >> 3, wu & 7);
        __syncthreads();

    }
    if (lo <= 8 && 9 < hi) xcd_barrier(bar);
    if (lo <= 9 && 9 < hi) {
        { const int sl = C.bid & 7, wsl = (C.bid >> 3) * 8 + C.wave, nws = (C.G >> 3) * 8;
          if (C.bid < (C.G & ~7)) peer_z_wave(C, sl, wsl, nws);
          xcd_barrier(bar);
          peer_act(C);
          xcd_barrier(bar);
          if (C.bid < (C.G & ~7)) peer_out_wave(C, sl, wsl, nws); }

    }
    if (lo <= 9 && 10 < hi) xcd_barrier(bar);
    if (lo <= 10 && 10 < hi) {
        pg8::Gemm g{WSP(bf16_t, WS_ACTA), WSP(bf16_t, WS_WPGT), T, DM, DM}; pg8::StaticOrder S; S.init(T, DM, C.G, C.bid);
        pg8::EpiPle E{WSP(bf16_t, WS_PE), WSP(float, WS_SSQ2), WSP(float, WS_X2), C.out, WSP(float, WS_SSQ3)};
        pg8::gemm_phase<pg8::EpiPle, pg8::StaticOrder, GEMM_ALIGN, GEMM_SP2>(L, g, S, E);

    }
    if (lo <= 10 && 11 < hi) xcd_barrier(bar);
    if (lo <= 11 && 11 < hi) {
 for (int t = gw; t < T; t += NGW) final_row(C, t);
    }
    if (lo <= 11 && 12 < hi) xcd_barrier(bar);
}

extern "C" void kernel_launch(void* const* d_in, const int* in_sizes, int n_in, void* d_out, int out_size, void* d_ws, size_t ws_size, hipStream_t stream) {
    static int grid = 0;
    if (grid == 0) {
        if (n_in != 24 || out_size != T * DM || ws_size < WS_END) { fprintf(stderr, "kernel_launch: unexpected shapes: n_in %d out %d ws %zu (need %zu)\n", n_in, out_size, ws_size, (size_t)WS_END); grid = -1; return; }
        int dev = 0, cus = 0;
        if (hipGetDevice(&dev) != hipSuccess || hipDeviceGetAttribute(&cus, hipDeviceAttributeMultiprocessorCount, dev) != hipSuccess) { grid = -1; return; }
        if (hipFuncSetAttribute((const void*)mk_fwd, hipFuncAttributeMaxDynamicSharedMemorySize, LDS_BYTES) != hipSuccess) { fprintf(stderr, "kernel_launch: hipFuncSetAttribute failed\n"); grid = -1; return; }
        (void)hipGetLastError();
        grid = cus;
    }
    if (grid < 0) return;
    (void)hipMemsetAsync((char*)d_ws + WS_CTL, 0, CTL_ZERO_BYTES, stream);
    Args a{};
    for (int i = 0; i < 24; ++i) a.in[i] = d_in[i];
    a.out = (float*)d_out; a.ws = (unsigned char*)d_ws;
#if MK_ONE_LAUNCH
    a.ph_lo = 0; a.ph_hi = NPHASE;
    hipLaunchKernelGGL(mk_fwd, dim3(grid), dim3(512), LDS_BYTES, stream, a);
#else
    for (int ph = 0; ph < NPHASE; ++ph) { a.ph_lo = ph; a.ph_hi = ph + 1; hipLaunchKernelGGL(mk_fwd, dim3(grid), dim3(512), LDS_BYTES, stream, a); }
#endif
}
```
